# Optimizing an MI355X kernel written in HIP

```python
import jax, jax.numpy as jnp
from jax import lax
import numpy as np

D_MODEL = 1024
BATCH = 4
SEQ = 4096
DEPTH = 2

CHUNK = 64
D_RNN = 1280
RNN_HEADS = 20
RNN_HEAD_DIM = D_RNN // RNN_HEADS
CONV_WIDTH = 4
LRU_C = 8.0
D_SGU = 1024
SGU_GROUPS = 8
SGU_GROUP_DIM = D_SGU // SGU_GROUPS
SGU_BLOCK = 128
N_BRANCH = 2
D_FF = 4 * D_MODEL
D_IN = 2 * D_RNN + 2 * D_SGU + N_BRANCH * D_MODEL
EPS = 1e-6

kernel_name = "hybrid_rglru_sgu_gated_encoder"


def rmsnorm(x, g):
    xf = x.astype(jnp.float32)
    y = xf * lax.rsqrt(jnp.mean(xf * xf, axis=-1, keepdims=True) + EPS)
    return (y * g.astype(jnp.float32)).astype(x.dtype)


def layernorm(x, g, b):
    xf = x.astype(jnp.float32)
    mu = jnp.mean(xf, axis=-1, keepdims=True)
    xc = xf - mu
    y = xc * lax.rsqrt(jnp.mean(xc * xc, axis=-1, keepdims=True) + EPS)
    return (y * g.astype(jnp.float32) + b.astype(jnp.float32)).astype(x.dtype)


def causal_depthwise_conv(x, w, b):
    s = x.shape[1]
    xp = jnp.pad(x, ((0, 0), (CONV_WIDTH - 1, 0), (0, 0)))
    y = b
    for k in range(CONV_WIDTH):
        y = y + xp[:, k:k + s, :] * w[k]
    return y


def rg_lru(x, w_a, b_a, w_x, b_x, lam):
    bsz, s, _ = x.shape
    xh = x.reshape(bsz, s, RNN_HEADS, RNN_HEAD_DIM)
    r = jax.nn.sigmoid(jnp.einsum('bshi,hij->bshj', xh, w_a) + b_a).reshape(bsz, s, D_RNN)
    i = jax.nn.sigmoid(jnp.einsum('bshi,hij->bshj', xh, w_x) + b_x).reshape(bsz, s, D_RNN)
    log_a = (-LRU_C * r.astype(jnp.float32)) * jax.nn.softplus(-lam.astype(jnp.float32))
    a = jnp.exp(log_a)
    norm = jnp.sqrt(-jnp.expm1(2.0 * log_a))
    u = norm * (i * x).astype(jnp.float32)

    def combine(left, right):
        a_l, b_l = left
        a_r, b_r = right
        return a_l * a_r, a_r * b_l + b_r

    _, h = lax.associative_scan(combine, (a, u), axis=1)
    return h.astype(x.dtype)


def spatial_gating(u, v, w_s, b_s, ln_g, ln_b):
    bsz, s, _ = u.shape
    nblk = s // SGU_BLOCK
    v = layernorm(v, ln_g, ln_b)
    vb = v.reshape(bsz, nblk, SGU_BLOCK, SGU_GROUPS, SGU_GROUP_DIM)
    chunk_id = jnp.arange(SGU_BLOCK) // CHUNK
    mask = (chunk_id[:, None] >= chunk_id[None, :]).astype(w_s.dtype)
    mixed = jnp.einsum('gts,bnsgc->bntgc', w_s * mask, vb)
    mixed = mixed + jnp.transpose(b_s)[None, None, :, :, None]
    return u * mixed.reshape(bsz, s, D_SGU)


def hybrid_layer(x, norm_mix_g, w_in, conv_w, conv_b, lru_w_a, lru_b_a, lru_w_x, lru_b_x,
                 lru_lambda, sgu_ln_g, sgu_ln_b, sgu_w_s, sgu_b_s, w_branch_a, w_branch_b,
                 w_out, norm_ffn_g, w_up, w_down):
    h = rmsnorm(x, norm_mix_g)
    proj = jnp.einsum('bsd,de->bse', h, w_in)
    cuts = np.cumsum([D_RNN, D_RNN, D_SGU, D_SGU, D_MODEL])
    x_rnn, g_rnn, u, v, gate_a, gate_b = jnp.split(proj, cuts, axis=-1)

    xr = causal_depthwise_conv(x_rnn, conv_w, conv_b)
    ya = rg_lru(xr, lru_w_a, lru_b_a, lru_w_x, lru_b_x, lru_lambda) * jax.nn.gelu(g_rnn)
    ya = jnp.einsum('bsr,rd->bsd', ya, w_branch_a)

    yb = spatial_gating(jax.nn.gelu(u), jax.nn.gelu(v), sgu_w_s, sgu_b_s, sgu_ln_g, sgu_ln_b)
    yb = jnp.einsum('bsc,cd->bsd', yb, w_branch_b)

    merged = jax.nn.sigmoid(gate_a) * ya + jax.nn.sigmoid(gate_b) * yb
    x = x + jnp.einsum('bsd,de->bse', merged, w_out)

    h2 = rmsnorm(x, norm_ffn_g)
    f = jnp.square(jax.nn.relu(jnp.einsum('bsd,df->bsf', h2, w_up)))
    return x + jnp.einsum('bsf,fd->bsd', f, w_down)


def setup_inputs(seed: int = 0) -> dict:
    key = jax.random.key(seed)
    ks = jax.random.split(key, 24)
    f32 = jnp.float32

    def nrm(k, shape, scale):
        return jax.random.normal(k, shape, f32) * scale

    a_c = jax.random.uniform(ks[7], (DEPTH, D_RNN), f32, 0.9, 0.999)
    a0 = a_c ** (1.0 / LRU_C)
    lru_lambda = jnp.log(a0) - jnp.log1p(-a0)

    return {
        "x": nrm(ks[0], (BATCH, SEQ, D_MODEL), 1.0),
        "norm_mix_g": 1.0 + nrm(ks[1], (DEPTH, D_MODEL), 0.02),
        "w_in": nrm(ks[2], (DEPTH, D_MODEL, D_IN), D_MODEL ** -0.5),
        "conv_w": nrm(ks[3], (DEPTH, CONV_WIDTH, D_RNN), CONV_WIDTH ** -0.5),
        "conv_b": nrm(ks[4], (DEPTH, D_RNN), 0.02),
        "lru_w_a": nrm(ks[5], (DEPTH, RNN_HEADS, RNN_HEAD_DIM, RNN_HEAD_DIM), RNN_HEAD_DIM ** -0.5),
        "lru_b_a": nrm(ks[6], (DEPTH, RNN_HEADS, RNN_HEAD_DIM), 0.02),
        "lru_w_x": nrm(ks[8], (DEPTH, RNN_HEADS, RNN_HEAD_DIM, RNN_HEAD_DIM), RNN_HEAD_DIM ** -0.5),
        "lru_b_x": nrm(ks[9], (DEPTH, RNN_HEADS, RNN_HEAD_DIM), 0.02),
        "lru_lambda": lru_lambda,
        "sgu_ln_g": 1.0 + nrm(ks[10], (DEPTH, D_SGU), 0.02),
        "sgu_ln_b": nrm(ks[11], (DEPTH, D_SGU), 0.02),
        "sgu_w_s": nrm(ks[12], (DEPTH, SGU_GROUPS, SGU_BLOCK, SGU_BLOCK), SGU_BLOCK ** -0.5),
        "sgu_b_s": 1.0 + nrm(ks[13], (DEPTH, SGU_GROUPS, SGU_BLOCK), 0.02),
        "w_branch_a": nrm(ks[14], (DEPTH, D_RNN, D_MODEL), D_RNN ** -0.5),
        "w_branch_b": nrm(ks[15], (DEPTH, D_SGU, D_MODEL), D_SGU ** -0.5),
        "w_out": nrm(ks[16], (DEPTH, D_MODEL, D_MODEL), D_MODEL ** -0.5),
        "norm_ffn_g": 1.0 + nrm(ks[17], (DEPTH, D_MODEL), 0.02),
        "w_up": nrm(ks[18], (DEPTH, D_MODEL, D_FF), D_MODEL ** -0.5),
        "w_down": nrm(ks[19], (DEPTH, D_FF, D_MODEL), D_FF ** -0.5),
        "final_norm_g": 1.0 + nrm(ks[20], (D_MODEL,), 0.02),
    }


def reference(x, norm_mix_g, w_in, conv_w, conv_b, lru_w_a, lru_b_a, lru_w_x, lru_b_x,
              lru_lambda, sgu_ln_g, sgu_ln_b, sgu_w_s, sgu_b_s, w_branch_a, w_branch_b,
              w_out, norm_ffn_g, w_up, w_down, final_norm_g):
    for l in range(DEPTH):
        x = hybrid_layer(x, norm_mix_g[l], w_in[l], conv_w[l], conv_b[l], lru_w_a[l], lru_b_a[l],
                         lru_w_x[l], lru_b_x[l], lru_lambda[l], sgu_ln_g[l], sgu_ln_b[l],
                         sgu_w_s[l], sgu_b_s[l], w_branch_a[l], w_branch_b[l], w_out[l],
                         norm_ffn_g[l], w_up[l], w_down[l])
    return rmsnorm(x, final_norm_g)
```

```cpp
#include <hip/hip_runtime.h>
#include <hip/hip_cooperative_groups.h>
#include <cstdio>
#include <cstdint>
namespace cg = cooperative_groups;
namespace pg8 {
#define PG8_LAS __attribute__((address_space(3)))
typedef unsigned short bf16_t;
typedef short bf16x8 __attribute__((ext_vector_type(8)));
typedef float f32x4 __attribute__((ext_vector_type(4)));
typedef unsigned u32x4 __attribute__((ext_vector_type(4)));
typedef unsigned u32x2 __attribute__((ext_vector_type(2)));
constexpr int BM = 256, BK = 64, HALF = 128, HTB = HALF * BK * 2, STAGE_BYTES = 8 * HTB, NXCD = 8, WGM = 8;
__host__ __device__ __forceinline__ int lds_byte(int r, int c) { const int st = (r >> 4) * 2 + (c >> 5), rr = r & 15, cc = c & 31, ob = rr * 64 + cc * 2; return st * 1024 + (ob ^ (((ob >> 9) & 1) << 5)); }
__host__ __device__ __forceinline__ void stage_rc(int b, int& R, int& C) { const int st = b / 1024, sb = b % 1024, swz = sb ^ (((sb >> 9) & 1) << 5); R = (st >> 1) * 16 + swz / 64; C = (st & 1) * 32 + (swz % 64) / 2; }
__host__ __device__ __forceinline__ int perm32(int rho) { const int n = rho >> 4, i = rho & 15; return 8 * (i >> 2) + 4 * n + (i & 3); }
struct Unit { int pm, pn; };
struct Gemm { const bf16_t* A; const bf16_t* Bt; int M, N, K; };
struct StaticOrder {
    int nM, nN, nwg, G, c;
    __host__ __device__ void init(int M, int N, int G_, int c_) { nM = M / BM; nN = N / BM; nwg = nM * nN; G = G_; c = c_; }
    __host__ __device__ bool next(int i, Unit& u) const {
        const long L = (long)i * G + c; if (L >= nwg) return false;
        int wgid = (int)L; { const int q = nwg / NXCD, r = nwg % NXCD, xcd = wgid % NXCD, off = wgid / NXCD; wgid = (xcd < r ? xcd * (q + 1) : r * (q + 1) + (xcd - r) * q) + off; }
        const int nig = WGM * nN, gid = wgid / nig, fm = gid * WGM, gsz = (nM - fm) < WGM ? (nM - fm) : WGM;
        u.pm = fm + ((wgid % nig) % gsz); u.pn = (wgid % nig) / gsz; return true;
    }
    __device__ __forceinline__ void a_ready(const Unit&) const {}
    __device__ __forceinline__ void done(const Unit&) const {}
};

constexpr float RMS_EPS = 1e-6f;
__device__ __forceinline__ unsigned cvt_pk_bf16(float lo, float hi) { unsigned r; asm volatile("v_cvt_pk_bf16_f32 %0, %1, %2" : "=v"(r) : "v"(lo), "v"(hi)); return r; }
__device__ __forceinline__ float bf_lo(unsigned w) { return __uint_as_float(w << 16); }
__device__ __forceinline__ float bf_hi(unsigned w) { return __uint_as_float(w & 0xffff0000u); }
__device__ __forceinline__ float sigm(float x) { return __builtin_amdgcn_rcpf(1.0f + __builtin_amdgcn_exp2f(-1.44269504f * x)); }
__device__ __forceinline__ float gelu_t(float x) { const float z = x * (1.5957691216f + 0.0713548163f * x * x); return x * __builtin_amdgcn_rcpf(1.0f + __builtin_amdgcn_exp2f(-1.44269504f * z)); }
constexpr float FIX_SSQ = 4096.0f, FIX_V = 65536.0f;
__device__ __forceinline__ float unfix(float slot, float scale) { return (float)(int)__float_as_uint(slot) * (1.0f / scale); }
__device__ __forceinline__ float tofix(float v, float scale) { return __uint_as_float((unsigned)(int)__builtin_rintf(v * scale)); }
__device__ __forceinline__ float rstd_of(float ssq) { return __builtin_amdgcn_rsqf(unfix(ssq, FIX_SSQ) * (1.0f / 1024.0f) + RMS_EPS); }
__device__ __forceinline__ void fadd_fix(float* p, float v, float scale) { (void)__hip_atomic_fetch_add((unsigned*)p, (unsigned)(int)__builtin_rintf(v * scale), __ATOMIC_RELAXED, __HIP_MEMORY_SCOPE_AGENT); }

struct EpiIn {
    static constexpr bool PERM = true, AFTER_DRAIN = false;
    bf16_t* XR; bf16_t* GR; bf16_t* U; bf16_t* V; const float* ssq; float* vsum; float* vsq;
    __device__ __forceinline__ void operator()(const f32x4 (&acc)[2][2][4][2], const Unit& u, int wr, int wc, int fr, int fq) const {
        const int pn = u.pn; bf16_t* base; int ldc, colt, act;
        if (pn < 5) { base = XR; ldc = 1280; colt = pn * 256; act = 0; }
        else if (pn < 10) { base = GR; ldc = 1280; colt = (pn - 5) * 256; act = 1; }
        else if (pn < 14) { base = U; ldc = 1024; colt = (pn - 10) * 256; act = 1; }
        else { base = V; ldc = 1024; colt = (pn - 14) * 256; act = 2; }
        const int row0 = u.pm * BM + wr * 64 + fr, col0 = colt + wc * 32 + 8 * fq;
#pragma unroll
        for (int ai = 0; ai < 2; ++ai)
#pragma unroll
            for (int m = 0; m < 4; ++m) {
                const int row = row0 + ai * HALF + m * 16; const float rs = rstd_of(ssq[row]);
                bf16_t* rowp = base + (size_t)row * ldc + col0; float s1 = 0.f, s2 = 0.f;
#pragma unroll
                for (int bj = 0; bj < 2; ++bj) { f32x4 v0 = acc[ai][bj][m][0] * rs, v1 = acc[ai][bj][m][1] * rs;
                    if (act) {
#pragma unroll
                        for (int j = 0; j < 4; ++j) { v0[j] = gelu_t(v0[j]); v1[j] = gelu_t(v1[j]); } }
                    if (act == 2) {
#pragma unroll
                        for (int j = 0; j < 4; ++j) { s1 += v0[j] + v1[j]; s2 += v0[j] * v0[j] + v1[j] * v1[j]; } }
                    u32x4 w; w.x = cvt_pk_bf16(v0[0], v0[1]); w.y = cvt_pk_bf16(v0[2], v0[3]); w.z = cvt_pk_bf16(v1[0], v1[1]); w.w = cvt_pk_bf16(v1[2], v1[3]);
                    *(u32x4*)(rowp + bj * HALF) = w; }
                if (act == 2) { s1 += __shfl_xor(s1, 16); s1 += __shfl_xor(s1, 32); s2 += __shfl_xor(s2, 16); s2 += __shfl_xor(s2, 32);
                    if (fq == 0) { fadd_fix(vsum + row, s1, FIX_V); fadd_fix(vsq + row, s2, FIX_V); } }
            }
    }
};
template <int ACT> struct EpiAct {
    static constexpr bool PERM = true, AFTER_DRAIN = false;
    bf16_t* O; int ldc; const float* ssq;
    __device__ __forceinline__ void operator()(const f32x4 (&acc)[2][2][4][2], const Unit& u, int wr, int wc, int fr, int fq) const {
        const int row0 = u.pm * BM + wr * 64 + fr, col0 = u.pn * BM + wc * 32 + 8 * fq;
#pragma unroll
        for (int ai = 0; ai < 2; ++ai)
#pragma unroll
            for (int m = 0; m < 4; ++m) {
                const int row = row0 + ai * HALF + m * 16; const float rs = rstd_of(ssq[row]);
                bf16_t* rowp = O + (size_t)row * ldc + col0;
#pragma unroll
                for (int bj = 0; bj < 2; ++bj) { f32x4 v0 = acc[ai][bj][m][0] * rs, v1 = acc[ai][bj][m][1] * rs;
#pragma unroll
                    for (int j = 0; j < 4; ++j) {
                        if (ACT == 0) { v0[j] = sigm(v0[j]); v1[j] = sigm(v1[j]); }
                        else { const float a = fmaxf(v0[j], 0.f), b = fmaxf(v1[j], 0.f); v0[j] = a * a; v1[j] = b * b; } }
                    u32x4 w; w.x = cvt_pk_bf16(v0[0], v0[1]); w.y = cvt_pk_bf16(v0[2], v0[3]); w.z = cvt_pk_bf16(v1[0], v1[1]); w.w = cvt_pk_bf16(v1[2], v1[3]);
                    *(u32x4*)(rowp + bj * HALF) = w; }
            }
    }
};
template <bool ADD> struct EpiMix {
    static constexpr bool PERM = true, AFTER_DRAIN = false;
    bf16_t* O; const bf16_t* Gt;
    __device__ __forceinline__ void operator()(const f32x4 (&acc)[2][2][4][2], const Unit& u, int wr, int wc, int fr, int fq) const {
        const int row0 = u.pm * BM + wr * 64 + fr, col0 = u.pn * BM + wc * 32 + 8 * fq;
#pragma unroll
        for (int ai = 0; ai < 2; ++ai)
#pragma unroll
            for (int m = 0; m < 4; ++m) {
                const size_t off = (size_t)(row0 + ai * HALF + m * 16) * 1024 + col0;
#pragma unroll
                for (int bj = 0; bj < 2; ++bj)
#pragma unroll
                    for (int n = 0; n < 2; ++n) { const f32x4 a = acc[ai][bj][m][n];
                        const u32x2 gw = *(const u32x2*)(Gt + off + bj * HALF + 4 * n);
                        f32x4 v; v[0] = bf_lo(gw.x) * a[0]; v[1] = bf_hi(gw.x) * a[1]; v[2] = bf_lo(gw.y) * a[2]; v[3] = bf_hi(gw.y) * a[3];
                        if (ADD) { const u32x2 tw = *(const u32x2*)(O + off + bj * HALF + 4 * n); v[0] += bf_lo(tw.x); v[1] += bf_hi(tw.x); v[2] += bf_lo(tw.y); v[3] += bf_hi(tw.y); }
                        u32x2 w; w.x = cvt_pk_bf16(v[0], v[1]); w.y = cvt_pk_bf16(v[2], v[3]);
                        *(u32x2*)(O + off + bj * HALF + 4 * n) = w; }
                asm volatile("" ::: "memory");
            }
    }
};
struct EpiRes {
    static constexpr bool PERM = false, AFTER_DRAIN = false;
    const float* xin; float* xout; bf16_t* xb; float* ssq_out;
    __device__ __forceinline__ void operator()(const f32x4 (&acc)[2][2][4][2], const Unit& u, int wr, int wc, int fr, int fq) const {
        const int row0 = u.pm * BM + wr * 64 + fr, col0 = u.pn * BM + wc * 32 + 4 * fq;
#pragma unroll
        for (int ai = 0; ai < 2; ++ai)
#pragma unroll
            for (int m = 0; m < 4; ++m) {
                const int row = row0 + ai * HALF + m * 16; const size_t off = (size_t)row * 1024 + col0; float s = 0.f;
#pragma unroll
                for (int bj = 0; bj < 2; ++bj)
#pragma unroll
                    for (int n = 0; n < 2; ++n) { const f32x4 x = *(const f32x4*)(xin + off + bj * HALF + n * 16) + acc[ai][bj][m][n];
                        *(f32x4*)(xout + off + bj * HALF + n * 16) = x;
                        u32x2 w; w.x = cvt_pk_bf16(x[0], x[1]); w.y = cvt_pk_bf16(x[2], x[3]); *(u32x2*)(xb + off + bj * HALF + n * 16) = w;
                        s += (x[0] * x[0] + x[1] * x[1]) + (x[2] * x[2] + x[3] * x[3]); }
                s += __shfl_xor(s, 16); s += __shfl_xor(s, 32);
                if (fq == 0) fadd_fix(ssq_out + row, s, FIX_SSQ);
                asm volatile("" ::: "memory");
            }
    }
};
template <class Epi, class Sched, bool ALIGN_EPI = false, bool SP2 = false>
__device__ __forceinline__ void gemm_phase(PG8_LAS unsigned char* lds, const Gemm g, const Sched& S, const Epi& E, const int tid) {
    const int wid = __builtin_amdgcn_readfirstlane(tid >> 6), lane = tid & 63, wr = wid >> 2, wc = wid & 3, fr = lane & 15, fq = lane >> 4;
    const int K = g.K, nt = K / BK;
    unsigned voffA[2], voffB[2];
#pragma unroll
    for (int i = 0; i < 2; ++i) { int R, C; stage_rc(tid * 16 + i * 8192, R, C); const int Rb = Epi::PERM ? ((R & ~31) + perm32(R & 31)) : R;
        voffA[i] = (unsigned)(R * K + C) * 2u; voffB[i] = (unsigned)(Rb * K + C) * 2u; }
    const size_t kstep = (size_t)(BK * 2);
    const size_t hstep = (size_t)HALF * K * 2;
    const size_t tstep = 2 * hstep;
    const unsigned ldsw = (unsigned)wid * 1024u;
    const int aoff = lds_byte(wr * 64 + fr, fq * 8), boff = lds_byte(wc * 32 + fr, fq * 8);
#define PG8_SA(b, h) (((b) * 2 + (h)) * HTB)
#define PG8_SB(b, h) ((4 + (b) * 2 + (h)) * HTB)
#define PG8_STAGE(bufoff, gbase, voff) do { _Pragma("unroll") for (int _i = 0; _i < 2; ++_i) \
        __builtin_amdgcn_global_load_lds((const unsigned*)((const char*)(gbase) + (voff)[_i]), (PG8_LAS unsigned*)(lds + (bufoff) + ldsw + _i * 8192), 16, 0, 0); } while (0)
#define PG8_LDA(dst, b, h) do { _Pragma("unroll") for (int m = 0; m < 4; ++m) _Pragma("unroll") for (int k = 0; k < 2; ++k) dst[m][k] = *(const PG8_LAS bf16x8*)(lds + PG8_SA(b, h) + aoff + m * 2048 + k * 1024); } while (0)
#define PG8_LDB(dst, b, h) do { _Pragma("unroll") for (int n = 0; n < 2; ++n) _Pragma("unroll") for (int k = 0; k < 2; ++k) dst[n][k] = *(const PG8_LAS bf16x8*)(lds + PG8_SB(b, h) + boff + n * 2048 + k * 1024); } while (0)
#define PG8_MMA(ai, bj, At, Bt) do { __builtin_amdgcn_s_setprio(1); _Pragma("unroll") for (int m = 0; m < 4; ++m) _Pragma("unroll") for (int n = 0; n < 2; ++n) _Pragma("unroll") for (int k = 0; k < 2; ++k) \
        acc[ai][bj][m][n] = __builtin_amdgcn_mfma_f32_16x16x32_bf16(Bt[n][k], At[m][k], acc[ai][bj][m][n], 0, 0, 0); __builtin_amdgcn_s_setprio(0); } while (0)
#define PG8_WAIT_V(n) asm volatile("s_waitcnt vmcnt(" #n ")" ::: "memory")
#define PG8_WAIT_L(n) asm volatile("s_waitcnt lgkmcnt(" #n ")" ::: "memory")
#define PG8_BAR __builtin_amdgcn_s_barrier()
#define PG8_SCHED __builtin_amdgcn_sched_barrier(0)
    Unit cur, nxt; int ui = 0;
    if (!S.next(0, cur)) return;
    f32x4 acc[2][2][4][2];
#pragma unroll
    for (int a = 0; a < 2; ++a)
#pragma unroll
        for (int b = 0; b < 2; ++b)
#pragma unroll
            for (int m = 0; m < 4; ++m)
#pragma unroll
                for (int n = 0; n < 2; ++n) acc[a][b][m][n] = (f32x4){0.f, 0.f, 0.f, 0.f};
    bf16x8 At[4][2], B0[2][2], B1[2][2];
    const char* cA = (const char*)g.A + (size_t)cur.pm * tstep; const char* cB = (const char*)g.Bt + (size_t)cur.pn * tstep;
    S.a_ready(cur);
    if constexpr (SP2) {
        PG8_STAGE(PG8_SB(0, 0), cB, voffB); PG8_STAGE(PG8_SB(0, 1), cB + hstep, voffB); PG8_STAGE(PG8_SA(0, 0), cA, voffA); PG8_STAGE(PG8_SA(0, 1), cA + hstep, voffA);
        if (wr == 1) PG8_BAR;
        PG8_WAIT_V(2); PG8_BAR;
        PG8_STAGE(PG8_SB(1, 0), cB + kstep, voffB); PG8_STAGE(PG8_SA(1, 0), cA + kstep, voffA); PG8_STAGE(PG8_SB(1, 1), cB + hstep + kstep, voffB);
        PG8_WAIT_V(6); PG8_BAR;
    } else {
        PG8_STAGE(PG8_SB(0, 0), cB, voffB); PG8_STAGE(PG8_SA(0, 0), cA, voffA); PG8_STAGE(PG8_SB(0, 1), cB + hstep, voffB); PG8_STAGE(PG8_SA(0, 1), cA + hstep, voffA);
        if (wr == 1) PG8_BAR;
        PG8_WAIT_V(4); PG8_BAR;
        PG8_STAGE(PG8_SB(1, 0), cB + kstep, voffB); PG8_STAGE(PG8_SA(1, 0), cA + kstep, voffA); PG8_STAGE(PG8_SB(1, 1), cB + hstep + kstep, voffB);
        PG8_WAIT_V(6); PG8_BAR;
    }
    for (;;) {
        const bool has_next = S.next(ui + 1, nxt);
        const char* nA = has_next ? (const char*)g.A + (size_t)nxt.pm * tstep : cA; const char* nB = has_next ? (const char*)g.Bt + (size_t)nxt.pn * tstep : cB;
        for (int t = 0; t < nt; t += 2) {
            const bool last = (t == nt - 2);
            const char* a1 = cA + (size_t)(t + 1) * kstep;
            const char* a2 = last ? nA : cA + (size_t)(t + 2) * kstep; const char* b2 = last ? nB : cB + (size_t)(t + 2) * kstep;
            const char* a3 = a2 + kstep; const char* b3 = b2 + kstep;
            if (last && has_next) S.a_ready(nxt);
            if constexpr (SP2) {
            PG8_LDB(B0, 0, 0); PG8_LDB(B1, 0, 1); PG8_SCHED; PG8_LDA(At, 0, 0); PG8_STAGE(PG8_SA(1, 1), a1 + hstep, voffA);
            PG8_WAIT_V(8); PG8_WAIT_L(0); PG8_BAR; PG8_MMA(0, 0, At, B0); PG8_MMA(0, 1, At, B1); PG8_BAR; PG8_SCHED;
            PG8_LDA(At, 0, 1); PG8_STAGE(PG8_SB(0, 0), b2, voffB); PG8_STAGE(PG8_SB(0, 1), b2 + hstep, voffB); PG8_STAGE(PG8_SA(0, 0), a2, voffA);
            PG8_WAIT_V(8); PG8_WAIT_L(0); PG8_BAR; PG8_MMA(1, 0, At, B0); PG8_MMA(1, 1, At, B1); PG8_BAR; PG8_SCHED;
            PG8_LDB(B0, 1, 0); PG8_LDB(B1, 1, 1); PG8_SCHED; PG8_LDA(At, 1, 0); PG8_STAGE(PG8_SA(0, 1), a2 + hstep, voffA);
            PG8_WAIT_V(8); PG8_WAIT_L(0); PG8_BAR; PG8_MMA(0, 0, At, B0); PG8_MMA(0, 1, At, B1); PG8_BAR; PG8_SCHED;
            PG8_LDA(At, 1, 1); PG8_STAGE(PG8_SB(1, 0), b3, voffB); PG8_STAGE(PG8_SB(1, 1), b3 + hstep, voffB); PG8_STAGE(PG8_SA(1, 0), a3, voffA);
            PG8_WAIT_V(8); PG8_WAIT_L(0); PG8_BAR; PG8_MMA(1, 0, At, B0); PG8_MMA(1, 1, At, B1); PG8_BAR; PG8_SCHED;
            } else {
            PG8_LDB(B0, 0, 0); PG8_SCHED; PG8_LDA(At, 0, 0); PG8_STAGE(PG8_SA(1, 1), a1 + hstep, voffA);
            PG8_WAIT_L(8); PG8_BAR; PG8_WAIT_L(0); PG8_MMA(0, 0, At, B0); PG8_BAR; PG8_SCHED;
            PG8_LDB(B1, 0, 1); PG8_STAGE(PG8_SB(0, 0), b2, voffB);
            PG8_BAR; PG8_WAIT_L(0); PG8_MMA(0, 1, At, B1); PG8_BAR;
            PG8_LDA(At, 0, 1); PG8_STAGE(PG8_SA(0, 0), a2, voffA);
            PG8_BAR; PG8_WAIT_L(0); PG8_MMA(1, 0, At, B0); PG8_BAR; PG8_SCHED;
            PG8_STAGE(PG8_SB(0, 1), b2 + hstep, voffB);
            PG8_WAIT_V(6); PG8_BAR; PG8_MMA(1, 1, At, B1); PG8_BAR;
            PG8_LDB(B0, 1, 0); PG8_SCHED; PG8_LDA(At, 1, 0); PG8_STAGE(PG8_SA(0, 1), a2 + hstep, voffA);
            PG8_WAIT_L(8); PG8_BAR; PG8_WAIT_L(0); PG8_MMA(0, 0, At, B0); PG8_BAR; PG8_SCHED;
            PG8_LDB(B1, 1, 1); PG8_STAGE(PG8_SB(1, 0), b3, voffB);
            PG8_BAR; PG8_WAIT_L(0); PG8_MMA(0, 1, At, B1); PG8_BAR;
            PG8_LDA(At, 1, 1); PG8_STAGE(PG8_SA(1, 0), a3, voffA);
            PG8_BAR; PG8_WAIT_L(0); PG8_MMA(1, 0, At, B0); PG8_BAR; PG8_SCHED;
            PG8_STAGE(PG8_SB(1, 1), b3 + hstep, voffB);
            PG8_WAIT_V(6); PG8_BAR; PG8_MMA(1, 1, At, B1); PG8_BAR;
            }
        }
        if constexpr (ALIGN_EPI) { if (wr == 0) PG8_BAR; }
        if constexpr (!Epi::AFTER_DRAIN) { E(acc, cur, wr, wc, fr, fq); S.done(cur); }
        if (!has_next) break;
#pragma unroll
        for (int a = 0; a < 2; ++a)
#pragma unroll
            for (int b = 0; b < 2; ++b)
#pragma unroll
                for (int m = 0; m < 4; ++m)
#pragma unroll
                    for (int n = 0; n < 2; ++n) acc[a][b][m][n] = (f32x4){0.f, 0.f, 0.f, 0.f};
        cur = nxt; cA = nA; cB = nB; ++ui;
        if constexpr (ALIGN_EPI) { if (wr == 1) PG8_BAR; }
    }
    PG8_WAIT_V(0);
    if constexpr (!ALIGN_EPI) { if (wr == 0) PG8_BAR; }
    PG8_BAR;
    if constexpr (Epi::AFTER_DRAIN) { E.fused(acc, cur, wr, wc, fr, fq, lds, wid, lane); S.done(cur); }
#undef PG8_SA
#undef PG8_SB
#undef PG8_STAGE
#undef PG8_LDA
#undef PG8_LDB
#undef PG8_MMA
#undef PG8_WAIT_V
#undef PG8_WAIT_L
#undef PG8_BAR
#undef PG8_SCHED
}
}
constexpr int BATCH = 4, SEQ = 4096, D = 1024, DRNN = 1280, NH = 20, FF = 4096, DEPTH = 2;
constexpr int M = BATCH * SEQ;
constexpr int DIN = 6656, NP1 = 4608;
constexpr int NSEG = 64;
constexpr int NWAVES = 8;
constexpr size_t KiB = 1024, MiB = 1u << 20;
constexpr size_t WS_SSQ = 0;
constexpr size_t WS_VST = 320 * KiB;
constexpr size_t WS_BAR = 640 * KiB;
constexpr size_t WS_ATOT = 1 * MiB, WS_HEND = 1 * MiB + 1280 * KiB;
constexpr size_t WS_W = 4 * MiB, W_LAYER = 37 * MiB;
constexpr size_t W_IN = 0, W_G = 9 * MiB, W_A = 13 * MiB, W_B = 15 * MiB + 512 * KiB, W_O = 17 * MiB + 512 * KiB, W_UP = 19 * MiB + 512 * KiB, W_DN = 27 * MiB + 512 * KiB,
                 W_L = 35 * MiB + 512 * KiB, W_S = 36 * MiB;
constexpr size_t WS_XB = 78 * MiB;
constexpr size_t WS_XR = 110 * MiB, WS_GR = 150 * MiB, WS_U = 190 * MiB, WS_V = 222 * MiB, WS_END = 254 * MiB;
constexpr size_t WS_F = 110 * MiB;
constexpr size_t WS_S1 = WS_V, WS_S2 = WS_XR;
static_assert(WS_HEND + 1280 * KiB <= WS_W && WS_W + 2 * W_LAYER <= WS_XB && WS_XB + (size_t)M * D * 2 <= WS_XR && WS_F + (size_t)M * FF * 2 <= WS_END, "d_ws map");
static_assert(W_S + 8 * 128 * 128 * 2 <= W_LAYER && W_L + 2 * 20 * 64 * 64 * 2 <= W_S, "weight map");
constexpr int LDS_BYTES = 147456;
constexpr int NPHASE = 16;

#define LAS __attribute__((address_space(3)))
typedef unsigned short bf16;
typedef float f32x4 __attribute__((ext_vector_type(4)));
typedef short bf16x8 __attribute__((ext_vector_type(8)));
typedef unsigned u32x4 __attribute__((ext_vector_type(4)));
typedef unsigned u32x2 __attribute__((ext_vector_type(2)));
#define LDS_WAIT() asm volatile("s_waitcnt lgkmcnt(0)" ::: "memory")
using pg8::cvt_pk_bf16; using pg8::bf_lo; using pg8::bf_hi; using pg8::sigm;

__device__ __forceinline__ float wave_sum(float v) {
#pragma unroll
    for (int o = 1; o < 64; o <<= 1) v += __shfl_xor(v, o);
    return v;
}
__device__ __forceinline__ void p0_transpose_item(const float* W, int ldw, int K, int nblk, bf16* WT, const float* ksc, LAS float* scr, int item, int lane) {
    const int kb = item / nblk, nb = item % nblk, k0 = 64 * kb, n0 = 32 * nb;
#pragma unroll 8
    for (int i = 0; i < 32; ++i) { const int kk = 2 * i + (lane >> 5); float v = W[(size_t)(k0 + kk) * ldw + n0 + (lane & 31)]; if (ksc) v *= ksc[k0 + kk]; scr[kk * 33 + (lane & 31)] = v; }
    LDS_WAIT(); asm volatile("" ::: "memory");
    const int c = lane & 7;
#pragma unroll
    for (int j = 0; j < 4; ++j) { const int n = (lane >> 3) + 8 * j; const LAS float* s = scr + (8 * c) * 33 + n;
        u32x4 o; o.x = cvt_pk_bf16(s[0 * 33], s[1 * 33]); o.y = cvt_pk_bf16(s[2 * 33], s[3 * 33]); o.z = cvt_pk_bf16(s[4 * 33], s[5 * 33]); o.w = cvt_pk_bf16(s[6 * 33], s[7 * 33]);
        *(u32x4*)(WT + (size_t)(n0 + n) * K + k0 + 8 * c) = o; }
    LDS_WAIT(); asm volatile("" ::: "memory");
}

struct Args { const float* in[21]; float* out; unsigned char* ws; int ph_lo, ph_hi; };
enum { I_X = 0, I_NMG, I_WIN, I_CW, I_CB, I_LWA, I_LBA, I_LWX, I_LBX, I_LAM, I_LNG, I_LNB, I_WS, I_BS, I_WA, I_WB, I_WO, I_NFG, I_WUP, I_WDN, I_FNG };

typedef const unsigned char __attribute__((address_space(4)))* kptr_t;
#define AIN(kp, i) (*(const float* const __attribute__((address_space(4)))*)((kp) + 8 * (i)))
__device__ __forceinline__ void p0_prologue(kptr_t kp, unsigned char* ws, LAS unsigned char* lds, int gw, int NGW, int wave, int lane) {
    LAS float* scr = (LAS float*)(lds + wave * 16384);
    constexpr int J0 = 16 * 144, J1 = 16 * 64, J2 = 20 * 32, J3 = 16 * 32, J4 = 16 * 32, J5 = 16 * 128, J6 = 64 * 32, JL = J0 + J1 + J2 + J3 + J4 + J5 + J6;
    for (int it = gw; it < DEPTH * JL; it += NGW) {
        const int l = it / JL; int r = it % JL; unsigned char* wl = ws + WS_W + (size_t)l * W_LAYER;
        if (r < J0) { p0_transpose_item(AIN(kp, I_WIN) + (size_t)l * D * DIN, DIN, D, NP1 / 32, (bf16*)(wl + W_IN), AIN(kp, I_NMG) + l * D, scr, r, lane); continue; } r -= J0;
        if (r < J1) { p0_transpose_item(AIN(kp, I_WIN) + (size_t)l * D * DIN + NP1, DIN, D, 2048 / 32, (bf16*)(wl + W_G), AIN(kp, I_NMG) + l * D, scr, r, lane); continue; } r -= J1;
        if (r < J2) { p0_transpose_item(AIN(kp, I_WA) + (size_t)l * DRNN * D, D, DRNN, D / 32, (bf16*)(wl + W_A), nullptr, scr, r, lane); continue; } r -= J2;
        if (r < J3) { p0_transpose_item(AIN(kp, I_WB) + (size_t)l * D * D, D, D, D / 32, (bf16*)(wl + W_B), nullptr, scr, r, lane); continue; } r -= J3;
        if (r < J4) { p0_transpose_item(AIN(kp, I_WO) + (size_t)l * D * D, D, D, D / 32, (bf16*)(wl + W_O), nullptr, scr, r, lane); continue; } r -= J4;
        if (r < J5) { p0_transpose_item(AIN(kp, I_WUP) + (size_t)l * D * FF, FF, D, FF / 32, (bf16*)(wl + W_UP), AIN(kp, I_NFG) + l * D, scr, r, lane); continue; } r -= J5;
        p0_transpose_item(AIN(kp, I_WDN) + (size_t)l * FF * D, D, FF, D / 32, (bf16*)(wl + W_DN), nullptr, scr, r, lane);
    }
    const int gt = gw * 64 + lane, NGT = NGW * 64;
    for (int e = gt; e < DEPTH * 2 * NH * 64 * 64; e += NGT) {
        const int i = e & 63, j = (e >> 6) & 63, h = (e >> 12) % NH, g = ((e >> 12) / NH) & 1, l = (e >> 12) / (2 * NH);
        const float v = AIN(kp, g ? I_LWX : I_LWA)[(((size_t)l * NH + h) * 64 + i) * 64 + j];
        ((bf16*)(ws + WS_W + (size_t)l * W_LAYER + W_L))[(((size_t)g * NH + h) * 64 + j) * 64 + i] = (bf16)(cvt_pk_bf16(v, 0.f) & 0xffffu);
    }
    for (int e = gt; e < DEPTH * 8 * 128 * 128; e += NGT) {
        const int s = e & 127, t = (e >> 7) & 127, l = e >> 17;
        float v = AIN(kp, I_WS)[e]; if ((t >> 6) < (s >> 6)) v = 0.f;
        ((bf16*)(ws + WS_W + (size_t)l * W_LAYER + W_S))[e & 131071] = (bf16)(cvt_pk_bf16(v, 0.f) & 0xffffu);
    }
    { float* z = (float*)(ws + WS_SSQ) + M; for (int e = gt; e < 8 * M; e += NGT) z[e] = 0.f; }
    for (int m = gw; m < M; m += NGW) {
        const f32x4* xr = (const f32x4*)(AIN(kp, I_X) + (size_t)m * D) + lane; u32x2* o = (u32x2*)((bf16*)(ws + WS_XB) + (size_t)m * D) + lane; float s = 0.f;
#pragma unroll
        for (int j = 0; j < 4; ++j) { const f32x4 v = xr[64 * j]; s += (v.x * v.x + v.y * v.y) + (v.z * v.z + v.w * v.w); u32x2 w; w.x = cvt_pk_bf16(v.x, v.y); w.y = cvt_pk_bf16(v.z, v.w); o[64 * j] = w; }
        s = wave_sum(s); if (lane == 0) ((float*)(ws + WS_SSQ))[m] = pg8::tofix(s, pg8::FIX_SSQ);
    }
}

struct SguP { const bf16* V; bf16* U; const bf16* Ws; const float* bs; const float* lng; const float* lnb; const float* vsum; const float* vsq; };
constexpr int VT_LD = 136;
__device__ __forceinline__ void sgu_item(const SguP& P, LAS bf16* Vt, int b, int blk, int g, int tid, int wave, int lane) {
    const int r0 = b * SEQ + blk * 128, c0 = g * 128;
#pragma unroll
    for (int i = 0; i < 4; ++i) {
        const int chunk = tid + 512 * i, s = chunk >> 4, cc = (chunk & 15) * 8, row = r0 + s;
        const float mu = pg8::unfix(P.vsum[row], pg8::FIX_V) * (1.0f / 1024.0f), var = fmaxf(pg8::unfix(P.vsq[row], pg8::FIX_V) * (1.0f / 1024.0f) - mu * mu, 0.f), rstd = __builtin_amdgcn_rsqf(var + 1e-6f);
        const u32x4 v = *(const u32x4*)(P.V + (size_t)row * 1024 + c0 + cc);
        const f32x4 g0 = *(const f32x4*)(P.lng + c0 + cc), g1 = *(const f32x4*)(P.lng + c0 + cc + 4), b0 = *(const f32x4*)(P.lnb + c0 + cc), b1 = *(const f32x4*)(P.lnb + c0 + cc + 4);
        float y[8];
        y[0] = (bf_lo(v.x) - mu) * rstd * g0[0] + b0[0]; y[1] = (bf_hi(v.x) - mu) * rstd * g0[1] + b0[1]; y[2] = (bf_lo(v.y) - mu) * rstd * g0[2] + b0[2]; y[3] = (bf_hi(v.y) - mu) * rstd * g0[3] + b0[3];
        y[4] = (bf_lo(v.z) - mu) * rstd * g1[0] + b1[0]; y[5] = (bf_hi(v.z) - mu) * rstd * g1[1] + b1[1]; y[6] = (bf_lo(v.w) - mu) * rstd * g1[2] + b1[2]; y[7] = (bf_hi(v.w) - mu) * rstd * g1[3] + b1[3];
#pragma unroll
        for (int e = 0; e < 8; e += 2) { const unsigned w = cvt_pk_bf16(y[e], y[e + 1]); Vt[(cc + e) * VT_LD + s] = (bf16)(w & 0xffffu); Vt[(cc + e + 1) * VT_LD + s] = (bf16)(w >> 16); }
    }
    __syncthreads();
    const int n = lane & 15, q = lane >> 4;
    bf16x8 Bv[4];
#pragma unroll
    for (int kk = 0; kk < 4; ++kk) Bv[kk] = *(const LAS bf16x8*)(Vt + (16 * wave + n) * VT_LD + 32 * kk + 8 * q);
    const bf16* Wg = P.Ws + (size_t)g * 128 * 128;
#pragma unroll
    for (int tt = 0; tt < 8; ++tt) {
        f32x4 d = (f32x4){0.f, 0.f, 0.f, 0.f};
#pragma unroll
        for (int kk = 0; kk < 4; ++kk) { if (tt < 4 && kk >= 2) continue;
            const bf16x8 Aw = *(const bf16x8*)(Wg + (size_t)(16 * tt + n) * 128 + 32 * kk + 8 * q);
            d = __builtin_amdgcn_mfma_f32_16x16x32_bf16(Bv[kk], Aw, d, 0, 0, 0); }
        const int t = 16 * tt + n; const float bias = P.bs[g * 128 + t];
        u32x2* up = (u32x2*)(P.U + (size_t)(r0 + t) * 1024 + c0 + 16 * wave + 4 * q); const u32x2 uw = *up;
        u32x2 o; o.x = cvt_pk_bf16(bf_lo(uw.x) * (d[0] + bias), bf_hi(uw.x) * (d[1] + bias)); o.y = cvt_pk_bf16(bf_lo(uw.y) * (d[2] + bias), bf_hi(uw.y) * (d[3] + bias));
        *up = o;
    }
    __syncthreads();
}

struct RnnP { const bf16* XR; bf16* GY; const bf16* WL; const float* cw; const float* cb; const float* ba; const float* bx; const float* lam; float* Atot; float* Hend; };
constexpr int XL_LD = 68;
__device__ __forceinline__ float softplus_f(float z) { return fmaxf(z, 0.f) + log1pf(__expf(-fabsf(z))); }
__device__ __forceinline__ float neg_expm1(float y) {
    const float p = -y * (1.0f + y * (0.5f + y * (0.16666667f + y * (0.041666668f + y * (0.0083333338f + y * 0.0013888889f)))));
    const float e = 1.0f - __builtin_amdgcn_exp2f(1.44269504f * y);
    return (y > -0.3f) ? p : e;
}
template <bool PASS2>
__device__ __forceinline__ void rnn_item(const RnnP& P, LAS float* xl, int b, int h, int seg, int lane) {
    const int n = lane & 15, q = lane >> 4;
    const int cD = h * 64 + 4 * n;
    bf16x8 Wf[2][4][2];
#pragma unroll
    for (int g = 0; g < 2; ++g)
#pragma unroll
        for (int c = 0; c < 4; ++c)
#pragma unroll
            for (int ks = 0; ks < 2; ++ks) Wf[g][c][ks] = *(const bf16x8*)(P.WL + (((size_t)g * NH + h) * 64 + 4 * n + c) * 64 + 32 * ks + 8 * q);
    const f32x4 ba4 = *(const f32x4*)(P.ba + cD), bx4 = *(const f32x4*)(P.bx + cD), lam4 = *(const f32x4*)(P.lam + cD);
    float sp4[4];
#pragma unroll
    for (int c = 0; c < 4; ++c) sp4[c] = 8.0f * softplus_f(-lam4[c]);
    float hin[4] = {0.f, 0.f, 0.f, 0.f}, atot[4] = {1.f, 1.f, 1.f, 1.f};
    if (PASS2) {
        float A[4] = {1.f, 1.f, 1.f, 1.f}, H[4] = {0.f, 0.f, 0.f, 0.f};
        const int s1 = min(16 * q + 16, seg);
        for (int s = 16 * q; s < s1; ++s) { const size_t o = ((size_t)(b * NSEG + s)) * DRNN + cD; const f32x4 as = *(const f32x4*)(P.Atot + o), hs = *(const f32x4*)(P.Hend + o);
#pragma unroll
            for (int c = 0; c < 4; ++c) { H[c] = as[c] * H[c] + hs[c]; A[c] = as[c] * A[c]; } }
#pragma unroll
        for (int c = 0; c < 4; ++c) {
            float Ap = __shfl_up(A[c], 16), Hp = __shfl_up(H[c], 16); if (q >= 1) { H[c] = A[c] * Hp + H[c]; A[c] = A[c] * Ap; }
            Ap = __shfl_up(A[c], 32); Hp = __shfl_up(H[c], 32); if (q >= 2) { H[c] = A[c] * Hp + H[c]; A[c] = A[c] * Ap; }
            hin[c] = __shfl(H[c], 48 + n);
        }
    }
#pragma unroll 1
    for (int nt = 0; nt < 4; ++nt) {
        asm volatile("" ::: "memory");
        const int t0 = seg * 64 + 16 * nt, tA = t0 + n;
        bf16x8 Xf[2];
#pragma unroll
        for (int ks = 0; ks < 2; ++ks) {
            const int c0 = h * 64 + 32 * ks + 8 * q;
            f32x4 x0 = *(const f32x4*)(P.cb + c0), x1 = *(const f32x4*)(P.cb + c0 + 4);
#pragma unroll
            for (int k = 0; k < 4; ++k) { const int tt = tA - 3 + k;
                if (tt >= 0) { const u32x4 xv = *(const u32x4*)(P.XR + ((size_t)(b * SEQ + tt)) * DRNN + c0);
                    const f32x4 w0 = *(const f32x4*)(P.cw + k * DRNN + c0), w1 = *(const f32x4*)(P.cw + k * DRNN + c0 + 4);
                    x0[0] += bf_lo(xv.x) * w0[0]; x0[1] += bf_hi(xv.x) * w0[1]; x0[2] += bf_lo(xv.y) * w0[2]; x0[3] += bf_hi(xv.y) * w0[3];
                    x1[0] += bf_lo(xv.z) * w1[0]; x1[1] += bf_hi(xv.z) * w1[1]; x1[2] += bf_lo(xv.w) * w1[2]; x1[3] += bf_hi(xv.w) * w1[3]; } }
            *(LAS f32x4*)(xl + n * XL_LD + 32 * ks + 8 * q) = x0; *(LAS f32x4*)(xl + n * XL_LD + 32 * ks + 8 * q + 4) = x1;
            u32x4 w; w.x = cvt_pk_bf16(x0[0], x0[1]); w.y = cvt_pk_bf16(x0[2], x0[3]); w.z = cvt_pk_bf16(x1[0], x1[1]); w.w = cvt_pk_bf16(x1[2], x1[3]);
            Xf[ks] = __builtin_bit_cast(bf16x8, w);
        }
        f32x4 Da[4], Dx[4];
#pragma unroll
        for (int c = 0; c < 4; ++c) {
            Da[c] = __builtin_amdgcn_mfma_f32_16x16x32_bf16(Xf[0], Wf[0][c][0], (f32x4){0.f, 0.f, 0.f, 0.f}, 0, 0, 0); Da[c] = __builtin_amdgcn_mfma_f32_16x16x32_bf16(Xf[1], Wf[0][c][1], Da[c], 0, 0, 0);
            Dx[c] = __builtin_amdgcn_mfma_f32_16x16x32_bf16(Xf[0], Wf[1][c][0], (f32x4){0.f, 0.f, 0.f, 0.f}, 0, 0, 0); Dx[c] = __builtin_amdgcn_mfma_f32_16x16x32_bf16(Xf[1], Wf[1][c][1], Dx[c], 0, 0, 0);
        }
        f32x4 xd[4];
#pragma unroll
        for (int jj = 0; jj < 4; ++jj) xd[jj] = *(const LAS f32x4*)(xl + (4 * q + jj) * XL_LD + 4 * n);
        float hh[4][4];
#pragma unroll
        for (int c = 0; c < 4; ++c) {
            float av[4], uv[4];
#pragma unroll
            for (int jj = 0; jj < 4; ++jj) {
                const float r = sigm(Da[c][jj] + ba4[c]), ig = sigm(Dx[c][jj] + bx4[c]);
                const float la = -r * sp4[c]; av[jj] = __builtin_amdgcn_exp2f(1.44269504f * la);
                uv[jj] = __builtin_amdgcn_sqrtf(neg_expm1(2.0f * la)) * (ig * xd[jj][c]);
            }
            float ac[4], hl[4]; ac[0] = av[0]; hl[0] = uv[0];
#pragma unroll
            for (int jj = 1; jj < 4; ++jj) { hl[jj] = av[jj] * hl[jj - 1] + uv[jj]; ac[jj] = av[jj] * ac[jj - 1]; }
            float Aq = ac[3], Hq = hl[3];
            float Ap = __shfl_up(Aq, 16), Hp = __shfl_up(Hq, 16); if (q >= 1) { Hq = Aq * Hp + Hq; Aq = Aq * Ap; }
            Ap = __shfl_up(Aq, 32); Hp = __shfl_up(Hq, 32); if (q >= 2) { Hq = Aq * Hp + Hq; Aq = Aq * Ap; }
            float Ae = __shfl_up(Aq, 16), He = __shfl_up(Hq, 16); if (q == 0) { Ae = 1.f; He = 0.f; }
            const float cin = He + Ae * hin[c];
#pragma unroll
            for (int jj = 0; jj < 4; ++jj) hh[c][jj] = hl[jj] + ac[jj] * cin;
            const float A3 = __shfl(Aq, 48 + n), H3 = __shfl(Hq, 48 + n);
            hin[c] = H3 + A3 * hin[c]; atot[c] *= A3;
        }
        if (PASS2) {
#pragma unroll
            for (int jj = 0; jj < 4; ++jj) { u32x2* gp = (u32x2*)(P.GY + ((size_t)(b * SEQ + t0 + 4 * q + jj)) * DRNN + cD); const u32x2 gw = *gp;
                u32x2 o; o.x = cvt_pk_bf16(hh[0][jj] * bf_lo(gw.x), hh[1][jj] * bf_hi(gw.x)); o.y = cvt_pk_bf16(hh[2][jj] * bf_lo(gw.y), hh[3][jj] * bf_hi(gw.y)); *gp = o; }
        }
    }
    if (!PASS2 && q == 0) { const size_t o = ((size_t)(b * NSEG + seg)) * DRNN + cD;
        *(f32x4*)(P.Atot + o) = (f32x4){atot[0], atot[1], atot[2], atot[3]}; *(f32x4*)(P.Hend + o) = (f32x4){hin[0], hin[1], hin[2], hin[3]}; }
}
__device__ __forceinline__ float bf2f(bf16 v) { return __uint_as_float(((unsigned)v) << 16); }
__device__ __forceinline__ bf16 f2bf(float f) { return (bf16)(cvt_pk_bf16(f, 0.f) & 0xffffu); }
__device__ __forceinline__ void naive_vstats(const bf16* V, float* st0, float* st1, int gw, int NGW, int lane) {
    for (int m = gw; m < M; m += NGW) { float s = 0.f, s2 = 0.f;
        for (int j = lane; j < 1024; j += 64) { const float v = bf2f(V[(size_t)m * 1024 + j]); s += v; s2 += v * v; }
        s = wave_sum(s); s2 = wave_sum(s2); const float mu = s * (1.f / 1024.f), var = fmaxf(s2 * (1.f / 1024.f) - mu * mu, 0.f);
        if (lane == 0) { st0[m] = mu; st1[m] = 1.0f / sqrtf(var + 1e-6f); } }
}
__device__ __forceinline__ void naive_sgu(const bf16* V, bf16* U, const float* w_s  , const float* bs, const float* lng, const float* lnb, const float* st0, const float* st1, int gt, int NGT) {
    for (size_t idx = gt; idx < (size_t)M * 1024; idx += NGT) {
        const int row = (int)(idx >> 10), col = (int)(idx & 1023), b = row / SEQ, ta = row % SEQ, blk = ta >> 7, t = ta & 127, g = col >> 7;
        const int ns = (t < 64) ? 64 : 128; float acc = 0.f; const float gg = lng[col], bb = lnb[col];
        for (int s = 0; s < ns; ++s) { const int rs_ = b * SEQ + blk * 128 + s; const float y = (bf2f(V[(size_t)rs_ * 1024 + col]) - st0[rs_]) * st1[rs_] * gg + bb; acc += w_s[((size_t)g * 128 + t) * 128 + s] * y; }
        U[idx] = f2bf(bf2f(U[idx]) * (acc + bs[g * 128 + t]));
    }
}
__device__ __forceinline__ void naive_rnn(const bf16* XR, bf16* GY, const float* w_a  , const float* w_x, const float* ba, const float* bx, const float* lam, const float* cw, const float* cb, int gw, int NGW, int lane) {
    for (int it = gw; it < BATCH * NH; it += NGW) { const int b = it / NH, h = it % NH, c = h * 64 + lane;
        const float sp = 8.0f * softplus_f(-lam[c]), bac = ba[c], bxc = bx[c], cbc = cb[c], c0 = cw[c], c1 = cw[DRNN + c], c2 = cw[2 * DRNN + c], c3 = cw[3 * DRNN + c];
        float hst = 0.f, xm1 = 0.f, xm2 = 0.f, xm3 = 0.f;
        for (int t = 0; t < SEQ; ++t) { const size_t o = ((size_t)(b * SEQ + t)) * DRNN + c; const float x0 = bf2f(XR[o]);
            const float xr = cbc + c0 * xm3 + c1 * xm2 + c2 * xm1 + c3 * x0; xm3 = xm2; xm2 = xm1; xm1 = x0;
            float ra = bac, rx = bxc;
            for (int i = 0; i < 64; ++i) { const float xi = __shfl(xr, i); ra += xi * w_a[((size_t)h * 64 + i) * 64 + lane]; rx += xi * w_x[((size_t)h * 64 + i) * 64 + lane]; }
            const float r = 1.0f / (1.0f + __expf(-ra)), ig = 1.0f / (1.0f + __expf(-rx)), la = -r * sp, a = __expf(la), nm = sqrtf(fmaxf(-expm1f(2.0f * la), 0.f));
            hst = a * hst + nm * (ig * xr);
            GY[o] = f2bf(hst * bf2f(GY[o])); }
    }
}
#define XB_TMO      128
#define XB_XCNT(j)  (256  + 64 * (j))
#define XB_XSUB(j)  (1280 + 64 * (j))
#define XB_XGEN(j)  (2304 + 64 * (j))
#define XB_TOP      3328
#define XB_TOPGEN   3392
#define XCD_BAR_WORDS 3456
#define XB_SPIN_CAP (1u << 18)

__device__ __forceinline__ unsigned xb_ld(unsigned* p)              { return __hip_atomic_load(p, __ATOMIC_RELAXED, __HIP_MEMORY_SCOPE_AGENT); }
__device__ __forceinline__ unsigned xb_add(unsigned* p, unsigned v) { return __hip_atomic_fetch_add(p, v, __ATOMIC_RELAXED, __HIP_MEMORY_SCOPE_AGENT); }
__device__ __forceinline__ unsigned xb_xcc_id() { return (unsigned)__builtin_amdgcn_s_getreg((3 << 11) | 20) & 0xFu; }
#define XB_SPIN(cond, bar) do { unsigned _sp = 0; while (cond) { __builtin_amdgcn_s_sleep(1); \
    if ((++_sp & 255u) == 0u) { if (xb_ld(&(bar)[XB_TMO])) break; if (_sp > XB_SPIN_CAP) { atomicAdd(&(bar)[XB_TMO], 1u); break; } } } } while (0)

struct XcdBarrier {
    unsigned* bar; unsigned x;
    volatile LAS unsigned* st;
};

__device__ __forceinline__ XcdBarrier xcd_barrier_post(unsigned* bar, volatile LAS unsigned* st) {
    XcdBarrier b; b.bar = bar; b.x = xb_xcc_id(); b.st = st;
    if (threadIdx.x == 0) (void)xb_add(&bar[XB_XCNT(b.x)], 1u);
    return b;
}
__device__ __forceinline__ void xcd_barrier_complete(unsigned* bar, unsigned x, unsigned& nloc, unsigned& nx) {
    const unsigned G = gridDim.x * gridDim.y * gridDim.z;
    unsigned sum, cnt, mine, sp = 0u;
    for (;;) {
        sum = 0u; cnt = 0u; mine = 0u;
#pragma unroll
        for (unsigned j = 0; j < 16; ++j) { const unsigned c = xb_ld(&bar[XB_XCNT(j)]); sum += c; cnt += (c > 0u) ? 1u : 0u; mine = (j == x) ? c : mine; }
        if (sum == G) break;
        __builtin_amdgcn_s_sleep(1);
        if ((++sp & 255u) == 0u) { if (xb_ld(&bar[XB_TMO])) break; if (sp > XB_SPIN_CAP) { atomicAdd(&bar[XB_TMO], 1u); break; } }
    }
    nloc = mine > 0u ? mine : 1u; nx = cnt > 0u ? cnt : 1u;
}

__device__ __forceinline__ void xcd_barrier(const XcdBarrier& b) {
    asm volatile("s_waitcnt vmcnt(0)" ::: "memory");
    __syncthreads();
    if (threadIdx.x == 0) {
        unsigned* bar = b.bar;
        __builtin_amdgcn_s_waitcnt(0);
        unsigned nloc = b.st[0], nx = b.st[1];
        if (nloc == 0u) { xcd_barrier_complete(bar, b.x, nloc, nx); b.st[0] = nloc; b.st[1] = nx; }
        const unsigned old = xb_add(&bar[XB_XSUB(b.x)], 1u);
        const unsigned gen = old / nloc;
        if (old + 1u == (gen + 1u) * nloc) {
            __builtin_amdgcn_fence(__ATOMIC_RELEASE, "agent");
            asm volatile("s_waitcnt vmcnt(0)" ::: "memory");
            const unsigned og = xb_add(&bar[XB_TOP], 1u);
            const unsigned tg = og / nx;
            if (og + 1u == (tg + 1u) * nx) xb_add(&bar[XB_TOPGEN], 1u);
            else XB_SPIN(xb_ld(&bar[XB_TOPGEN]) == tg, bar);
            __builtin_amdgcn_fence(__ATOMIC_ACQUIRE, "agent");
            xb_add(&bar[XB_XGEN(b.x)], 1u);
            asm volatile("s_waitcnt vmcnt(0)" ::: "memory");
        } else {
            XB_SPIN(xb_ld(&bar[XB_XGEN(b.x)]) == gen, bar);
            __builtin_amdgcn_fence(__ATOMIC_ACQUIRE, "agent");
            asm volatile("s_waitcnt vmcnt(0)" ::: "memory");
        }
    }
    __syncthreads();
}
#ifndef PH_HI
#define PH_HI NPHASE
#endif
#ifndef PH_MASK
#define PH_MASK 511
#endif

__global__ void __launch_bounds__(NWAVES * 64, 2) fwd_megakernel(Args a) {
    extern __shared__ __attribute__((aligned(16))) unsigned char lds_raw[];
    LAS unsigned char* lds = (LAS unsigned char*)lds_raw;
    cg::grid_group grid = cg::this_grid();
    { LAS unsigned* z = (LAS unsigned*)(lds + 131072); if (threadIdx.x < 64) z[threadIdx.x] = 0u; }
    __syncthreads();
    grid.sync();
    (void)xcd_barrier_post((unsigned*)(*(unsigned char* const __attribute__((address_space(4)))*)((kptr_t)__builtin_amdgcn_kernarg_segment_ptr() + 176) + WS_BAR), (volatile LAS unsigned*)(lds + 131072 + 32));
    int tid = threadIdx.x, G = gridDim.x, bx = blockIdx.x;
    kptr_t kp = (kptr_t)__builtin_amdgcn_kernarg_segment_ptr();
    unsigned char* ws = *(unsigned char* const __attribute__((address_space(4)))*)(kp + 176);
    float* const outp = *(float* const __attribute__((address_space(4)))*)(kp + 168);
    const int ph_lo = *(const int __attribute__((address_space(4)))*)(kp + 184), ph_hi = *(const int __attribute__((address_space(4)))*)(kp + 188);
#define REFRESH_PTRS() asm volatile("" : "+s"(ws), "+s"(kp))
    float* ssq = (float*)(ws + WS_SSQ); float* vst = (float*)(ws + WS_VST);
    bf16* XB = (bf16*)(ws + WS_XB); bf16* XR = (bf16*)(ws + WS_XR); bf16* GR = (bf16*)(ws + WS_GR); bf16* U = (bf16*)(ws + WS_U); bf16* V = (bf16*)(ws + WS_V);
    bf16* F = (bf16*)(ws + WS_F); bf16* S1 = (bf16*)(ws + WS_S1); bf16* S2 = (bf16*)(ws + WS_S2);

    for (int ph = ph_lo; ph < ph_hi; ++ph) {
        if (ph > ph_lo) { XcdBarrier bar; bar.bar = (unsigned*)(ws + WS_BAR); bar.x = xb_xcc_id(); bar.st = (volatile LAS unsigned*)(lds + 131072 + 32); xcd_barrier(bar); }
        REFRESH_PTRS(); asm volatile("" : "+v"(tid), "+s"(G), "+s"(bx));
        const int lane = tid & 63, wave = __builtin_amdgcn_readfirstlane(tid >> 6);
        const int vcu = (G % 8 == 0) ? (bx % 8) * (G / 8) + bx / 8 : bx;
        const int gw = vcu * NWAVES + wave, NGW = G * NWAVES;
        ssq = (float*)(ws + WS_SSQ); vst = (float*)(ws + WS_VST); XB = (bf16*)(ws + WS_XB); XR = (bf16*)(ws + WS_XR); GR = (bf16*)(ws + WS_GR); U = (bf16*)(ws + WS_U); V = (bf16*)(ws + WS_V);
        F = (bf16*)(ws + WS_F); S1 = (bf16*)(ws + WS_S1); S2 = (bf16*)(ws + WS_S2);
        if (ph == 0) { if (PH_MASK & 256) p0_prologue(kp, ws, lds, gw, NGW, wave, lane); continue; }
        if (ph == NPHASE - 1) {
            const float* gf = AIN(kp, I_FNG);
            for (int m = gw; m < M; m += NGW) { f32x4* xr = (f32x4*)(outp + (size_t)m * D) + lane; f32x4 v[4]; float s = 0.f;
#pragma unroll
                for (int j = 0; j < 4; ++j) { v[j] = xr[64 * j]; s += (v[j].x * v[j].x + v[j].y * v[j].y) + (v[j].z * v[j].z + v[j].w * v[j].w); }
                const float rs = __builtin_amdgcn_rsqf(wave_sum(s) * (1.0f / 1024.0f) + pg8::RMS_EPS);
#pragma unroll
                for (int j = 0; j < 4; ++j) { const f32x4 g4 = *((const f32x4*)gf + lane + 64 * j); xr[64 * j] = v[j] * rs * g4; } }
            continue;
        }
        const int l = (ph - 1) / 7, sub = (ph - 1) % 7;
        const unsigned char* wl = ws + WS_W + (size_t)l * W_LAYER;
        if (sub == 0 && (PH_MASK & 1)) {
            pg8::Gemm g{XB, (const bf16*)(wl + W_IN), M, NP1, D}; pg8::StaticOrder S; S.init(M, NP1, G, bx);
            pg8::EpiIn E{XR, GR, U, V, ssq + (2 * l) * M, vst + (2 * l) * M, vst + (2 * l + 1) * M};
            pg8::gemm_phase<pg8::EpiIn, pg8::StaticOrder, true, true>(lds, g, S, E, tid);
        }
#ifdef NAIVE_MIX
        else if (sub == 1) { naive_vstats(V, vst + (2 * l) * M, vst + (2 * l + 1) * M, gw, NGW, lane); }
        else if (sub == 2) {
            naive_sgu(V, U, AIN(kp, I_WS) + (size_t)l * 8 * 128 * 128, AIN(kp, I_BS) + l * 1024, AIN(kp, I_LNG) + l * 1024, AIN(kp, I_LNB) + l * 1024, vst + (2 * l) * M, vst + (2 * l + 1) * M, gw * 64 + lane, NGW * 64);
            naive_rnn(XR, GR, AIN(kp, I_LWA) + (size_t)l * NH * 4096, AIN(kp, I_LWX) + (size_t)l * NH * 4096, AIN(kp, I_LBA) + l * DRNN, AIN(kp, I_LBX) + l * DRNN, AIN(kp, I_LAM) + l * DRNN, AIN(kp, I_CW) + l * 4 * DRNN, AIN(kp, I_CB) + l * DRNN, gw, NGW, lane);
        }
#endif
        else if (sub == 1 && (PH_MASK & 2)) {
            SguP P{V, U, (const bf16*)(wl + W_S), AIN(kp, I_BS) + l * 1024, AIN(kp, I_LNG) + l * 1024, AIN(kp, I_LNB) + l * 1024, vst + (2 * l) * M, vst + (2 * l + 1) * M};
            for (int it = vcu; it < BATCH * 32 * 8; it += G) sgu_item(P, (LAS bf16*)lds, it >> 8, (it >> 3) & 31, it & 7, tid, wave, lane);
            RnnP R{XR, GR, (const bf16*)(wl + W_L), AIN(kp, I_CW) + l * 4 * DRNN, AIN(kp, I_CB) + l * DRNN, AIN(kp, I_LBA) + l * DRNN, AIN(kp, I_LBX) + l * DRNN, AIN(kp, I_LAM) + l * DRNN,
                   (float*)(ws + WS_ATOT), (float*)(ws + WS_HEND)};
            LAS float* xl = (LAS float*)(lds + 40960 + wave * 4608);
            for (int it = gw; it < BATCH * NH * NSEG; it += NGW) rnn_item<false>(R, xl, (it / NH) % BATCH, it % NH, it / (NH * BATCH), lane);
        } else if (sub == 2 && (PH_MASK & 4)) {
            RnnP R{XR, GR, (const bf16*)(wl + W_L), AIN(kp, I_CW) + l * 4 * DRNN, AIN(kp, I_CB) + l * DRNN, AIN(kp, I_LBA) + l * DRNN, AIN(kp, I_LBX) + l * DRNN, AIN(kp, I_LAM) + l * DRNN,
                   (float*)(ws + WS_ATOT), (float*)(ws + WS_HEND)};
            LAS float* xl = (LAS float*)(lds + 40960 + wave * 4608);
            for (int it = gw; it < BATCH * NH * NSEG; it += NGW) rnn_item<true>(R, xl, (it / NH) % BATCH, it % NH, it / (NH * BATCH), lane);
        } else if (sub == 3 && (PH_MASK & 8)) {
            pg8::StaticOrder S; S.init(M, D, G, bx);
            { asm volatile("" : "+v"(tid), "+s"(ws)); pg8::Gemm g{(bf16*)(ws + WS_XB), (const bf16*)(wl + W_G), M, D, D}; pg8::EpiAct<0> E{((bf16*)(ws + WS_S1)), D, ssq + (2 * l) * M}; pg8::gemm_phase<pg8::EpiAct<0>, pg8::StaticOrder, true, true>(lds, g, S, E, tid); }
            { asm volatile("" : "+v"(tid), "+s"(ws)); pg8::Gemm g{(bf16*)(ws + WS_GR), (const bf16*)(wl + W_A), M, D, DRNN}; pg8::EpiMix<false> E{((bf16*)(ws + WS_S1)), ((bf16*)(ws + WS_S1))}; pg8::gemm_phase<pg8::EpiMix<false>, pg8::StaticOrder, true, true>(lds, g, S, E, tid); }
            { asm volatile("" : "+v"(tid), "+s"(ws)); pg8::Gemm g{(bf16*)(ws + WS_XB), (const bf16*)(wl + W_G) + (size_t)D * D, M, D, D}; pg8::EpiAct<0> E{((bf16*)(ws + WS_S2)), D, ssq + (2 * l) * M}; pg8::gemm_phase<pg8::EpiAct<0>, pg8::StaticOrder, true, true>(lds, g, S, E, tid); }
            { asm volatile("" : "+v"(tid), "+s"(ws)); pg8::Gemm g{(bf16*)(ws + WS_U), (const bf16*)(wl + W_B), M, D, D}; pg8::EpiMix<true> E{((bf16*)(ws + WS_S1)), ((bf16*)(ws + WS_S2))}; pg8::gemm_phase<pg8::EpiMix<true>, pg8::StaticOrder, true, true>(lds, g, S, E, tid); }
        } else if (sub == 4 && (PH_MASK & 16)) {
            pg8::Gemm g{S1, (const bf16*)(wl + W_O), M, D, D}; pg8::StaticOrder S; S.init(M, D, G, bx);
            pg8::EpiRes E{l == 0 ? AIN(kp, I_X) : outp, outp, XB, ssq + (2 * l + 1) * M};
            pg8::gemm_phase<pg8::EpiRes, pg8::StaticOrder, true, true>(lds, g, S, E, tid);
        } else if (sub == 5 && (PH_MASK & 32)) {
            pg8::Gemm g{XB, (const bf16*)(wl + W_UP), M, FF, D}; pg8::StaticOrder S; S.init(M, FF, G, bx);
            pg8::EpiAct<1> E{F, FF, ssq + (2 * l + 1) * M};
            pg8::gemm_phase<pg8::EpiAct<1>, pg8::StaticOrder, true, true>(lds, g, S, E, tid);
        } else if (PH_MASK & 64) {
            pg8::Gemm g{F, (const bf16*)(wl + W_DN), M, D, FF}; pg8::StaticOrder S; S.init(M, D, G, bx);
            pg8::EpiRes E{outp, outp, XB, ssq + (2 * l + 2) * M};
            pg8::gemm_phase<pg8::EpiRes, pg8::StaticOrder, true, true>(lds, g, S, E, tid);
        }
    }
}

extern "C" void kernel_launch(void* const* d_in, const int* in_sizes, int n_in, void* d_out, int out_size, void* d_ws, size_t ws_size, hipStream_t stream) {
    static int grid = 0;
    if (grid == 0) {
        if (n_in != 21 || out_size != M * D || ws_size < WS_END) { fprintf(stderr, "kernel_launch: unexpected shapes (n_in %d, out %d, ws %zu); nothing launched\n", n_in, out_size, ws_size); grid = -1; return; }
        int dev = 0, cus = 0, per_cu = 0;
        if (hipGetDevice(&dev) != hipSuccess || hipDeviceGetAttribute(&cus, hipDeviceAttributeMultiprocessorCount, dev) != hipSuccess) { grid = -1; return; }
        if (hipFuncSetAttribute((const void*)fwd_megakernel, hipFuncAttributeMaxDynamicSharedMemorySize, LDS_BYTES) != hipSuccess) { fprintf(stderr, "kernel_launch: hipFuncSetAttribute failed\n"); grid = -1; return; }
        if (hipOccupancyMaxActiveBlocksPerMultiprocessor(&per_cu, (const void*)fwd_megakernel, NWAVES * 64, LDS_BYTES) != hipSuccess || per_cu < 1) per_cu = 1;
        (void)hipGetLastError();
        grid = cus * per_cu;
        fprintf(stderr, "kernel_launch: %d CUs x %d -> grid %d, ws %zu\n", cus, per_cu, grid, ws_size);
    }
    if (grid < 0) return;
#ifdef EXP_POISON
    (void)hipMemsetAsync(d_ws, 0xAA, WS_END, stream); (void)hipMemsetAsync(d_out, 0xAA, (size_t)M * D * 4, stream);
#endif
    if (hipMemsetAsync((char*)d_ws + WS_BAR, 0, 16384, stream) != hipSuccess) { fprintf(stderr, "kernel_launch: hipMemsetAsync failed\n"); return; }
    Args a{};
    for (int i = 0; i < 21; ++i) a.in[i] = (const float*)d_in[i];
    a.out = (float*)d_out; a.ws = (unsigned char*)d_ws; a.ph_lo = 0; a.ph_hi = PH_HI;
    void* args[] = {&a};
    const hipError_t e = hipLaunchCooperativeKernel((const void*)fwd_megakernel, dim3(grid), dim3(NWAVES * 64), args, LDS_BYTES, stream);
    if (e != hipSuccess) fprintf(stderr, "kernel_launch: cooperative launch failed: %s (grid %d)\n", hipGetErrorString(e), grid);
}
```

```cpp
#include <hip/hip_runtime.h>
#include <hip/hip_cooperative_groups.h>
#include <cstdio>
#include <cstdint>
namespace cg = cooperative_groups;
namespace pg8 {
#define PG8_LAS __attribute__((address_space(3)))
typedef unsigned short bf16_t;
typedef short bf16x8 __attribute__((ext_vector_type(8)));
typedef float f32x4 __attribute__((ext_vector_type(4)));
typedef unsigned u32x4 __attribute__((ext_vector_type(4)));
typedef unsigned u32x2 __attribute__((ext_vector_type(2)));
constexpr int BM = 256, BK = 64, HALF = 128, HTB = HALF * BK * 2, STAGE_BYTES = 8 * HTB, NXCD = 8, WGM = 4;
__host__ __device__ __forceinline__ int lds_byte(int r, int c) { const int st = (r >> 4) * 2 + (c >> 5), rr = r & 15, cc = c & 31, ob = rr * 64 + cc * 2; return st * 1024 + (ob ^ (((ob >> 9) & 1) << 5)); }
__host__ __device__ __forceinline__ void stage_rc(int b, int& R, int& C) { const int st = b / 1024, sb = b % 1024, swz = sb ^ (((sb >> 9) & 1) << 5); R = (st >> 1) * 16 + swz / 64; C = (st & 1) * 32 + (swz % 64) / 2; }
__host__ __device__ __forceinline__ int perm32(int rho) { const int n = rho >> 4, i = rho & 15; return 8 * (i >> 2) + 4 * n + (i & 3); }
struct Unit { int pm, pn; };
struct Gemm { const bf16_t* A; const bf16_t* Bt; int M, N, K; };
struct StaticOrder {
    int nM, nN, nwg, G, c;
    __host__ __device__ void init(int M, int N, int G_, int c_) { nM = M / BM; nN = N / BM; nwg = nM * nN; G = G_; c = c_; }
    __host__ __device__ bool next(int i, Unit& u) const {
        const long L = (long)i * G + c; if (L >= nwg) return false;
        int wgid = (int)L; { const int q = nwg / NXCD, r = nwg % NXCD, xcd = wgid % NXCD, off = wgid / NXCD; wgid = (xcd < r ? xcd * (q + 1) : r * (q + 1) + (xcd - r) * q) + off; }
        const int nig = WGM * nN, gid = wgid / nig, fm = gid * WGM, gsz = (nM - fm) < WGM ? (nM - fm) : WGM;
        u.pm = fm + ((wgid % nig) % gsz); u.pn = (wgid % nig) / gsz; return true;
    }
    __device__ __forceinline__ void a_ready(const Unit&) const {}
    __device__ __forceinline__ void done(const Unit&) const {}
};

constexpr float RMS_EPS = 1e-6f;
__device__ __forceinline__ unsigned cvt_pk_bf16(float lo, float hi) { unsigned r; asm volatile("v_cvt_pk_bf16_f32 %0, %1, %2" : "=v"(r) : "v"(lo), "v"(hi)); return r; }
__device__ __forceinline__ float bf_lo(unsigned w) { return __uint_as_float(w << 16); }
__device__ __forceinline__ float bf_hi(unsigned w) { return __uint_as_float(w & 0xffff0000u); }
__device__ __forceinline__ float sigm(float x) { return __builtin_amdgcn_rcpf(1.0f + __builtin_amdgcn_exp2f(-1.44269504f * x)); }
__device__ __forceinline__ float gelu_t(float x) { const float z = x * (1.5957691216f + 0.0713548163f * x * x); return x * __builtin_amdgcn_rcpf(1.0f + __builtin_amdgcn_exp2f(-1.44269504f * z)); }
constexpr float FIX_SSQ = 4096.0f, FIX_V = 65536.0f;
__device__ __forceinline__ float unfix(float slot, float scale) { return (float)(int)__float_as_uint(slot) * (1.0f / scale); }
__device__ __forceinline__ float tofix(float v, float scale) { return __uint_as_float((unsigned)(int)__builtin_rintf(v * scale)); }
__device__ __forceinline__ float rstd_of(float ssq) { return __builtin_amdgcn_rsqf(unfix(ssq, FIX_SSQ) * (1.0f / 1024.0f) + RMS_EPS); }
__device__ __forceinline__ void fadd_fix(float* p, float v, float scale) { (void)__hip_atomic_fetch_add((unsigned*)p, (unsigned)(int)__builtin_rintf(v * scale), __ATOMIC_RELAXED, __HIP_MEMORY_SCOPE_AGENT); }

struct EpiIn {
    static constexpr bool PERM = true, AFTER_DRAIN = false;
    bf16_t* XR; bf16_t* GR; bf16_t* U; bf16_t* V; bf16_t* HALO; const float* ssq; float* vsum; float* vsq;
    __device__ __forceinline__ void operator()(const f32x4 (&acc)[2][2][4][2], const Unit& u, int wr, int wc, int fr, int fq) const {
        const int pn = u.pn; bf16_t* base; int ldc, colt, act;
        if (pn < 5) { base = XR; ldc = 1280; colt = pn * 256; act = 0; }
        else if (pn < 10) { base = GR; ldc = 1280; colt = (pn - 5) * 256; act = 1; }
        else if (pn < 14) { base = U; ldc = 1024; colt = (pn - 10) * 256; act = 1; }
        else { base = V; ldc = 1024; colt = (pn - 14) * 256; act = 2; }
        const int row0 = u.pm * BM + wr * 64 + fr, col0 = colt + wc * 32 + 8 * fq;
#pragma unroll
        for (int ai = 0; ai < 2; ++ai)
#pragma unroll
            for (int m = 0; m < 4; ++m) {
                const int row = row0 + ai * HALF + m * 16; const float rs = rstd_of(ssq[row]);
                bf16_t* rowp = base + (size_t)row * ldc + col0; float s1 = 0.f, s2 = 0.f;
#pragma unroll
                for (int bj = 0; bj < 2; ++bj) { f32x4 v0 = acc[ai][bj][m][0] * rs, v1 = acc[ai][bj][m][1] * rs;
                    if (act) {
#pragma unroll
                        for (int j = 0; j < 4; ++j) { v0[j] = gelu_t(v0[j]); v1[j] = gelu_t(v1[j]); } }
                    if (act == 2) {
#pragma unroll
                        for (int j = 0; j < 4; ++j) { s1 += v0[j] + v1[j]; s2 += v0[j] * v0[j] + v1[j] * v1[j]; } }
                    u32x4 w; w.x = cvt_pk_bf16(v0[0], v0[1]); w.y = cvt_pk_bf16(v0[2], v0[3]); w.z = cvt_pk_bf16(v1[0], v1[1]); w.w = cvt_pk_bf16(v1[2], v1[3]);
                    *(u32x4*)(rowp + bj * HALF) = w;
                    if (pn < 5 && m == 3 && fr >= 13) *(u32x4*)(HALO + ((size_t)(row >> 6) * 3 + (fr - 13)) * 1280 + col0 + bj * HALF) = w; }
                if (act == 2) { s1 += __shfl_xor(s1, 16); s1 += __shfl_xor(s1, 32); s2 += __shfl_xor(s2, 16); s2 += __shfl_xor(s2, 32);
                    if (fq == 0) { fadd_fix(vsum + row, s1, FIX_V); fadd_fix(vsq + row, s2, FIX_V); } }
            }
    }
};
template <int ACT> struct EpiAct {
    static constexpr bool PERM = true, AFTER_DRAIN = false;
    bf16_t* O; int ldc; const float* ssq;
    __device__ __forceinline__ void operator()(const f32x4 (&acc)[2][2][4][2], const Unit& u, int wr, int wc, int fr, int fq) const {
        const int row0 = u.pm * BM + wr * 64 + fr, col0 = u.pn * BM + wc * 32 + 8 * fq;
#pragma unroll
        for (int ai = 0; ai < 2; ++ai)
#pragma unroll
            for (int m = 0; m < 4; ++m) {
                const int row = row0 + ai * HALF + m * 16; const float rs = rstd_of(ssq[row]);
                bf16_t* rowp = O + (size_t)row * ldc + col0;
#pragma unroll
                for (int bj = 0; bj < 2; ++bj) { f32x4 v0 = acc[ai][bj][m][0] * rs, v1 = acc[ai][bj][m][1] * rs;
#pragma unroll
                    for (int j = 0; j < 4; ++j) {
                        if (ACT == 0) { v0[j] = sigm(v0[j]); v1[j] = sigm(v1[j]); }
                        else { const float a = fmaxf(v0[j], 0.f), b = fmaxf(v1[j], 0.f); v0[j] = a * a; v1[j] = b * b; } }
                    u32x4 w; w.x = cvt_pk_bf16(v0[0], v0[1]); w.y = cvt_pk_bf16(v0[2], v0[3]); w.z = cvt_pk_bf16(v1[0], v1[1]); w.w = cvt_pk_bf16(v1[2], v1[3]);
                    *(u32x4*)(rowp + bj * HALF) = w; }
            }
    }
};
struct EpiGate8 {
    static constexpr bool PERM = true, AFTER_DRAIN = false;
    unsigned char* G8; const float* ssq;
    __device__ __forceinline__ void operator()(const f32x4 (&acc)[2][2][4][2], const Unit& u, int wr, int wc, int fr, int fq) const {
        const int row0 = u.pm * BM + wr * 64 + fr, col0 = u.pn * BM + wc * 32 + 8 * fq;
#pragma unroll
        for (int ai = 0; ai < 2; ++ai)
#pragma unroll
            for (int m = 0; m < 4; ++m) {
                const int row = row0 + ai * HALF + m * 16; const float rs = rstd_of(ssq[row]);
                unsigned char* rowp = G8 + (size_t)row * 1024 + col0;
#pragma unroll
                for (int bj = 0; bj < 2; ++bj) { const f32x4 v0 = acc[ai][bj][m][0] * rs, v1 = acc[ai][bj][m][1] * rs; unsigned q[8];
#pragma unroll
                    for (int j = 0; j < 4; ++j) { q[j] = (unsigned)__builtin_rintf(255.0f * sigm(v0[j])); q[4 + j] = (unsigned)__builtin_rintf(255.0f * sigm(v1[j])); }
                    u32x2 w; w.x = q[0] | (q[1] << 8) | (q[2] << 16) | (q[3] << 24); w.y = q[4] | (q[5] << 8) | (q[6] << 16) | (q[7] << 24);
                    *(u32x2*)(rowp + bj * HALF) = w; }
            }
    }
};
template <bool ADD> struct EpiMix {
    static constexpr bool PERM = true, AFTER_DRAIN = false;
    bf16_t* O; const unsigned char* G8;
    __device__ __forceinline__ void operator()(const f32x4 (&acc)[2][2][4][2], const Unit& u, int wr, int wc, int fr, int fq) const {
        const int row0 = u.pm * BM + wr * 64 + fr, col0 = u.pn * BM + wc * 32 + 8 * fq;
#pragma unroll
        for (int ai = 0; ai < 2; ++ai)
#pragma unroll
            for (int m = 0; m < 4; ++m) {
                const size_t off = (size_t)(row0 + ai * HALF + m * 16) * 1024 + col0;
#pragma unroll
                for (int bj = 0; bj < 2; ++bj) { const u32x2 gq = *(const u32x2*)(G8 + off + bj * HALF); const f32x4 a0 = acc[ai][bj][m][0], a1 = acc[ai][bj][m][1];
                    const float k = 1.0f / 255.0f; f32x4 v0, v1;
                    v0[0] = (float)(gq.x & 255u) * k * a0[0]; v0[1] = (float)((gq.x >> 8) & 255u) * k * a0[1]; v0[2] = (float)((gq.x >> 16) & 255u) * k * a0[2]; v0[3] = (float)(gq.x >> 24) * k * a0[3];
                    v1[0] = (float)(gq.y & 255u) * k * a1[0]; v1[1] = (float)((gq.y >> 8) & 255u) * k * a1[1]; v1[2] = (float)((gq.y >> 16) & 255u) * k * a1[2]; v1[3] = (float)(gq.y >> 24) * k * a1[3];
                    if (ADD) { const u32x4 tw = *(const u32x4*)(O + off + bj * HALF);
                        v0[0] += bf_lo(tw.x); v0[1] += bf_hi(tw.x); v0[2] += bf_lo(tw.y); v0[3] += bf_hi(tw.y); v1[0] += bf_lo(tw.z); v1[1] += bf_hi(tw.z); v1[2] += bf_lo(tw.w); v1[3] += bf_hi(tw.w); }
                    u32x4 w; w.x = cvt_pk_bf16(v0[0], v0[1]); w.y = cvt_pk_bf16(v0[2], v0[3]); w.z = cvt_pk_bf16(v1[0], v1[1]); w.w = cvt_pk_bf16(v1[2], v1[3]);
                    *(u32x4*)(O + off + bj * HALF) = w; }
                asm volatile("" ::: "memory");
            }
    }
};
struct EpiRes {
    static constexpr bool PERM = true, AFTER_DRAIN = false;
    bf16_t* xb; float* ssq_out;
    __device__ __forceinline__ void operator()(const f32x4 (&acc)[2][2][4][2], const Unit& u, int wr, int wc, int fr, int fq) const {
        const int row0 = u.pm * BM + wr * 64 + fr, col0 = u.pn * BM + wc * 32 + 8 * fq;
#pragma unroll
        for (int ai = 0; ai < 2; ++ai)
#pragma unroll
            for (int m = 0; m < 4; ++m) {
                const int row = row0 + ai * HALF + m * 16; const size_t off = (size_t)row * 1024 + col0; float s = 0.f;
#pragma unroll
                for (int bj = 0; bj < 2; ++bj) { const u32x4 xw = *(const u32x4*)(xb + off + bj * HALF); const f32x4 a0 = acc[ai][bj][m][0], a1 = acc[ai][bj][m][1];
                    f32x4 v0, v1; v0[0] = bf_lo(xw.x) + a0[0]; v0[1] = bf_hi(xw.x) + a0[1]; v0[2] = bf_lo(xw.y) + a0[2]; v0[3] = bf_hi(xw.y) + a0[3];
                    v1[0] = bf_lo(xw.z) + a1[0]; v1[1] = bf_hi(xw.z) + a1[1]; v1[2] = bf_lo(xw.w) + a1[2]; v1[3] = bf_hi(xw.w) + a1[3];
                    u32x4 w; w.x = cvt_pk_bf16(v0[0], v0[1]); w.y = cvt_pk_bf16(v0[2], v0[3]); w.z = cvt_pk_bf16(v1[0], v1[1]); w.w = cvt_pk_bf16(v1[2], v1[3]);
                    *(u32x4*)(xb + off + bj * HALF) = w;
                    s += (v0[0] * v0[0] + v0[1] * v0[1]) + (v0[2] * v0[2] + v0[3] * v0[3]) + (v1[0] * v1[0] + v1[1] * v1[1]) + (v1[2] * v1[2] + v1[3] * v1[3]); }
                s += __shfl_xor(s, 16); s += __shfl_xor(s, 32);
                if (fq == 0) fadd_fix(ssq_out + row, s, FIX_SSQ);
                asm volatile("" ::: "memory");
            }
    }
};
template <class Epi, class Sched, bool ALIGN_EPI = false, bool SP2 = false>
__device__ __forceinline__ void gemm_phase(PG8_LAS unsigned char* lds, const Gemm g, const Sched& S, const Epi& E, const int tid) {
    const int wid = __builtin_amdgcn_readfirstlane(tid >> 6), lane = tid & 63, wr = wid >> 2, wc = wid & 3, fr = lane & 15, fq = lane >> 4;
    const int K = g.K, nt = K / BK;
    unsigned voffA[2], voffB[2];
#pragma unroll
    for (int i = 0; i < 2; ++i) { int R, C; stage_rc(tid * 16 + i * 8192, R, C); const int Rb = Epi::PERM ? ((R & ~31) + perm32(R & 31)) : R;
        voffA[i] = (unsigned)(R * K + C) * 2u; voffB[i] = (unsigned)(Rb * K + C) * 2u; }
    const size_t kstep = (size_t)(BK * 2);
    const size_t hstep = (size_t)HALF * K * 2;
    const size_t tstep = 2 * hstep;
    const unsigned ldsw = (unsigned)wid * 1024u;
    const int aoff = lds_byte(wr * 64 + fr, fq * 8), boff = lds_byte(wc * 32 + fr, fq * 8);
#define PG8_SA(b, h) (((b) * 2 + (h)) * HTB)
#define PG8_SB(b, h) ((4 + (b) * 2 + (h)) * HTB)
#define PG8_STAGE(bufoff, gbase, voff) do { _Pragma("unroll") for (int _i = 0; _i < 2; ++_i) \
        __builtin_amdgcn_global_load_lds((const unsigned*)((const char*)(gbase) + (voff)[_i]), (PG8_LAS unsigned*)(lds + (bufoff) + ldsw + _i * 8192), 16, 0, 0); } while (0)
#define PG8_LDA(dst, b, h) do { _Pragma("unroll") for (int m = 0; m < 4; ++m) _Pragma("unroll") for (int k = 0; k < 2; ++k) dst[m][k] = *(const PG8_LAS bf16x8*)(lds + PG8_SA(b, h) + aoff + m * 2048 + k * 1024); } while (0)
#define PG8_LDB(dst, b, h) do { _Pragma("unroll") for (int n = 0; n < 2; ++n) _Pragma("unroll") for (int k = 0; k < 2; ++k) dst[n][k] = *(const PG8_LAS bf16x8*)(lds + PG8_SB(b, h) + boff + n * 2048 + k * 1024); } while (0)
#define PG8_MMA(ai, bj, At, Bt) do { __builtin_amdgcn_s_setprio(1); _Pragma("unroll") for (int m = 0; m < 4; ++m) _Pragma("unroll") for (int n = 0; n < 2; ++n) _Pragma("unroll") for (int k = 0; k < 2; ++k) \
        acc[ai][bj][m][n] = __builtin_amdgcn_mfma_f32_16x16x32_bf16(Bt[n][k], At[m][k], acc[ai][bj][m][n], 0, 0, 0); __builtin_amdgcn_s_setprio(0); } while (0)
#define PG8_WAIT_V(n) asm volatile("s_waitcnt vmcnt(" #n ")" ::: "memory")
#define PG8_WAIT_L(n) asm volatile("s_waitcnt lgkmcnt(" #n ")" ::: "memory")
#define PG8_BAR __builtin_amdgcn_s_barrier()
#define PG8_SCHED __builtin_amdgcn_sched_barrier(0)
    Unit cur, nxt; int ui = 0;
    if (!S.next(0, cur)) return;
    f32x4 acc[2][2][4][2];
#pragma unroll
    for (int a = 0; a < 2; ++a)
#pragma unroll
        for (int b = 0; b < 2; ++b)
#pragma unroll
            for (int m = 0; m < 4; ++m)
#pragma unroll
                for (int n = 0; n < 2; ++n) acc[a][b][m][n] = (f32x4){0.f, 0.f, 0.f, 0.f};
    bf16x8 At[4][2], B0[2][2], B1[2][2];
    const char* cA = (const char*)g.A + (size_t)cur.pm * tstep; const char* cB = (const char*)g.Bt + (size_t)cur.pn * tstep;
    S.a_ready(cur);
    if constexpr (SP2) {
        PG8_STAGE(PG8_SB(0, 0), cB, voffB); PG8_STAGE(PG8_SB(0, 1), cB + hstep, voffB); PG8_STAGE(PG8_SA(0, 0), cA, voffA); PG8_STAGE(PG8_SA(0, 1), cA + hstep, voffA);
        if (wr == 1) PG8_BAR;
        PG8_WAIT_V(2); PG8_BAR;
        PG8_STAGE(PG8_SB(1, 0), cB + kstep, voffB); PG8_STAGE(PG8_SA(1, 0), cA + kstep, voffA); PG8_STAGE(PG8_SB(1, 1), cB + hstep + kstep, voffB);
        PG8_WAIT_V(6); PG8_BAR;
    } else {
        PG8_STAGE(PG8_SB(0, 0), cB, voffB); PG8_STAGE(PG8_SA(0, 0), cA, voffA); PG8_STAGE(PG8_SB(0, 1), cB + hstep, voffB); PG8_STAGE(PG8_SA(0, 1), cA + hstep, voffA);
        if (wr == 1) PG8_BAR;
        PG8_WAIT_V(4); PG8_BAR;
        PG8_STAGE(PG8_SB(1, 0), cB + kstep, voffB); PG8_STAGE(PG8_SA(1, 0), cA + kstep, voffA); PG8_STAGE(PG8_SB(1, 1), cB + hstep + kstep, voffB);
        PG8_WAIT_V(6); PG8_BAR;
    }
    for (;;) {
        const bool has_next = S.next(ui + 1, nxt);
        const char* nA = has_next ? (const char*)g.A + (size_t)nxt.pm * tstep : cA; const char* nB = has_next ? (const char*)g.Bt + (size_t)nxt.pn * tstep : cB;
        for (int t = 0; t < nt; t += 2) {
            const bool last = (t == nt - 2);
            const char* a1 = cA + (size_t)(t + 1) * kstep;
            const char* a2 = last ? nA : cA + (size_t)(t + 2) * kstep; const char* b2 = last ? nB : cB + (size_t)(t + 2) * kstep;
            const char* a3 = a2 + kstep; const char* b3 = b2 + kstep;
            if (last && has_next) S.a_ready(nxt);
            if constexpr (SP2) {
            PG8_LDB(B0, 0, 0); PG8_LDB(B1, 0, 1); PG8_SCHED; PG8_LDA(At, 0, 0); PG8_STAGE(PG8_SA(1, 1), a1 + hstep, voffA);
            PG8_WAIT_V(8); PG8_WAIT_L(0); PG8_BAR; PG8_MMA(0, 0, At, B0); PG8_MMA(0, 1, At, B1); PG8_BAR; PG8_SCHED;
            PG8_LDA(At, 0, 1); PG8_STAGE(PG8_SB(0, 0), b2, voffB); PG8_STAGE(PG8_SB(0, 1), b2 + hstep, voffB); PG8_STAGE(PG8_SA(0, 0), a2, voffA);
            PG8_WAIT_V(8); PG8_WAIT_L(0); PG8_BAR; PG8_MMA(1, 0, At, B0); PG8_MMA(1, 1, At, B1); PG8_BAR; PG8_SCHED;
            PG8_LDB(B0, 1, 0); PG8_LDB(B1, 1, 1); PG8_SCHED; PG8_LDA(At, 1, 0); PG8_STAGE(PG8_SA(0, 1), a2 + hstep, voffA);
            PG8_WAIT_V(8); PG8_WAIT_L(0); PG8_BAR; PG8_MMA(0, 0, At, B0); PG8_MMA(0, 1, At, B1); PG8_BAR; PG8_SCHED;
            PG8_LDA(At, 1, 1); PG8_STAGE(PG8_SB(1, 0), b3, voffB); PG8_STAGE(PG8_SB(1, 1), b3 + hstep, voffB); PG8_STAGE(PG8_SA(1, 0), a3, voffA);
            PG8_WAIT_V(8); PG8_WAIT_L(0); PG8_BAR; PG8_MMA(1, 0, At, B0); PG8_MMA(1, 1, At, B1); PG8_BAR; PG8_SCHED;
            } else {
            PG8_LDB(B0, 0, 0); PG8_SCHED; PG8_LDA(At, 0, 0); PG8_STAGE(PG8_SA(1, 1), a1 + hstep, voffA);
            PG8_WAIT_L(8); PG8_BAR; PG8_WAIT_L(0); PG8_MMA(0, 0, At, B0); PG8_BAR; PG8_SCHED;
            PG8_LDB(B1, 0, 1); PG8_STAGE(PG8_SB(0, 0), b2, voffB);
            PG8_BAR; PG8_WAIT_L(0); PG8_MMA(0, 1, At, B1); PG8_BAR;
            PG8_LDA(At, 0, 1); PG8_STAGE(PG8_SA(0, 0), a2, voffA);
            PG8_BAR; PG8_WAIT_L(0); PG8_MMA(1, 0, At, B0); PG8_BAR; PG8_SCHED;
            PG8_STAGE(PG8_SB(0, 1), b2 + hstep, voffB);
            PG8_WAIT_V(6); PG8_BAR; PG8_MMA(1, 1, At, B1); PG8_BAR;
            PG8_LDB(B0, 1, 0); PG8_SCHED; PG8_LDA(At, 1, 0); PG8_STAGE(PG8_SA(0, 1), a2 + hstep, voffA);
            PG8_WAIT_L(8); PG8_BAR; PG8_WAIT_L(0); PG8_MMA(0, 0, At, B0); PG8_BAR; PG8_SCHED;
            PG8_LDB(B1, 1, 1); PG8_STAGE(PG8_SB(1, 0), b3, voffB);
            PG8_BAR; PG8_WAIT_L(0); PG8_MMA(0, 1, At, B1); PG8_BAR;
            PG8_LDA(At, 1, 1); PG8_STAGE(PG8_SA(1, 0), a3, voffA);
            PG8_BAR; PG8_WAIT_L(0); PG8_MMA(1, 0, At, B0); PG8_BAR; PG8_SCHED;
            PG8_STAGE(PG8_SB(1, 1), b3 + hstep, voffB);
            PG8_WAIT_V(6); PG8_BAR; PG8_MMA(1, 1, At, B1); PG8_BAR;
            }
        }
        if constexpr (ALIGN_EPI) { if (wr == 0) PG8_BAR; }
        if constexpr (!Epi::AFTER_DRAIN) { E(acc, cur, wr, wc, fr, fq); S.done(cur); }
        if (!has_next) break;
#pragma unroll
        for (int a = 0; a < 2; ++a)
#pragma unroll
            for (int b = 0; b < 2; ++b)
#pragma unroll
                for (int m = 0; m < 4; ++m)
#pragma unroll
                    for (int n = 0; n < 2; ++n) acc[a][b][m][n] = (f32x4){0.f, 0.f, 0.f, 0.f};
        cur = nxt; cA = nA; cB = nB; ++ui;
        if constexpr (ALIGN_EPI) { if (wr == 1) PG8_BAR; }
    }
    PG8_WAIT_V(0);
    if constexpr (!ALIGN_EPI) { if (wr == 0) PG8_BAR; }
    PG8_BAR;
    if constexpr (Epi::AFTER_DRAIN) { E.fused(acc, cur, wr, wc, fr, fq, lds, wid, lane); S.done(cur); }
#undef PG8_SA
#undef PG8_SB
#undef PG8_STAGE
#undef PG8_LDA
#undef PG8_LDB
#undef PG8_MMA
#undef PG8_WAIT_V
#undef PG8_WAIT_L
#undef PG8_BAR
#undef PG8_SCHED
}

struct UnitX { int pm, pn; const bf16_t* A; const bf16_t* Bt; int K; int kind; };
template <class Epi, class Sched, bool ALIGN_EPI = false, bool SP2 = false>
__device__ __forceinline__ void gemm_phase_multi(PG8_LAS unsigned char* lds, const Sched& S, const Epi& E, const int tid) {
    const int wid = __builtin_amdgcn_readfirstlane(tid >> 6), lane = tid & 63, wr = wid >> 2, wc = wid & 3, fr = lane & 15, fq = lane >> 4;
    int sR[2], sRb[2], sC[2];
#pragma unroll
    for (int i = 0; i < 2; ++i) { int R, C; stage_rc(tid * 16 + i * 8192, R, C); sR[i] = R; sRb[i] = Epi::PERM ? ((R & ~31) + perm32(R & 31)) : R; sC[i] = C; }
    unsigned voffA[2], voffB[2], voffAn[2], voffBn[2];
#define PG8_VOFF(dA, dB, KK) do { _Pragma("unroll") for (int _i = 0; _i < 2; ++_i) { dA[_i] = (unsigned)(sR[_i] * (KK) + sC[_i]) * 2u; dB[_i] = (unsigned)(sRb[_i] * (KK) + sC[_i]) * 2u; } } while (0)
    const size_t kstep = (size_t)(BK * 2);
    const unsigned ldsw = (unsigned)wid * 1024u;
    const int aoff = lds_byte(wr * 64 + fr, fq * 8), boff = lds_byte(wc * 32 + fr, fq * 8);
#define PG8_SA(b, h) (((b) * 2 + (h)) * HTB)
#define PG8_SB(b, h) ((4 + (b) * 2 + (h)) * HTB)
#define PG8_STAGE(bufoff, gbase, voff) do { _Pragma("unroll") for (int _i = 0; _i < 2; ++_i) \
        __builtin_amdgcn_global_load_lds((const unsigned*)((const char*)(gbase) + (voff)[_i]), (PG8_LAS unsigned*)(lds + (bufoff) + ldsw + _i * 8192), 16, 0, 0); } while (0)
#define PG8_LDA(dst, b, h) do { _Pragma("unroll") for (int m = 0; m < 4; ++m) _Pragma("unroll") for (int k = 0; k < 2; ++k) dst[m][k] = *(const PG8_LAS bf16x8*)(lds + PG8_SA(b, h) + aoff + m * 2048 + k * 1024); } while (0)
#define PG8_LDB(dst, b, h) do { _Pragma("unroll") for (int n = 0; n < 2; ++n) _Pragma("unroll") for (int k = 0; k < 2; ++k) dst[n][k] = *(const PG8_LAS bf16x8*)(lds + PG8_SB(b, h) + boff + n * 2048 + k * 1024); } while (0)
#define PG8_MMA(ai, bj, At, Bt) do { __builtin_amdgcn_s_setprio(1); _Pragma("unroll") for (int m = 0; m < 4; ++m) _Pragma("unroll") for (int n = 0; n < 2; ++n) _Pragma("unroll") for (int k = 0; k < 2; ++k) \
        acc[ai][bj][m][n] = __builtin_amdgcn_mfma_f32_16x16x32_bf16(Bt[n][k], At[m][k], acc[ai][bj][m][n], 0, 0, 0); __builtin_amdgcn_s_setprio(0); } while (0)
#define PG8_WAIT_V(n) asm volatile("s_waitcnt vmcnt(" #n ")" ::: "memory")
#define PG8_WAIT_L(n) asm volatile("s_waitcnt lgkmcnt(" #n ")" ::: "memory")
#define PG8_BAR __builtin_amdgcn_s_barrier()
#define PG8_SCHED __builtin_amdgcn_sched_barrier(0)
    UnitX cur, nxt; int ui = 0;
    if (!S.next(0, cur)) return;
    int K = cur.K, nt = K / BK; size_t hstep = (size_t)HALF * K * 2, hstepn = hstep; PG8_VOFF(voffA, voffB, K); PG8_VOFF(voffAn, voffBn, K);
    f32x4 acc[2][2][4][2];
#pragma unroll
    for (int a = 0; a < 2; ++a)
#pragma unroll
        for (int b = 0; b < 2; ++b)
#pragma unroll
            for (int m = 0; m < 4; ++m)
#pragma unroll
                for (int n = 0; n < 2; ++n) acc[a][b][m][n] = (f32x4){0.f, 0.f, 0.f, 0.f};
    bf16x8 At[4][2], B0[2][2], B1[2][2];
    const char* cA = (const char*)cur.A + (size_t)cur.pm * 2 * hstep; const char* cB = (const char*)cur.Bt + (size_t)cur.pn * 2 * hstep;
    S.a_ready(cur);
    if constexpr (SP2) {
        PG8_STAGE(PG8_SB(0, 0), cB, voffB); PG8_STAGE(PG8_SB(0, 1), cB + hstep, voffB); PG8_STAGE(PG8_SA(0, 0), cA, voffA); PG8_STAGE(PG8_SA(0, 1), cA + hstep, voffA);
        if (wr == 1) PG8_BAR;
        PG8_WAIT_V(2); PG8_BAR;
        PG8_STAGE(PG8_SB(1, 0), cB + kstep, voffB); PG8_STAGE(PG8_SA(1, 0), cA + kstep, voffA); PG8_STAGE(PG8_SB(1, 1), cB + hstep + kstep, voffB);
        PG8_WAIT_V(6); PG8_BAR;
    } else {
        PG8_STAGE(PG8_SB(0, 0), cB, voffB); PG8_STAGE(PG8_SA(0, 0), cA, voffA); PG8_STAGE(PG8_SB(0, 1), cB + hstep, voffB); PG8_STAGE(PG8_SA(0, 1), cA + hstep, voffA);
        if (wr == 1) PG8_BAR;
        PG8_WAIT_V(4); PG8_BAR;
        PG8_STAGE(PG8_SB(1, 0), cB + kstep, voffB); PG8_STAGE(PG8_SA(1, 0), cA + kstep, voffA); PG8_STAGE(PG8_SB(1, 1), cB + hstep + kstep, voffB);
        PG8_WAIT_V(6); PG8_BAR;
    }
    for (;;) {
        const bool has_next = S.next(ui + 1, nxt);
        if (has_next) { hstepn = (size_t)HALF * nxt.K * 2; PG8_VOFF(voffAn, voffBn, nxt.K); } else { hstepn = hstep; PG8_VOFF(voffAn, voffBn, K); }
        const char* nA = has_next ? (const char*)nxt.A + (size_t)nxt.pm * 2 * hstepn : cA; const char* nB = has_next ? (const char*)nxt.Bt + (size_t)nxt.pn * 2 * hstepn : cB;
        for (int t = 0; t < nt; t += 2) {
            const bool last = (t == nt - 2);
            const char* a1 = cA + (size_t)(t + 1) * kstep;
            const char* a2 = last ? nA : cA + (size_t)(t + 2) * kstep; const char* b2 = last ? nB : cB + (size_t)(t + 2) * kstep;
            const char* a3 = a2 + kstep; const char* b3 = b2 + kstep;
            unsigned vA2[2], vB2[2]; vA2[0] = last ? voffAn[0] : voffA[0]; vA2[1] = last ? voffAn[1] : voffA[1]; vB2[0] = last ? voffBn[0] : voffB[0]; vB2[1] = last ? voffBn[1] : voffB[1];
            const size_t hs2 = last ? hstepn : hstep;
            if (last && has_next) S.a_ready(nxt);
            if constexpr (SP2) {
            PG8_LDB(B0, 0, 0); PG8_LDB(B1, 0, 1); PG8_SCHED; PG8_LDA(At, 0, 0); PG8_STAGE(PG8_SA(1, 1), a1 + hstep, voffA);
            PG8_WAIT_V(8); PG8_WAIT_L(0); PG8_BAR; PG8_MMA(0, 0, At, B0); PG8_MMA(0, 1, At, B1); PG8_BAR; PG8_SCHED;
            PG8_LDA(At, 0, 1); PG8_STAGE(PG8_SB(0, 0), b2, vB2); PG8_STAGE(PG8_SB(0, 1), b2 + hs2, vB2); PG8_STAGE(PG8_SA(0, 0), a2, vA2);
            PG8_WAIT_V(8); PG8_WAIT_L(0); PG8_BAR; PG8_MMA(1, 0, At, B0); PG8_MMA(1, 1, At, B1); PG8_BAR; PG8_SCHED;
            PG8_LDB(B0, 1, 0); PG8_LDB(B1, 1, 1); PG8_SCHED; PG8_LDA(At, 1, 0); PG8_STAGE(PG8_SA(0, 1), a2 + hs2, vA2);
            PG8_WAIT_V(8); PG8_WAIT_L(0); PG8_BAR; PG8_MMA(0, 0, At, B0); PG8_MMA(0, 1, At, B1); PG8_BAR; PG8_SCHED;
            PG8_LDA(At, 1, 1); PG8_STAGE(PG8_SB(1, 0), b3, vB2); PG8_STAGE(PG8_SB(1, 1), b3 + hs2, vB2); PG8_STAGE(PG8_SA(1, 0), a3, vA2);
            PG8_WAIT_V(8); PG8_WAIT_L(0); PG8_BAR; PG8_MMA(1, 0, At, B0); PG8_MMA(1, 1, At, B1); PG8_BAR; PG8_SCHED;
            } else {
            PG8_LDB(B0, 0, 0); PG8_SCHED; PG8_LDA(At, 0, 0); PG8_STAGE(PG8_SA(1, 1), a1 + hstep, voffA);
            PG8_WAIT_L(8); PG8_BAR; PG8_WAIT_L(0); PG8_MMA(0, 0, At, B0); PG8_BAR; PG8_SCHED;
            PG8_LDB(B1, 0, 1); PG8_STAGE(PG8_SB(0, 0), b2, voffB);
            PG8_BAR; PG8_WAIT_L(0); PG8_MMA(0, 1, At, B1); PG8_BAR;
            PG8_LDA(At, 0, 1); PG8_STAGE(PG8_SA(0, 0), a2, voffA);
            PG8_BAR; PG8_WAIT_L(0); PG8_MMA(1, 0, At, B0); PG8_BAR; PG8_SCHED;
            PG8_STAGE(PG8_SB(0, 1), b2 + hstep, voffB);
            PG8_WAIT_V(6); PG8_BAR; PG8_MMA(1, 1, At, B1); PG8_BAR;
            PG8_LDB(B0, 1, 0); PG8_SCHED; PG8_LDA(At, 1, 0); PG8_STAGE(PG8_SA(0, 1), a2 + hstep, voffA);
            PG8_WAIT_L(8); PG8_BAR; PG8_WAIT_L(0); PG8_MMA(0, 0, At, B0); PG8_BAR; PG8_SCHED;
            PG8_LDB(B1, 1, 1); PG8_STAGE(PG8_SB(1, 0), b3, voffB);
            PG8_BAR; PG8_WAIT_L(0); PG8_MMA(0, 1, At, B1); PG8_BAR;
            PG8_LDA(At, 1, 1); PG8_STAGE(PG8_SA(1, 0), a3, voffA);
            PG8_BAR; PG8_WAIT_L(0); PG8_MMA(1, 0, At, B0); PG8_BAR; PG8_SCHED;
            PG8_STAGE(PG8_SB(1, 1), b3 + hstep, voffB);
            PG8_WAIT_V(6); PG8_BAR; PG8_MMA(1, 1, At, B1); PG8_BAR;
            }
        }
        if constexpr (ALIGN_EPI) { if (wr == 0) PG8_BAR; }
        if constexpr (!Epi::AFTER_DRAIN) { E(acc, cur, wr, wc, fr, fq); S.done(cur); }
        if (!has_next) break;
#pragma unroll
        for (int a = 0; a < 2; ++a)
#pragma unroll
            for (int b = 0; b < 2; ++b)
#pragma unroll
                for (int m = 0; m < 4; ++m)
#pragma unroll
                    for (int n = 0; n < 2; ++n) acc[a][b][m][n] = (f32x4){0.f, 0.f, 0.f, 0.f};
        cur = nxt; cA = nA; cB = nB; ++ui; K = cur.K; nt = K / BK; hstep = hstepn; voffA[0] = voffAn[0]; voffA[1] = voffAn[1]; voffB[0] = voffBn[0]; voffB[1] = voffBn[1];
        if constexpr (ALIGN_EPI) { if (wr == 1) PG8_BAR; }
    }
    PG8_WAIT_V(0);
    if constexpr (!ALIGN_EPI) { if (wr == 0) PG8_BAR; }
    PG8_BAR;
    if constexpr (Epi::AFTER_DRAIN) { E.fused(acc, cur, wr, wc, fr, fq, lds, wid, lane); S.done(cur); }
#undef PG8_SA
#undef PG8_SB
#undef PG8_STAGE
#undef PG8_LDA
#undef PG8_LDB
#undef PG8_MMA
#undef PG8_WAIT_V
#undef PG8_WAIT_L
#undef PG8_BAR
#undef PG8_SCHED
#undef PG8_VOFF
}


}
constexpr int BATCH = 4, SEQ = 4096, D = 1024, DRNN = 1280, NH = 20, FF = 4096, DEPTH = 2;
constexpr int M = BATCH * SEQ;
constexpr int DIN = 6656, NP1 = 4608;
constexpr int NSEG = 64;
constexpr int NWAVES = 8;
constexpr size_t KiB = 1024, MiB = 1u << 20;
constexpr size_t WS_SSQ = 0;
constexpr size_t WS_VST = 320 * KiB;
constexpr size_t WS_TS = 704 * KiB;
constexpr size_t WS_BAR = 640 * KiB;
constexpr size_t WS_ATOT = 1 * MiB, WS_HEND = 1 * MiB + 1280 * KiB;
constexpr size_t WS_W = 4 * MiB, W_LAYER = 37 * MiB;
constexpr size_t W_IN = 0, W_G = 9 * MiB, W_A = 13 * MiB, W_B = 15 * MiB + 512 * KiB, W_O = 17 * MiB + 512 * KiB, W_UP = 19 * MiB + 512 * KiB, W_DN = 27 * MiB + 512 * KiB,
                 W_L = 35 * MiB + 512 * KiB, W_S = 36 * MiB;
constexpr size_t WS_HALO = 254 * MiB;
constexpr size_t WS_XB = 78 * MiB;
constexpr size_t WS_XR = 110 * MiB, WS_GR = 150 * MiB, WS_U = 190 * MiB, WS_V = 222 * MiB, WS_END = 256 * MiB;
constexpr size_t WS_F = 110 * MiB;
constexpr size_t WS_S1 = WS_V, WS_S2 = WS_XR;
static_assert(WS_HEND + 1280 * KiB <= WS_W && WS_W + 2 * W_LAYER <= WS_XB && WS_XB + (size_t)M * D * 2 <= WS_XR && WS_F + (size_t)M * FF * 2 <= WS_HALO && WS_V + (size_t)M * D * 2 <= WS_HALO && WS_HALO + (size_t)(M / 64) * 3 * DRNN * 2 <= WS_END, "d_ws map");
static_assert(W_S + 8 * 128 * 128 * 2 <= W_LAYER && W_L + 2 * 20 * 64 * 64 * 2 <= W_S, "weight map");
constexpr int LDS_BYTES = 147456;
constexpr int NPHASE = 16;

#define LAS __attribute__((address_space(3)))
typedef unsigned short bf16;
typedef float f32x4 __attribute__((ext_vector_type(4)));
typedef short bf16x8 __attribute__((ext_vector_type(8)));
typedef unsigned u32x4 __attribute__((ext_vector_type(4)));
typedef unsigned u32x2 __attribute__((ext_vector_type(2)));
#define LDS_WAIT() asm volatile("s_waitcnt lgkmcnt(0)" ::: "memory")
using pg8::cvt_pk_bf16; using pg8::bf_lo; using pg8::bf_hi; using pg8::sigm;

__device__ __forceinline__ float wave_sum(float v) {
#pragma unroll
    for (int o = 1; o < 64; o <<= 1) v += __shfl_xor(v, o);
    return v;
}
struct Args { const float* in[21]; float* out; unsigned char* ws; int ph_lo, ph_hi; };
enum { I_X = 0, I_NMG, I_WIN, I_CW, I_CB, I_LWA, I_LBA, I_LWX, I_LBX, I_LAM, I_LNG, I_LNB, I_WS, I_BS, I_WA, I_WB, I_WO, I_NFG, I_WUP, I_WDN, I_FNG };
typedef const unsigned char __attribute__((address_space(4)))* kptr_t;
#define AIN(kp, i) (*(const float* const __attribute__((address_space(4)))*)((kp) + 8 * (i)))
struct CvtItem { const float* src; const float* ksc; bf16* dst; int ldw, K; };
__device__ __forceinline__ CvtItem cvt_decode(kptr_t kp, unsigned char* wl, int l, int r) {
    constexpr int J0 = 16 * 144, J1 = 16 * 64, J2 = 20 * 32, J3 = 16 * 32, J4 = 16 * 32, J5 = 16 * 128;
    const float* W; const float* ksc = nullptr; bf16* WT; int ldw, K, nblk;
    if (r < J0) { W = AIN(kp, I_WIN) + (size_t)l * D * DIN; ldw = DIN; K = D; nblk = NP1 / 32; WT = (bf16*)(wl + W_IN); ksc = AIN(kp, I_NMG) + l * D; }
    else if ((r -= J0) < J1) { W = AIN(kp, I_WIN) + (size_t)l * D * DIN + NP1; ldw = DIN; K = D; nblk = 2048 / 32; WT = (bf16*)(wl + W_G); ksc = AIN(kp, I_NMG) + l * D; }
    else if ((r -= J1) < J2) { W = AIN(kp, I_WA) + (size_t)l * DRNN * D; ldw = D; K = DRNN; nblk = D / 32; WT = (bf16*)(wl + W_A); }
    else if ((r -= J2) < J3) { W = AIN(kp, I_WB) + (size_t)l * D * D; ldw = D; K = D; nblk = D / 32; WT = (bf16*)(wl + W_B); }
    else if ((r -= J3) < J4) { W = AIN(kp, I_WO) + (size_t)l * D * D; ldw = D; K = D; nblk = D / 32; WT = (bf16*)(wl + W_O); }
    else if ((r -= J4) < J5) { W = AIN(kp, I_WUP) + (size_t)l * D * FF; ldw = FF; K = D; nblk = FF / 32; WT = (bf16*)(wl + W_UP); ksc = AIN(kp, I_NFG) + l * D; }
    else { r -= J5; W = AIN(kp, I_WDN) + (size_t)l * FF * D; ldw = D; K = FF; nblk = D / 32; WT = (bf16*)(wl + W_DN); }
    const int k0 = 64 * (r / nblk), n0 = 32 * (r % nblk);
    CvtItem c; c.src = W + (size_t)k0 * ldw + n0; c.ksc = ksc ? ksc + k0 : nullptr; c.dst = WT + (size_t)n0 * K + k0; c.ldw = ldw; c.K = K; return c;
}
constexpr int CVT_WIN = 16 * 144, CVT_ALL = 16 * 144 + 16 * 64 + 20 * 32 + 16 * 32 + 16 * 32 + 16 * 128 + 64 * 32;
__device__ __forceinline__ void convert_layer(kptr_t kp, unsigned char* ws, int l, int lo, int JL, LAS float* scr, int gw, int NGW, int lane) {
    gw += lo;
    unsigned char* wl = ws + WS_W + (size_t)l * W_LAYER;
    const int lr = lane >> 3, lc = (lane & 7) * 4;
    if (gw >= JL) return;
    CvtItem cur = cvt_decode(kp, wl, l, gw);
    f32x4 v[8];
#pragma unroll
    for (int i = 0; i < 8; ++i) v[i] = *(const f32x4*)(cur.src + (size_t)(lr + 8 * i) * cur.ldw + lc);
    for (int it = gw; it < JL; it += NGW) {
        const bool more = it + NGW < JL; CvtItem nxt = cur; f32x4 vn[8];
        if (more) { nxt = cvt_decode(kp, wl, l, it + NGW);
#pragma unroll
            for (int i = 0; i < 8; ++i) vn[i] = *(const f32x4*)(nxt.src + (size_t)(lr + 8 * i) * nxt.ldw + lc); }
        if (cur.ksc) {
#pragma unroll
            for (int i = 0; i < 8; ++i) v[i] = v[i] * cur.ksc[lr + 8 * i]; }
#pragma unroll
        for (int i = 0; i < 8; ++i) { LAS float* d = scr + (lr + 8 * i) * 33 + lc; d[0] = v[i][0]; d[1] = v[i][1]; d[2] = v[i][2]; d[3] = v[i][3]; }
        LDS_WAIT(); asm volatile("" ::: "memory");
        const int c = lane & 7;
#pragma unroll
        for (int j = 0; j < 4; ++j) { const int n = (lane >> 3) + 8 * j; const LAS float* s = scr + (8 * c) * 33 + n;
            u32x4 o; o.x = cvt_pk_bf16(s[0 * 33], s[1 * 33]); o.y = cvt_pk_bf16(s[2 * 33], s[3 * 33]); o.z = cvt_pk_bf16(s[4 * 33], s[5 * 33]); o.w = cvt_pk_bf16(s[6 * 33], s[7 * 33]);
            *(u32x4*)(cur.dst + (size_t)n * cur.K + 8 * c) = o; }
        LDS_WAIT(); asm volatile("" ::: "memory");
        if (more) { cur = nxt;
#pragma unroll
            for (int i = 0; i < 8; ++i) v[i] = vn[i]; }
    }
}
__device__ __forceinline__ void p0_prologue(kptr_t kp, unsigned char* ws, LAS unsigned char* lds, int gw, int NGW, int wave, int lane) {
    LAS float* scr = (LAS float*)(lds + wave * 16384);
    convert_layer(kp, ws, 0, 0, CVT_WIN, scr, gw, NGW, lane);
    const int gt = gw * 64 + lane, NGT = NGW * 64;
    for (int e = gt; e < DEPTH * 2 * NH * 64 * 64; e += NGT) {
        const int i = e & 63, j = (e >> 6) & 63, h = (e >> 12) % NH, g = ((e >> 12) / NH) & 1, l = (e >> 12) / (2 * NH);
        const float v = AIN(kp, g ? I_LWX : I_LWA)[(((size_t)l * NH + h) * 64 + i) * 64 + j];
        ((bf16*)(ws + WS_W + (size_t)l * W_LAYER + W_L))[(((size_t)g * NH + h) * 64 + j) * 64 + i] = (bf16)(cvt_pk_bf16(v, 0.f) & 0xffffu);
    }
    for (int e = gt; e < DEPTH * 8 * 128 * 128; e += NGT) {
        const int s = e & 127, t = (e >> 7) & 127, l = e >> 17;
        float v = AIN(kp, I_WS)[e]; if ((t >> 6) < (s >> 6)) v = 0.f;
        ((bf16*)(ws + WS_W + (size_t)l * W_LAYER + W_S))[e & 131071] = (bf16)(cvt_pk_bf16(v, 0.f) & 0xffffu);
    }
    { float* z = (float*)(ws + WS_SSQ) + M; for (int e = gt; e < 8 * M; e += NGT) z[e] = 0.f; }
    for (int m = gw; m < M; m += NGW) {
        const f32x4* xr = (const f32x4*)(AIN(kp, I_X) + (size_t)m * D) + lane; u32x2* o = (u32x2*)((bf16*)(ws + WS_XB) + (size_t)m * D) + lane; float s = 0.f;
#pragma unroll
        for (int j = 0; j < 4; ++j) { const f32x4 v = xr[64 * j]; s += (v.x * v.x + v.y * v.y) + (v.z * v.z + v.w * v.w); u32x2 w; w.x = cvt_pk_bf16(v.x, v.y); w.y = cvt_pk_bf16(v.z, v.w); o[64 * j] = w; }
        s = wave_sum(s); if (lane == 0) ((float*)(ws + WS_SSQ))[m] = pg8::tofix(s, pg8::FIX_SSQ);
    }
}

struct SguP { const bf16* V; bf16* U; const bf16* Ws; const float* bs; const float* lng; const float* lnb; const float* vsum; const float* vsq; };
__device__ __forceinline__ unsigned off_b(unsigned row, unsigned ch) { return 256u * row + 16u * (ch ^ (((row & 3) << 2) | ((row >> 2) & 3))); }
__device__ __forceinline__ unsigned tr_addr16(unsigned lane, unsigned c, unsigned ks, unsigned t) { const unsigned g = lane >> 4, q = (lane & 15) >> 2, p = lane & 3; return off_b(32 * ks + 8 * g + 4 * t + q, 2 * c + (p >> 1)) + 8 * (p & 1); }
__device__ __forceinline__ void sgu_dma(const SguP& P, LAS unsigned char* raw, int it, int wave, int lane) {
    const int b = it >> 8, blk = (it >> 3) & 31, g = it & 7, r0 = b * SEQ + blk * 128, c0 = g * 128;
#pragma unroll
    for (int j = 0; j < 4; ++j) { const int row = 16 * wave + 4 * j + (lane >> 4);
        __builtin_amdgcn_global_load_lds((const unsigned*)(P.V + (size_t)(r0 + row) * 1024 + c0 + (lane & 15) * 8), (LAS unsigned*)(raw + (16 * wave + 4 * j) * 256), 16, 0, 0); }
}
__device__ __forceinline__ void sgu_item(const SguP& P, LAS unsigned char* vt, LAS unsigned char* raw, int it_next, int b, int blk, int g, int tid, int wave, int lane) {
    const int r0 = b * SEQ + blk * 128, c0 = g * 128, n = lane & 15, q = lane >> 4;
    const int cc = (tid & 15) * 8;
    const f32x4 g0 = *(const f32x4*)(P.lng + c0 + cc), g1 = *(const f32x4*)(P.lng + c0 + cc + 4), b0 = *(const f32x4*)(P.lnb + c0 + cc), b1 = *(const f32x4*)(P.lnb + c0 + cc + 4);
    float vs1[4], vs2[4];
#pragma unroll
    for (int i = 0; i < 4; ++i) { const int row = r0 + ((tid + 512 * i) >> 4); vs1[i] = P.vsum[row]; vs2[i] = P.vsq[row]; }
    const int nkk = (wave < 4) ? 2 : 4;
    const bf16* Wg = P.Ws + (size_t)g * 128 * 128 + (size_t)(16 * wave + n) * 128 + 8 * q;
    bf16x8 Aw[4];
#pragma unroll
    for (int kk = 0; kk < 4; ++kk) Aw[kk] = (kk < nkk) ? *(const bf16x8*)(Wg + 32 * kk) : (bf16x8){0, 0, 0, 0, 0, 0, 0, 0};
    const int t = 16 * wave + n; const float bias = P.bs[g * 128 + t];
    bf16* ubase = P.U + (size_t)(r0 + t) * 1024 + c0 + 4 * q;
    u32x2 upre[8];
#pragma unroll
    for (int c = 0; c < 8; ++c) upre[c] = *(const u32x2*)(ubase + 16 * c);
    asm volatile("s_waitcnt vmcnt(0)" ::: "memory"); __syncthreads();
#pragma unroll
    for (int i = 0; i < 4; ++i) {
        const int chunk = tid + 512 * i, s = chunk >> 4, ch = chunk & 15;
        const float mu = pg8::unfix(vs1[i], pg8::FIX_V) * (1.0f / 1024.0f), var = fmaxf(pg8::unfix(vs2[i], pg8::FIX_V) * (1.0f / 1024.0f) - mu * mu, 0.f), rstd = __builtin_amdgcn_rsqf(var + 1e-6f);
        const u32x4 v = *(const LAS u32x4*)(raw + chunk * 16);
        float y[8];
        y[0] = (bf_lo(v.x) - mu) * rstd * g0[0] + b0[0]; y[1] = (bf_hi(v.x) - mu) * rstd * g0[1] + b0[1]; y[2] = (bf_lo(v.y) - mu) * rstd * g0[2] + b0[2]; y[3] = (bf_hi(v.y) - mu) * rstd * g0[3] + b0[3];
        y[4] = (bf_lo(v.z) - mu) * rstd * g1[0] + b1[0]; y[5] = (bf_hi(v.z) - mu) * rstd * g1[1] + b1[1]; y[6] = (bf_lo(v.w) - mu) * rstd * g1[2] + b1[2]; y[7] = (bf_hi(v.w) - mu) * rstd * g1[3] + b1[3];
        u32x4 w; w.x = cvt_pk_bf16(y[0], y[1]); w.y = cvt_pk_bf16(y[2], y[3]); w.z = cvt_pk_bf16(y[4], y[5]); w.w = cvt_pk_bf16(y[6], y[7]);
        *(LAS u32x4*)(vt + off_b(s, ch)) = w;
    }
    __syncthreads();
    if (it_next >= 0) sgu_dma(P, raw, it_next, wave, lane);
    const unsigned vb = (unsigned)(size_t)vt;
#pragma unroll
    for (int c = 0; c < 8; ++c) {
        typedef unsigned short u16x4 __attribute__((ext_vector_type(4)));
        u16x4 r[8]; unsigned ad[8];
#pragma unroll
        for (int kk = 0; kk < 4; ++kk) { ad[2 * kk] = vb + tr_addr16(lane, c, kk, 0); ad[2 * kk + 1] = vb + tr_addr16(lane, c, kk, 1); }
        asm volatile("ds_read_b64_tr_b16 %0, %8\n\tds_read_b64_tr_b16 %1, %9\n\tds_read_b64_tr_b16 %2, %10\n\tds_read_b64_tr_b16 %3, %11\n\t"
                     "ds_read_b64_tr_b16 %4, %12\n\tds_read_b64_tr_b16 %5, %13\n\tds_read_b64_tr_b16 %6, %14\n\tds_read_b64_tr_b16 %7, %15\n\ts_waitcnt lgkmcnt(0)"
                     : "=&v"(r[0]), "=&v"(r[1]), "=&v"(r[2]), "=&v"(r[3]), "=&v"(r[4]), "=&v"(r[5]), "=&v"(r[6]), "=&v"(r[7])
                     : "v"(ad[0]), "v"(ad[1]), "v"(ad[2]), "v"(ad[3]), "v"(ad[4]), "v"(ad[5]), "v"(ad[6]), "v"(ad[7]) : "memory");
        f32x4 d = (f32x4){0.f, 0.f, 0.f, 0.f};
#pragma unroll
        for (int kk = 0; kk < 4; ++kk) { if (kk < nkk) { bf16x8 Bv; Bv[0] = (short)r[2 * kk][0]; Bv[1] = (short)r[2 * kk][1]; Bv[2] = (short)r[2 * kk][2]; Bv[3] = (short)r[2 * kk][3];
            Bv[4] = (short)r[2 * kk + 1][0]; Bv[5] = (short)r[2 * kk + 1][1]; Bv[6] = (short)r[2 * kk + 1][2]; Bv[7] = (short)r[2 * kk + 1][3];
            d = __builtin_amdgcn_mfma_f32_16x16x32_bf16(Bv, Aw[kk], d, 0, 0, 0); } }
        const u32x2 uw = upre[c];
        u32x2 o; o.x = cvt_pk_bf16(bf_lo(uw.x) * (d[0] + bias), bf_hi(uw.x) * (d[1] + bias)); o.y = cvt_pk_bf16(bf_lo(uw.y) * (d[2] + bias), bf_hi(uw.y) * (d[3] + bias));
        *(u32x2*)(ubase + 16 * c) = o;
    }
}

struct RnnP { bf16* XR; bf16* GY; const bf16* HALO; const bf16* WL; const float* cw; const float* cb; const float* ba; const float* bx; const float* lam; float* Atot; float* Hend; };
constexpr int XL_LD = 68;
__device__ __forceinline__ float softplus_f(float z) { return fmaxf(z, 0.f) + log1pf(__expf(-fabsf(z))); }
__device__ __forceinline__ void rnn_item(const RnnP& P, LAS float* xl, int b, int h, int seg, int lane) {
    const int n = lane & 15, q = lane >> 4;
    const int cD = h * 64 + 4 * n;
    bf16x8 Wf[2][4][2];
#pragma unroll
    for (int g = 0; g < 2; ++g)
#pragma unroll
        for (int c = 0; c < 4; ++c)
#pragma unroll
            for (int ks = 0; ks < 2; ++ks) Wf[g][c][ks] = *(const bf16x8*)(P.WL + (((size_t)g * NH + h) * 64 + 4 * n + c) * 64 + 32 * ks + 8 * q);
    const f32x4 ba4 = *(const f32x4*)(P.ba + cD), bx4 = *(const f32x4*)(P.bx + cD), lam4 = *(const f32x4*)(P.lam + cD);
    float sp4[4];
#pragma unroll
    for (int c = 0; c < 4; ++c) sp4[c] = 8.0f * softplus_f(-lam4[c]);
    float hin[4] = {0.f, 0.f, 0.f, 0.f}, atot[4] = {1.f, 1.f, 1.f, 1.f};
    LAS float* wlp = xl + 16 * XL_LD;
#pragma unroll
    for (int k = 0; k < 5; ++k) wlp[k * 64 + lane] = (k < 4) ? P.cw[k * DRNN + h * 64 + lane] : P.cb[h * 64 + lane];
    u32x4 xn[2][4];
#define RNN_FETCH(NT) do { const int tl_ = 16 * (NT) + n; _Pragma("unroll") for (int ks = 0; ks < 2; ++ks) _Pragma("unroll") for (int k = 0; k < 4; ++k) { const int tl = tl_ - 3 + k;   \
        const bf16* src = (tl >= 0) ? P.XR + ((size_t)(b * SEQ + seg * 64 + tl)) * DRNN : P.HALO + ((size_t)((b * NSEG + (seg > 0 ? seg - 1 : 0)) * 3 + (tl + 3))) * DRNN; \
        u32x4 xv = *(const u32x4*)(src + h * 64 + 32 * ks + 8 * q); if (tl < 0 && seg == 0) xv = (u32x4){0u, 0u, 0u, 0u}; xn[ks][k] = xv; } } while (0)
    RNN_FETCH(0);
#pragma unroll 1
    for (int nt = 0; nt < 4; ++nt) {
        asm volatile("" ::: "memory");
        const int t0 = seg * 64 + 16 * nt;
        bf16x8 Xf[2];
#pragma unroll
        for (int ks = 0; ks < 2; ++ks) {
            const LAS float* wq = wlp + 32 * ks + 8 * q;
            f32x4 x0 = *(const LAS f32x4*)(wq + 4 * 64), x1 = *(const LAS f32x4*)(wq + 4 * 64 + 4);
#pragma unroll
            for (int k = 0; k < 4; ++k) { const u32x4 xv = xn[ks][k];
                const f32x4 w0 = *(const LAS f32x4*)(wq + k * 64), w1 = *(const LAS f32x4*)(wq + k * 64 + 4);
                x0[0] += bf_lo(xv.x) * w0[0]; x0[1] += bf_hi(xv.x) * w0[1]; x0[2] += bf_lo(xv.y) * w0[2]; x0[3] += bf_hi(xv.y) * w0[3];
                x1[0] += bf_lo(xv.z) * w1[0]; x1[1] += bf_hi(xv.z) * w1[1]; x1[2] += bf_lo(xv.w) * w1[2]; x1[3] += bf_hi(xv.w) * w1[3]; }
            *(LAS f32x4*)(xl + n * XL_LD + 32 * ks + 8 * q) = x0; *(LAS f32x4*)(xl + n * XL_LD + 32 * ks + 8 * q + 4) = x1;
            u32x4 w; w.x = cvt_pk_bf16(x0[0], x0[1]); w.y = cvt_pk_bf16(x0[2], x0[3]); w.z = cvt_pk_bf16(x1[0], x1[1]); w.w = cvt_pk_bf16(x1[2], x1[3]);
            Xf[ks] = __builtin_bit_cast(bf16x8, w);
        }
        if (nt < 3) RNN_FETCH(nt + 1);
        u32x2 gpre[4];
#pragma unroll
        for (int jj = 0; jj < 4; ++jj) gpre[jj] = *(const u32x2*)(P.GY + ((size_t)(b * SEQ + t0 + 4 * q + jj)) * DRNN + cD);
        f32x4 Da[4], Dx[4];
#pragma unroll
        for (int c = 0; c < 4; ++c) {
            Da[c] = __builtin_amdgcn_mfma_f32_16x16x32_bf16(Xf[0], Wf[0][c][0], (f32x4){0.f, 0.f, 0.f, 0.f}, 0, 0, 0); Da[c] = __builtin_amdgcn_mfma_f32_16x16x32_bf16(Xf[1], Wf[0][c][1], Da[c], 0, 0, 0);
            Dx[c] = __builtin_amdgcn_mfma_f32_16x16x32_bf16(Xf[0], Wf[1][c][0], (f32x4){0.f, 0.f, 0.f, 0.f}, 0, 0, 0); Dx[c] = __builtin_amdgcn_mfma_f32_16x16x32_bf16(Xf[1], Wf[1][c][1], Dx[c], 0, 0, 0);
        }
        f32x4 xd[4];
#pragma unroll
        for (int jj = 0; jj < 4; ++jj) xd[jj] = *(const LAS f32x4*)(xl + (4 * q + jj) * XL_LD + 4 * n);
        float hh[4][4], pp[4][4];
#pragma unroll
        for (int c = 0; c < 4; ++c) {
            float av[4], uv[4];
#pragma unroll
            for (int jj = 0; jj < 4; ++jj) {
                const float r = sigm(Da[c][jj] + ba4[c]), ig = sigm(Dx[c][jj] + bx4[c]);
                const float la = -r * sp4[c];
                float d = -la * (1.0f + la * (0.5f + la * (0.16666667f + la * (0.041666668f + la * (0.0083333338f + la * (0.0013888889f + la * 0.0001984127f))))));
                if (__builtin_expect(__any(la < -0.35f), 0)) { if (la < -0.35f) d = 1.0f - __builtin_amdgcn_exp2f(1.44269504f * la); }
                av[jj] = 1.0f - d;
                uv[jj] = __builtin_amdgcn_sqrtf(d * (2.0f - d)) * (ig * xd[jj][c]);
            }
            pp[c][0] = av[0]; hh[c][0] = uv[0];
#pragma unroll
            for (int jj = 1; jj < 4; ++jj) { hh[c][jj] = av[jj] * hh[c][jj - 1] + uv[jj]; pp[c][jj] = av[jj] * pp[c][jj - 1]; }
        }
        float Aq[4], Hq[4], Ax[4], Hx[4];
#pragma unroll
        for (int c = 0; c < 4; ++c) { Aq[c] = pp[c][3]; Hq[c] = hh[c][3]; }
#pragma unroll
        for (int c = 0; c < 4; ++c) { Ax[c] = __shfl_up(Aq[c], 16); Hx[c] = __shfl_up(Hq[c], 16); }
#pragma unroll
        for (int c = 0; c < 4; ++c) if (q >= 1) { Hq[c] = Aq[c] * Hx[c] + Hq[c]; Aq[c] = Aq[c] * Ax[c]; }
#pragma unroll
        for (int c = 0; c < 4; ++c) { Ax[c] = __shfl_up(Aq[c], 32); Hx[c] = __shfl_up(Hq[c], 32); }
#pragma unroll
        for (int c = 0; c < 4; ++c) if (q >= 2) { Hq[c] = Aq[c] * Hx[c] + Hq[c]; Aq[c] = Aq[c] * Ax[c]; }
        float A3[4], H3[4];
#pragma unroll
        for (int c = 0; c < 4; ++c) { Ax[c] = __shfl_up(Aq[c], 16); Hx[c] = __shfl_up(Hq[c], 16); A3[c] = __shfl(Aq[c], 48 + n); H3[c] = __shfl(Hq[c], 48 + n); }
#pragma unroll
        for (int c = 0; c < 4; ++c) {
            if (q == 0) { Ax[c] = 1.f; Hx[c] = 0.f; }
            const float cin = Hx[c] + Ax[c] * hin[c], pin = Ax[c] * atot[c];
#pragma unroll
            for (int jj = 0; jj < 4; ++jj) { hh[c][jj] = hh[c][jj] + pp[c][jj] * cin; pp[c][jj] = pp[c][jj] * pin; }
            hin[c] = H3[c] + A3[c] * hin[c]; atot[c] *= A3[c];
        }
#pragma unroll
        for (int jj = 0; jj < 4; ++jj) { const size_t o = ((size_t)(b * SEQ + t0 + 4 * q + jj)) * DRNN + cD; const u32x2 gw = gpre[jj];
            const float g0 = bf_lo(gw.x), g1 = bf_hi(gw.x), g2 = bf_lo(gw.y), g3 = bf_hi(gw.y);
            u32x2 oy; oy.x = cvt_pk_bf16(hh[0][jj] * g0, hh[1][jj] * g1); oy.y = cvt_pk_bf16(hh[2][jj] * g2, hh[3][jj] * g3); *(u32x2*)(P.GY + o) = oy;
            u32x2 op; op.x = cvt_pk_bf16(pp[0][jj] * g0, pp[1][jj] * g1); op.y = cvt_pk_bf16(pp[2][jj] * g2, pp[3][jj] * g3); *(u32x2*)(P.XR + o) = op; }
    }
    if (q == 0) { const size_t o = ((size_t)(b * NSEG + seg)) * DRNN + cD;
        *(f32x4*)(P.Atot + o) = (f32x4){atot[0], atot[1], atot[2], atot[3]}; *(f32x4*)(P.Hend + o) = (f32x4){hin[0], hin[1], hin[2], hin[3]}; }
}
__device__ __forceinline__ void rnn_apply(const RnnP& P, LAS float* cl, int b, int seg, int tid) {
    if (seg == 0) return;
    {
        float H[3] = {0.f, 0.f, 0.f};
        for (int s0 = 0; s0 < seg; s0 += 16) { float as[3][16], hs[3][16];
#pragma unroll
            for (int k = 0; k < 3; ++k) { const int c = tid + k * NWAVES * 64;
#pragma unroll
                for (int j = 0; j < 16; ++j) { const bool in = (s0 + j < seg) && (c < DRNN); const size_t o = ((size_t)(b * NSEG + (in ? s0 + j : 0))) * DRNN + (in ? c : 0); as[k][j] = in ? P.Atot[o] : 1.f; hs[k][j] = in ? P.Hend[o] : 0.f; } }
#pragma unroll
            for (int k = 0; k < 3; ++k)
#pragma unroll
                for (int j = 0; j < 16; ++j) H[k] = as[k][j] * H[k] + hs[k][j]; }
#pragma unroll
        for (int k = 0; k < 3; ++k) { const int c = tid + k * NWAVES * 64; if (c < DRNN) cl[c] = H[k]; }
    }
    __syncthreads();
    for (int i = tid; i < 64 * (DRNN / 8); i += NWAVES * 64) { const int r = i / (DRNN / 8), ch = (i % (DRNN / 8)) * 8; const size_t o = ((size_t)(b * SEQ + seg * 64 + r)) * DRNN + ch;
        const u32x4 y = *(const u32x4*)(P.GY + o), p = *(const u32x4*)(P.XR + o); const f32x4 c0 = *(const LAS f32x4*)(cl + ch), c1 = *(const LAS f32x4*)(cl + ch + 4);
        u32x4 w; w.x = cvt_pk_bf16(bf_lo(y.x) + bf_lo(p.x) * c0[0], bf_hi(y.x) + bf_hi(p.x) * c0[1]); w.y = cvt_pk_bf16(bf_lo(y.y) + bf_lo(p.y) * c0[2], bf_hi(y.y) + bf_hi(p.y) * c0[3]);
        w.z = cvt_pk_bf16(bf_lo(y.z) + bf_lo(p.z) * c1[0], bf_hi(y.z) + bf_hi(p.z) * c1[1]); w.w = cvt_pk_bf16(bf_lo(y.w) + bf_lo(p.w) * c1[2], bf_hi(y.w) + bf_hi(p.w) * c1[3]);
        *(u32x4*)(P.GY + o) = w; }
    __syncthreads();
}
#define XB_TMO      128
#define XB_XCNT(j)  (256  + 64 * (j))
#define XB_XSUB(j)  (1280 + 64 * (j))
#define XB_XGEN(j)  (2304 + 64 * (j))
#define XB_TOP      3328
#define XB_TOPGEN   3392
#define XCD_BAR_WORDS 3456
#define XB_SPIN_CAP (1u << 18)

__device__ __forceinline__ unsigned xb_ld(unsigned* p)              { return __hip_atomic_load(p, __ATOMIC_RELAXED, __HIP_MEMORY_SCOPE_AGENT); }
__device__ __forceinline__ unsigned xb_add(unsigned* p, unsigned v) { return __hip_atomic_fetch_add(p, v, __ATOMIC_RELAXED, __HIP_MEMORY_SCOPE_AGENT); }
__device__ __forceinline__ unsigned xb_xcc_id() { return (unsigned)__builtin_amdgcn_s_getreg((3 << 11) | 20) & 0xFu; }
#define XB_SPIN(cond, bar) do { unsigned _sp = 0; while (cond) { __builtin_amdgcn_s_sleep(1); \
    if ((++_sp & 255u) == 0u) { if (xb_ld(&(bar)[XB_TMO])) break; if (_sp > XB_SPIN_CAP) { atomicAdd(&(bar)[XB_TMO], 1u); break; } } } } while (0)

struct XcdBarrier {
    unsigned* bar; unsigned x;
    volatile LAS unsigned* st;
};

__device__ __forceinline__ XcdBarrier xcd_barrier_post(unsigned* bar, volatile LAS unsigned* st) {
    XcdBarrier b; b.bar = bar; b.x = xb_xcc_id(); b.st = st;
    if (threadIdx.x == 0) (void)xb_add(&bar[XB_XCNT(b.x)], 1u);
    return b;
}
__device__ __forceinline__ void xcd_barrier_complete(unsigned* bar, unsigned x, unsigned& nloc, unsigned& nx) {
    const unsigned G = gridDim.x * gridDim.y * gridDim.z;
    unsigned sum, cnt, mine, sp = 0u;
    for (;;) {
        sum = 0u; cnt = 0u; mine = 0u;
#pragma unroll
        for (unsigned j = 0; j < 16; ++j) { const unsigned c = xb_ld(&bar[XB_XCNT(j)]); sum += c; cnt += (c > 0u) ? 1u : 0u; mine = (j == x) ? c : mine; }
        if (sum == G) break;
        __builtin_amdgcn_s_sleep(1);
        if ((++sp & 255u) == 0u) { if (xb_ld(&bar[XB_TMO])) break; if (sp > XB_SPIN_CAP) { atomicAdd(&bar[XB_TMO], 1u); break; } }
    }
    nloc = mine > 0u ? mine : 1u; nx = cnt > 0u ? cnt : 1u;
}

__device__ __forceinline__ void xcd_barrier(const XcdBarrier& b) {
    asm volatile("s_waitcnt vmcnt(0)" ::: "memory");
    __syncthreads();
    if (threadIdx.x == 0) {
        unsigned* bar = b.bar;
        __builtin_amdgcn_s_waitcnt(0);
        unsigned nloc = b.st[0], nx = b.st[1];
        if (nloc == 0u) { xcd_barrier_complete(bar, b.x, nloc, nx); b.st[0] = nloc; b.st[1] = nx; }
        const unsigned old = xb_add(&bar[XB_XSUB(b.x)], 1u);
        const unsigned gen = old / nloc;
        if (old + 1u == (gen + 1u) * nloc) {
            __builtin_amdgcn_fence(__ATOMIC_RELEASE, "agent");
            asm volatile("s_waitcnt vmcnt(0)" ::: "memory");
            const unsigned og = xb_add(&bar[XB_TOP], 1u);
            const unsigned tg = og / nx;
            if (og + 1u == (tg + 1u) * nx) xb_add(&bar[XB_TOPGEN], 1u);
            else XB_SPIN(xb_ld(&bar[XB_TOPGEN]) == tg, bar);
            __builtin_amdgcn_fence(__ATOMIC_ACQUIRE, "agent");
            xb_add(&bar[XB_XGEN(b.x)], 1u);
            asm volatile("s_waitcnt vmcnt(0)" ::: "memory");
        } else {
            XB_SPIN(xb_ld(&bar[XB_XGEN(b.x)]) == gen, bar);
            __builtin_amdgcn_fence(__ATOMIC_ACQUIRE, "agent");
            asm volatile("s_waitcnt vmcnt(0)" ::: "memory");
        }
    }
    __syncthreads();
}
#ifndef PH_HI
#define PH_HI NPHASE
#endif
#ifndef PH_MASK
#define PH_MASK 511
#endif

struct P3Sched {
    pg8::StaticOrder S0; const bf16 *XB, *WG, *YA, *WA, *YB, *WB;
    __device__ __forceinline__ bool next(int i, pg8::UnitX& u) const { pg8::Unit t; if (!S0.next(i >> 2, t)) return false; const int s = i & 3; u.pm = t.pm; u.pn = t.pn; u.kind = s;
        if (s == 0) { u.A = XB; u.Bt = WG; u.K = D; } else if (s == 1) { u.A = YA; u.Bt = WA; u.K = DRNN; } else if (s == 2) { u.A = XB; u.Bt = WG + (size_t)D * D; u.K = D; } else { u.A = YB; u.Bt = WB; u.K = D; }
        return true; }
    __device__ __forceinline__ void a_ready(const pg8::UnitX&) const {}
    __device__ __forceinline__ void done(const pg8::UnitX&) const {}
};
struct EpiP3 {
    static constexpr bool PERM = true, AFTER_DRAIN = false;
    pg8::EpiGate8 ga, gb; pg8::EpiMix<false> ma; pg8::EpiMix<true> mb;
    __device__ __forceinline__ void operator()(const pg8::f32x4 (&acc)[2][2][4][2], const pg8::UnitX& u, int wr, int wc, int fr, int fq) const {
        const pg8::Unit t{u.pm, u.pn};
        if (u.kind == 0) ga(acc, t, wr, wc, fr, fq); else if (u.kind == 1) ma(acc, t, wr, wc, fr, fq); else if (u.kind == 2) gb(acc, t, wr, wc, fr, fq); else mb(acc, t, wr, wc, fr, fq);
    }
};

__global__ void __launch_bounds__(NWAVES * 64, 2) fwd_megakernel(Args a) {
    extern __shared__ __attribute__((aligned(16))) unsigned char lds_raw[];
    LAS unsigned char* lds = (LAS unsigned char*)lds_raw;
    cg::grid_group grid = cg::this_grid();
    { LAS unsigned* z = (LAS unsigned*)(lds + 131072); if (threadIdx.x < 64) z[threadIdx.x] = 0u; }
    __syncthreads();
    grid.sync();
    (void)xcd_barrier_post((unsigned*)(*(unsigned char* const __attribute__((address_space(4)))*)((kptr_t)__builtin_amdgcn_kernarg_segment_ptr() + 176) + WS_BAR), (volatile LAS unsigned*)(lds + 131072 + 32));
    int tid = threadIdx.x, G = gridDim.x, bx = blockIdx.x;
    kptr_t kp = (kptr_t)__builtin_amdgcn_kernarg_segment_ptr();
    unsigned char* ws = *(unsigned char* const __attribute__((address_space(4)))*)(kp + 176);
    float* const outp = *(float* const __attribute__((address_space(4)))*)(kp + 168);
    const int ph_lo = *(const int __attribute__((address_space(4)))*)(kp + 184), ph_hi = *(const int __attribute__((address_space(4)))*)(kp + 188);
#define REFRESH_PTRS() asm volatile("" : "+s"(ws), "+s"(kp))
    float* ssq = (float*)(ws + WS_SSQ); float* vst = (float*)(ws + WS_VST);
    bf16* XB = (bf16*)(ws + WS_XB); bf16* XR = (bf16*)(ws + WS_XR); bf16* GR = (bf16*)(ws + WS_GR); bf16* U = (bf16*)(ws + WS_U); bf16* V = (bf16*)(ws + WS_V);
    bf16* F = (bf16*)(ws + WS_F); bf16* S1 = (bf16*)(ws + WS_S1); bf16* S2 = (bf16*)(ws + WS_S2);

    for (int ph = ph_lo; ph < ph_hi; ++ph) {
        if (ph > ph_lo) { XcdBarrier bar; bar.bar = (unsigned*)(ws + WS_BAR); bar.x = xb_xcc_id(); bar.st = (volatile LAS unsigned*)(lds + 131072 + 32); xcd_barrier(bar); }
#ifdef TS_SEL
        if (blockIdx.x == 0 && threadIdx.x == 0) ((unsigned long long*)(ws + WS_TS))[ph] = __builtin_amdgcn_s_memrealtime();
        if (ph == NPHASE - 1) { XcdBarrier bar; bar.bar = (unsigned*)(ws + WS_BAR); bar.x = xb_xcc_id(); bar.st = (volatile LAS unsigned*)(lds + 131072 + 32); xcd_barrier(bar); }
#endif
        asm volatile("" : "+s"(ws)); asm volatile("" : "+s"(kp)); asm volatile("" : "+v"(tid)); asm volatile("" : "+s"(G)); asm volatile("" : "+s"(bx));
        const int lane = tid & 63, wave = __builtin_amdgcn_readfirstlane(tid >> 6);
        const int vcu = (G % 8 == 0) ? (bx % 8) * (G / 8) + bx / 8 : bx;
        const int gw = vcu * NWAVES + wave, NGW = G * NWAVES;
        ssq = (float*)(ws + WS_SSQ); vst = (float*)(ws + WS_VST); XB = (bf16*)(ws + WS_XB); XR = (bf16*)(ws + WS_XR); GR = (bf16*)(ws + WS_GR); U = (bf16*)(ws + WS_U); V = (bf16*)(ws + WS_V);
        F = (bf16*)(ws + WS_F); S1 = (bf16*)(ws + WS_S1); S2 = (bf16*)(ws + WS_S2);
        if (ph == 0) { if (PH_MASK & 256) p0_prologue(kp, ws, lds, gw, NGW, wave, lane); continue; }
        if (ph == NPHASE - 1) {
            const float* gf = AIN(kp, I_FNG);
            for (int m = gw; m < M; m += NGW) { f32x4* xr = (f32x4*)(outp + (size_t)m * D) + lane; const u32x2* xbr = (const u32x2*)(XB + (size_t)m * D) + lane; f32x4 v[4]; float s = 0.f;
#pragma unroll
                for (int j = 0; j < 4; ++j) { const u32x2 w = xbr[64 * j]; v[j] = (f32x4){bf_lo(w.x), bf_hi(w.x), bf_lo(w.y), bf_hi(w.y)}; s += (v[j].x * v[j].x + v[j].y * v[j].y) + (v[j].z * v[j].z + v[j].w * v[j].w); }
                const float rs = __builtin_amdgcn_rsqf(wave_sum(s) * (1.0f / 1024.0f) + pg8::RMS_EPS);
#pragma unroll
                for (int j = 0; j < 4; ++j) { const f32x4 g4 = *((const f32x4*)gf + lane + 64 * j); f32x4 o = v[j] * rs * g4;
#ifdef TS_SEL
                    { const unsigned long long* ts = (const unsigned long long*)(ws + WS_TS); unsigned long long sel = 0; const int ids[] = TS_SEL;
                      for (unsigned k = 0; k < sizeof(ids) / sizeof(int); ++k) sel += ts[ids[k] + 1] - ts[ids[k]];
                      const float frac = (float)sel / (float)(ts[NPHASE - 1] - ts[0]), dlt = 0.02f * sqrtf(frac); o += (f32x4){dlt, -dlt, dlt, -dlt}; }
#endif
                    xr[64 * j] = o; } }
            continue;
        }
        const int l = (ph - 1) / 7, sub = (ph - 1) % 7;
        const unsigned char* wl = ws + WS_W + (size_t)l * W_LAYER;
        if (sub == 0 && (PH_MASK & 1)) {
            pg8::Gemm g{XB, (const bf16*)(wl + W_IN), M, NP1, D}; pg8::StaticOrder S; S.init(M, NP1, G, bx);
            pg8::EpiIn E{XR, GR, U, V, (bf16*)(ws + WS_HALO), ssq + (2 * l) * M, vst + (2 * l) * M, vst + (2 * l + 1) * M};
            pg8::gemm_phase<pg8::EpiIn, pg8::StaticOrder, true, true>(lds, g, S, E, tid);
            {
                const int rounds = (S.nwg + G - 1) / G, nidle = rounds * G - S.nwg, first_idle = G - nidle;
                const bool all = (nidle == 0); const int cg = all ? gw : (bx - first_idle) * NWAVES + wave, cn = all ? NGW : nidle * NWAVES;
                if (all || bx >= first_idle) { LAS float* scr = (LAS float*)(lds + wave * 16384);
                    convert_layer(kp, ws, l, CVT_WIN, CVT_ALL, scr, cg, cn, lane);
                    if (l + 1 < DEPTH) convert_layer(kp, ws, l + 1, 0, CVT_WIN, scr, cg, cn, lane); }
            }
        }
#ifdef NAIVE_MIX
        else if (sub == 1) { naive_vstats(V, vst + (2 * l) * M, vst + (2 * l + 1) * M, gw, NGW, lane); }
        else if (sub == 2) {
            naive_sgu(V, U, AIN(kp, I_WS) + (size_t)l * 8 * 128 * 128, AIN(kp, I_BS) + l * 1024, AIN(kp, I_LNG) + l * 1024, AIN(kp, I_LNB) + l * 1024, vst + (2 * l) * M, vst + (2 * l + 1) * M, gw * 64 + lane, NGW * 64);
            naive_rnn(XR, GR, AIN(kp, I_LWA) + (size_t)l * NH * 4096, AIN(kp, I_LWX) + (size_t)l * NH * 4096, AIN(kp, I_LBA) + l * DRNN, AIN(kp, I_LBX) + l * DRNN, AIN(kp, I_LAM) + l * DRNN, AIN(kp, I_CW) + l * 4 * DRNN, AIN(kp, I_CB) + l * DRNN, gw, NGW, lane);
        }
#endif
        else if (sub == 1 && (PH_MASK & 2)) {
            SguP P{V, U, (const bf16*)(wl + W_S), AIN(kp, I_BS) + l * 1024, AIN(kp, I_LNG) + l * 1024, AIN(kp, I_LNB) + l * 1024, vst + (2 * l) * M, vst + (2 * l + 1) * M};
            { LAS unsigned char* raw = lds + 32768; if (vcu < BATCH * 32 * 8) sgu_dma(P, raw, vcu, wave, lane);
              for (int it = vcu; it < BATCH * 32 * 8; it += G) sgu_item(P, lds, raw, (it + G < BATCH * 32 * 8) ? it + G : -1, it >> 8, (it >> 3) & 31, it & 7, tid, wave, lane);
              __syncthreads(); }
            RnnP R{XR, GR, (const bf16*)(ws + WS_HALO), (const bf16*)(wl + W_L), AIN(kp, I_CW) + l * 4 * DRNN, AIN(kp, I_CB) + l * DRNN, AIN(kp, I_LBA) + l * DRNN, AIN(kp, I_LBX) + l * DRNN, AIN(kp, I_LAM) + l * DRNN,
                   (float*)(ws + WS_ATOT), (float*)(ws + WS_HEND)};
            LAS float* xl = (LAS float*)(lds + 40960 + wave * 6144);
            { const int per = (BATCH * NH * NSEG + G - 1) / G, base = vcu * per, lim = min(base + per, BATCH * NH * NSEG);
              for (int j = wave; j < per; j += NWAVES) { const int it = base + j; if (it < lim) rnn_item(R, xl, (it / NH) % BATCH, it % NH, it / (NH * BATCH), lane); } }
        } else if (sub == 2 && (PH_MASK & 4)) {
            RnnP R{XR, GR, (const bf16*)(ws + WS_HALO), (const bf16*)(wl + W_L), AIN(kp, I_CW) + l * 4 * DRNN, AIN(kp, I_CB) + l * DRNN, AIN(kp, I_LBA) + l * DRNN, AIN(kp, I_LBX) + l * DRNN, AIN(kp, I_LAM) + l * DRNN,
                   (float*)(ws + WS_ATOT), (float*)(ws + WS_HEND)};
            for (int it = vcu; it < BATCH * NSEG; it += G) rnn_apply(R, (LAS float*)lds, it / NSEG, it % NSEG, tid);
        } else if (sub == 3 && (PH_MASK & 8)) {
            pg8::StaticOrder S; S.init(M, D, G, bx);
            unsigned char* G8 = (unsigned char*)outp;
            P3Sched PS{S, XB, (const bf16*)(wl + W_G), GR, (const bf16*)(wl + W_A), U, (const bf16*)(wl + W_B)};
            EpiP3 E{pg8::EpiGate8{G8, ssq + (2 * l) * M}, pg8::EpiGate8{G8 + (size_t)M * D, ssq + (2 * l) * M}, pg8::EpiMix<false>{S1, G8}, pg8::EpiMix<true>{S1, G8 + (size_t)M * D}};
            pg8::gemm_phase_multi<EpiP3, P3Sched, true, true>(lds, PS, E, tid);
        } else if (sub == 4 && (PH_MASK & 16)) {
            pg8::Gemm g{S1, (const bf16*)(wl + W_O), M, D, D}; pg8::StaticOrder S; S.init(M, D, G, bx);
            pg8::EpiRes E{XB, ssq + (2 * l + 1) * M};
            pg8::gemm_phase<pg8::EpiRes, pg8::StaticOrder, true, true>(lds, g, S, E, tid);
        } else if (sub == 5 && (PH_MASK & 32)) {
            pg8::Gemm g{XB, (const bf16*)(wl + W_UP), M, FF, D}; pg8::StaticOrder S; S.init(M, FF, G, bx);
            pg8::EpiAct<1> E{F, FF, ssq + (2 * l + 1) * M};
            pg8::gemm_phase<pg8::EpiAct<1>, pg8::StaticOrder, true, true>(lds, g, S, E, tid);
        } else if (PH_MASK & 64) {
            pg8::Gemm g{F, (const bf16*)(wl + W_DN), M, D, FF}; pg8::StaticOrder S; S.init(M, D, G, bx);
            pg8::EpiRes E{XB, ssq + (2 * l + 2) * M};
            pg8::gemm_phase<pg8::EpiRes, pg8::StaticOrder, true, true>(lds, g, S, E, tid);
        }
    }
}

extern "C" void kernel_launch(void* const* d_in, const int* in_sizes, int n_in, void* d_out, int out_size, void* d_ws, size_t ws_size, hipStream_t stream) {
    static int grid = 0;
    if (grid == 0) {
        if (n_in != 21 || out_size != M * D || ws_size < WS_END) { fprintf(stderr, "kernel_launch: unexpected shapes (n_in %d, out %d, ws %zu); nothing launched\n", n_in, out_size, ws_size); grid = -1; return; }
        int dev = 0, cus = 0, per_cu = 0;
        if (hipGetDevice(&dev) != hipSuccess || hipDeviceGetAttribute(&cus, hipDeviceAttributeMultiprocessorCount, dev) != hipSuccess) { grid = -1; return; }
        if (hipFuncSetAttribute((const void*)fwd_megakernel, hipFuncAttributeMaxDynamicSharedMemorySize, LDS_BYTES) != hipSuccess) { fprintf(stderr, "kernel_launch: hipFuncSetAttribute failed\n"); grid = -1; return; }
        if (hipOccupancyMaxActiveBlocksPerMultiprocessor(&per_cu, (const void*)fwd_megakernel, NWAVES * 64, LDS_BYTES) != hipSuccess || per_cu < 1) per_cu = 1;
        (void)hipGetLastError();
        grid = cus * per_cu;
        fprintf(stderr, "kernel_launch: %d CUs x %d -> grid %d, ws %zu\n", cus, per_cu, grid, ws_size);
    }
    if (grid < 0) return;
#ifdef EXP_POISON
    (void)hipMemsetAsync(d_ws, 0xAA, WS_END, stream); (void)hipMemsetAsync(d_out, 0xAA, (size_t)M * D * 4, stream);
#endif
    if (hipMemsetAsync((char*)d_ws + WS_BAR, 0, 16384, stream) != hipSuccess) { fprintf(stderr, "kernel_launch: hipMemsetAsync failed\n"); return; }
    Args a{};
    for (int i = 0; i < 21; ++i) a.in[i] = (const float*)d_in[i];
    a.out = (float*)d_out; a.ws = (unsigned char*)d_ws; a.ph_lo = 0; a.ph_hi = PH_HI;
    void* args[] = {&a};
    const hipError_t e = hipLaunchCooperativeKernel((const void*)fwd_megakernel, dim3(grid), dim3(NWAVES * 64), args, LDS_BYTES, stream);
    if (e != hipSuccess) fprintf(stderr, "kernel_launch: cooperative launch failed: %s (grid %d)\n", hipGetErrorString(e), grid);
}
```

```cpp
#include <hip/hip_runtime.h>
#include <hip/hip_cooperative_groups.h>
#include <cstdio>
#include <cstdint>
namespace cg = cooperative_groups;
namespace pg8 {
#define PG8_LAS __attribute__((address_space(3)))
typedef unsigned short bf16_t;
typedef short bf16x8 __attribute__((ext_vector_type(8)));
typedef float f32x4 __attribute__((ext_vector_type(4)));
typedef unsigned u32x4 __attribute__((ext_vector_type(4)));
typedef unsigned u32x2 __attribute__((ext_vector_type(2)));
constexpr int BM = 256, BK = 64, HALF = 128, HTB = HALF * BK * 2, STAGE_BYTES = 8 * HTB, NXCD = 8, WGM = 4;
__host__ __device__ __forceinline__ int lds_byte(int r, int c) { const int st = (r >> 4) * 2 + (c >> 5), rr = r & 15, cc = c & 31, ob = rr * 64 + cc * 2; return st * 1024 + (ob ^ (((ob >> 9) & 1) << 5)); }
__host__ __device__ __forceinline__ void stage_rc(int b, int& R, int& C) { const int st = b / 1024, sb = b % 1024, swz = sb ^ (((sb >> 9) & 1) << 5); R = (st >> 1) * 16 + swz / 64; C = (st & 1) * 32 + (swz % 64) / 2; }
__host__ __device__ __forceinline__ int perm32(int rho) { const int n = rho >> 4, i = rho & 15; return 8 * (i >> 2) + 4 * n + (i & 3); }
struct Unit { int pm, pn; };
struct Gemm { const bf16_t* A; const bf16_t* Bt; int M, N, K; };
struct StaticOrder {
    int nM, nN, nwg, G, c;
    __host__ __device__ void init(int M, int N, int G_, int c_) { nM = M / BM; nN = N / BM; nwg = nM * nN; G = G_; c = c_; }
    __host__ __device__ bool next(int i, Unit& u) const {
        const long L = (long)i * G + c; if (L >= nwg) return false;
        int wgid = (int)L; { const int q = nwg / NXCD, r = nwg % NXCD, xcd = wgid % NXCD, off = wgid / NXCD; wgid = (xcd < r ? xcd * (q + 1) : r * (q + 1) + (xcd - r) * q) + off; }
        const int nig = WGM * nN, gid = wgid / nig, fm = gid * WGM, gsz = (nM - fm) < WGM ? (nM - fm) : WGM;
        u.pm = fm + ((wgid % nig) % gsz); u.pn = (wgid % nig) / gsz; return true;
    }
    __device__ __forceinline__ void a_ready(const Unit&) const {}
    __device__ __forceinline__ void done(const Unit&) const {}
};

constexpr float RMS_EPS = 1e-6f;
__device__ __forceinline__ unsigned cvt_pk_bf16(float lo, float hi) { unsigned r; asm volatile("v_cvt_pk_bf16_f32 %0, %1, %2" : "=v"(r) : "v"(lo), "v"(hi)); return r; }
__device__ __forceinline__ float bf_lo(unsigned w) { return __uint_as_float(w << 16); }
__device__ __forceinline__ float bf_hi(unsigned w) { return __uint_as_float(w & 0xffff0000u); }
__device__ __forceinline__ float sigm(float x) { return __builtin_amdgcn_rcpf(1.0f + __builtin_amdgcn_exp2f(-1.44269504f * x)); }
__device__ __forceinline__ float gelu_t(float x) { const float z = x * (1.5957691216f + 0.0713548163f * x * x); return x * __builtin_amdgcn_rcpf(1.0f + __builtin_amdgcn_exp2f(-1.44269504f * z)); }
constexpr float FIX_SSQ = 4096.0f, FIX_V = 65536.0f;
__device__ __forceinline__ float unfix(float slot, float scale) { return (float)(int)__float_as_uint(slot) * (1.0f / scale); }
__device__ __forceinline__ float tofix(float v, float scale) { return __uint_as_float((unsigned)(int)__builtin_rintf(v * scale)); }
__device__ __forceinline__ float rstd_of(float ssq) { return __builtin_amdgcn_rsqf(unfix(ssq, FIX_SSQ) * (1.0f / 1024.0f) + RMS_EPS); }
__device__ __forceinline__ void fadd_fix(float* p, float v, float scale) { (void)__hip_atomic_fetch_add((unsigned*)p, (unsigned)(int)__builtin_rintf(v * scale), __ATOMIC_RELAXED, __HIP_MEMORY_SCOPE_AGENT); }

struct EpiIn {
    static constexpr bool PERM = true, AFTER_DRAIN = false;
    bf16_t* XR; bf16_t* GR; bf16_t* U; bf16_t* V; bf16_t* HALO; const float* ssq; float* vsum; float* vsq;
    __device__ __forceinline__ void operator()(const f32x4 (&acc)[2][2][4][2], const Unit& u, int wr, int wc, int fr, int fq) const {
        const int pn = u.pn; bf16_t* base; int ldc, colt, act;
        if (pn < 5) { base = XR; ldc = 1280; colt = pn * 256; act = 0; }
        else if (pn < 10) { base = GR; ldc = 1280; colt = (pn - 5) * 256; act = 1; }
        else if (pn < 14) { base = U; ldc = 1024; colt = (pn - 10) * 256; act = 1; }
        else { base = V; ldc = 1024; colt = (pn - 14) * 256; act = 2; }
        const int row0 = u.pm * BM + wr * 64 + fr, col0 = colt + wc * 32 + 8 * fq;
        float rs8[8];
#pragma unroll
        for (int i = 0; i < 8; ++i) rs8[i] = ssq[row0 + (i >> 2) * HALF + (i & 3) * 16];
        asm volatile("" ::: "memory");
#pragma unroll
        for (int ai = 0; ai < 2; ++ai)
#pragma unroll
            for (int m = 0; m < 4; ++m) {
                const int row = row0 + ai * HALF + m * 16; const float rs = rstd_of(rs8[ai * 4 + m]);
                bf16_t* rowp = base + (size_t)row * ldc + col0; float s1 = 0.f, s2 = 0.f;
#pragma unroll
                for (int bj = 0; bj < 2; ++bj) { f32x4 v0 = acc[ai][bj][m][0] * rs, v1 = acc[ai][bj][m][1] * rs;
                    if (act) {
#pragma unroll
                        for (int j = 0; j < 4; ++j) { v0[j] = gelu_t(v0[j]); v1[j] = gelu_t(v1[j]); } }
                    if (act == 2) {
#pragma unroll
                        for (int j = 0; j < 4; ++j) { s1 += v0[j] + v1[j]; s2 += v0[j] * v0[j] + v1[j] * v1[j]; } }
                    u32x4 w; w.x = cvt_pk_bf16(v0[0], v0[1]); w.y = cvt_pk_bf16(v0[2], v0[3]); w.z = cvt_pk_bf16(v1[0], v1[1]); w.w = cvt_pk_bf16(v1[2], v1[3]);
                    *(u32x4*)(rowp + bj * HALF) = w;
                    if (pn < 5 && m == 3 && fr >= 13) *(u32x4*)(HALO + ((size_t)(row >> 6) * 3 + (fr - 13)) * 1280 + col0 + bj * HALF) = w; }
                if (act == 2) { s1 += __shfl_xor(s1, 16); s1 += __shfl_xor(s1, 32); s2 += __shfl_xor(s2, 16); s2 += __shfl_xor(s2, 32);
                    if (fq == 0) { fadd_fix(vsum + row, s1, FIX_V); fadd_fix(vsq + row, s2, FIX_V); } }
            }
    }
};
template <int ACT> struct EpiAct {
    static constexpr bool PERM = true, AFTER_DRAIN = false;
    bf16_t* O; int ldc; const float* ssq;
    __device__ __forceinline__ void operator()(const f32x4 (&acc)[2][2][4][2], const Unit& u, int wr, int wc, int fr, int fq) const {
        const int row0 = u.pm * BM + wr * 64 + fr, col0 = u.pn * BM + wc * 32 + 8 * fq;
        float rs8[8];
#pragma unroll
        for (int i = 0; i < 8; ++i) rs8[i] = ssq[row0 + (i >> 2) * HALF + (i & 3) * 16];
        asm volatile("" ::: "memory");
#pragma unroll
        for (int ai = 0; ai < 2; ++ai)
#pragma unroll
            for (int m = 0; m < 4; ++m) {
                const int row = row0 + ai * HALF + m * 16; const float rs = rstd_of(rs8[ai * 4 + m]);
                bf16_t* rowp = O + (size_t)row * ldc + col0;
#pragma unroll
                for (int bj = 0; bj < 2; ++bj) { f32x4 v0 = acc[ai][bj][m][0] * rs, v1 = acc[ai][bj][m][1] * rs;
#pragma unroll
                    for (int j = 0; j < 4; ++j) {
                        if (ACT == 0) { v0[j] = sigm(v0[j]); v1[j] = sigm(v1[j]); }
                        else { const float a = fmaxf(v0[j], 0.f), b = fmaxf(v1[j], 0.f); v0[j] = a * a; v1[j] = b * b; } }
                    u32x4 w; w.x = cvt_pk_bf16(v0[0], v0[1]); w.y = cvt_pk_bf16(v0[2], v0[3]); w.z = cvt_pk_bf16(v1[0], v1[1]); w.w = cvt_pk_bf16(v1[2], v1[3]);
                    *(u32x4*)(rowp + bj * HALF) = w; }
            }
    }
};
struct EpiGate8 {
    static constexpr bool PERM = true, AFTER_DRAIN = false;
    unsigned char* G8; const float* ssq;
    __device__ __forceinline__ void operator()(const f32x4 (&acc)[2][2][4][2], const Unit& u, int wr, int wc, int fr, int fq) const {
        const int row0 = u.pm * BM + wr * 64 + fr, col0 = u.pn * BM + wc * 32 + 8 * fq;
#pragma unroll
        for (int ai = 0; ai < 2; ++ai)
#pragma unroll
            for (int m = 0; m < 4; ++m) {
                const int row = row0 + ai * HALF + m * 16; const float rs = rstd_of(ssq[row]);
                unsigned char* rowp = G8 + (size_t)row * 1024 + col0;
#pragma unroll
                for (int bj = 0; bj < 2; ++bj) { const f32x4 v0 = acc[ai][bj][m][0] * rs, v1 = acc[ai][bj][m][1] * rs; unsigned q[8];
#pragma unroll
                    for (int j = 0; j < 4; ++j) { q[j] = (unsigned)__builtin_rintf(255.0f * sigm(v0[j])); q[4 + j] = (unsigned)__builtin_rintf(255.0f * sigm(v1[j])); }
                    u32x2 w; w.x = q[0] | (q[1] << 8) | (q[2] << 16) | (q[3] << 24); w.y = q[4] | (q[5] << 8) | (q[6] << 16) | (q[7] << 24);
                    *(u32x2*)(rowp + bj * HALF) = w; }
            }
    }
};
template <bool ADD> struct EpiMix {
    static constexpr bool PERM = true, AFTER_DRAIN = false;
    bf16_t* O; const unsigned char* G8;
    __device__ __forceinline__ void operator()(const f32x4 (&acc)[2][2][4][2], const Unit& u, int wr, int wc, int fr, int fq) const {
        const int row0 = u.pm * BM + wr * 64 + fr, col0 = u.pn * BM + wc * 32 + 8 * fq;
#pragma unroll
        for (int ai = 0; ai < 2; ++ai)
#pragma unroll
            for (int m = 0; m < 4; ++m) {
                const size_t off = (size_t)(row0 + ai * HALF + m * 16) * 1024 + col0;
#pragma unroll
                for (int bj = 0; bj < 2; ++bj) { const u32x2 gq = *(const u32x2*)(G8 + off + bj * HALF); const f32x4 a0 = acc[ai][bj][m][0], a1 = acc[ai][bj][m][1];
                    const float k = 1.0f / 255.0f; f32x4 v0, v1;
                    v0[0] = (float)(gq.x & 255u) * k * a0[0]; v0[1] = (float)((gq.x >> 8) & 255u) * k * a0[1]; v0[2] = (float)((gq.x >> 16) & 255u) * k * a0[2]; v0[3] = (float)(gq.x >> 24) * k * a0[3];
                    v1[0] = (float)(gq.y & 255u) * k * a1[0]; v1[1] = (float)((gq.y >> 8) & 255u) * k * a1[1]; v1[2] = (float)((gq.y >> 16) & 255u) * k * a1[2]; v1[3] = (float)(gq.y >> 24) * k * a1[3];
                    if (ADD) { const u32x4 tw = *(const u32x4*)(O + off + bj * HALF);
                        v0[0] += bf_lo(tw.x); v0[1] += bf_hi(tw.x); v0[2] += bf_lo(tw.y); v0[3] += bf_hi(tw.y); v1[0] += bf_lo(tw.z); v1[1] += bf_hi(tw.z); v1[2] += bf_lo(tw.w); v1[3] += bf_hi(tw.w); }
                    u32x4 w; w.x = cvt_pk_bf16(v0[0], v0[1]); w.y = cvt_pk_bf16(v0[2], v0[3]); w.z = cvt_pk_bf16(v1[0], v1[1]); w.w = cvt_pk_bf16(v1[2], v1[3]);
                    *(u32x4*)(O + off + bj * HALF) = w; }
                asm volatile("" ::: "memory");
            }
    }
};
struct EpiRes {
    static constexpr bool PERM = true, AFTER_DRAIN = false;
    bf16_t* xb; float* ssq_out;
    __device__ __forceinline__ void operator()(const f32x4 (&acc)[2][2][4][2], const Unit& u, int wr, int wc, int fr, int fq) const {
        const int row0 = u.pm * BM + wr * 64 + fr, col0 = u.pn * BM + wc * 32 + 8 * fq;
#pragma unroll
        for (int ai = 0; ai < 2; ++ai)
#pragma unroll
            for (int m = 0; m < 4; ++m) {
                const int row = row0 + ai * HALF + m * 16; const size_t off = (size_t)row * 1024 + col0; float s = 0.f;
#pragma unroll
                for (int bj = 0; bj < 2; ++bj) { const u32x4 xw = *(const u32x4*)(xb + off + bj * HALF); const f32x4 a0 = acc[ai][bj][m][0], a1 = acc[ai][bj][m][1];
                    f32x4 v0, v1; v0[0] = bf_lo(xw.x) + a0[0]; v0[1] = bf_hi(xw.x) + a0[1]; v0[2] = bf_lo(xw.y) + a0[2]; v0[3] = bf_hi(xw.y) + a0[3];
                    v1[0] = bf_lo(xw.z) + a1[0]; v1[1] = bf_hi(xw.z) + a1[1]; v1[2] = bf_lo(xw.w) + a1[2]; v1[3] = bf_hi(xw.w) + a1[3];
                    u32x4 w; w.x = cvt_pk_bf16(v0[0], v0[1]); w.y = cvt_pk_bf16(v0[2], v0[3]); w.z = cvt_pk_bf16(v1[0], v1[1]); w.w = cvt_pk_bf16(v1[2], v1[3]);
                    *(u32x4*)(xb + off + bj * HALF) = w;
                    s += (v0[0] * v0[0] + v0[1] * v0[1]) + (v0[2] * v0[2] + v0[3] * v0[3]) + (v1[0] * v1[0] + v1[1] * v1[1]) + (v1[2] * v1[2] + v1[3] * v1[3]); }
                s += __shfl_xor(s, 16); s += __shfl_xor(s, 32);
                if (fq == 0) fadd_fix(ssq_out + row, s, FIX_SSQ);
                asm volatile("" ::: "memory");
            }
    }
};
template <class Epi, class Sched, bool ALIGN_EPI = false, bool SP2 = false>
__device__ __forceinline__ void gemm_phase(PG8_LAS unsigned char* lds, const Gemm g, const Sched& S, const Epi& E, const int tid) {
    const int wid = __builtin_amdgcn_readfirstlane(tid >> 6), lane = tid & 63, wr = wid >> 2, wc = wid & 3, fr = lane & 15, fq = lane >> 4;
    const int K = g.K, nt = K / BK;
    unsigned voffA[2], voffB[2];
#pragma unroll
    for (int i = 0; i < 2; ++i) { int R, C; stage_rc(tid * 16 + i * 8192, R, C); const int Rb = Epi::PERM ? ((R & ~31) + perm32(R & 31)) : R;
        voffA[i] = (unsigned)(R * K + C) * 2u; voffB[i] = (unsigned)(Rb * K + C) * 2u; }
    const size_t kstep = (size_t)(BK * 2);
    const size_t hstep = (size_t)HALF * K * 2;
    const size_t tstep = 2 * hstep;
    const unsigned ldsw = (unsigned)wid * 1024u;
    const int aoff = lds_byte(wr * 64 + fr, fq * 8), boff = lds_byte(wc * 32 + fr, fq * 8);
#define PG8_SA(b, h) (((b) * 2 + (h)) * HTB)
#define PG8_SB(b, h) ((4 + (b) * 2 + (h)) * HTB)
#define PG8_STAGE(bufoff, gbase, voff) do { _Pragma("unroll") for (int _i = 0; _i < 2; ++_i) \
        __builtin_amdgcn_global_load_lds((const unsigned*)((const char*)(gbase) + (voff)[_i]), (PG8_LAS unsigned*)(lds + (bufoff) + ldsw + _i * 8192), 16, 0, 0); } while (0)
#define PG8_LDA(dst, b, h) do { _Pragma("unroll") for (int m = 0; m < 4; ++m) _Pragma("unroll") for (int k = 0; k < 2; ++k) dst[m][k] = *(const PG8_LAS bf16x8*)(lds + PG8_SA(b, h) + aoff + m * 2048 + k * 1024); } while (0)
#define PG8_LDB(dst, b, h) do { _Pragma("unroll") for (int n = 0; n < 2; ++n) _Pragma("unroll") for (int k = 0; k < 2; ++k) dst[n][k] = *(const PG8_LAS bf16x8*)(lds + PG8_SB(b, h) + boff + n * 2048 + k * 1024); } while (0)
#define PG8_MMA(ai, bj, At, Bt) do { __builtin_amdgcn_s_setprio(1); _Pragma("unroll") for (int m = 0; m < 4; ++m) _Pragma("unroll") for (int n = 0; n < 2; ++n) _Pragma("unroll") for (int k = 0; k < 2; ++k) \
        acc[ai][bj][m][n] = __builtin_amdgcn_mfma_f32_16x16x32_bf16(Bt[n][k], At[m][k], acc[ai][bj][m][n], 0, 0, 0); __builtin_amdgcn_s_setprio(0); } while (0)
#define PG8_WAIT_V(n) asm volatile("s_waitcnt vmcnt(" #n ")" ::: "memory")
#define PG8_WAIT_L(n) asm volatile("s_waitcnt lgkmcnt(" #n ")" ::: "memory")
#define PG8_BAR __builtin_amdgcn_s_barrier()
#define PG8_SCHED __builtin_amdgcn_sched_barrier(0)
    Unit cur, nxt; int ui = 0;
    if (!S.next(0, cur)) return;
    f32x4 acc[2][2][4][2];
#pragma unroll
    for (int a = 0; a < 2; ++a)
#pragma unroll
        for (int b = 0; b < 2; ++b)
#pragma unroll
            for (int m = 0; m < 4; ++m)
#pragma unroll
                for (int n = 0; n < 2; ++n) acc[a][b][m][n] = (f32x4){0.f, 0.f, 0.f, 0.f};
    bf16x8 At[4][2], B0[2][2], B1[2][2];
    const char* cA = (const char*)g.A + (size_t)cur.pm * tstep; const char* cB = (const char*)g.Bt + (size_t)cur.pn * tstep;
    S.a_ready(cur);
    if constexpr (SP2) {
        PG8_STAGE(PG8_SB(0, 0), cB, voffB); PG8_STAGE(PG8_SB(0, 1), cB + hstep, voffB); PG8_STAGE(PG8_SA(0, 0), cA, voffA); PG8_STAGE(PG8_SA(0, 1), cA + hstep, voffA);
        if (wr == 1) PG8_BAR;
        PG8_WAIT_V(2); PG8_BAR;
        PG8_STAGE(PG8_SB(1, 0), cB + kstep, voffB); PG8_STAGE(PG8_SA(1, 0), cA + kstep, voffA); PG8_STAGE(PG8_SB(1, 1), cB + hstep + kstep, voffB);
        PG8_WAIT_V(6); PG8_BAR;
    } else {
        PG8_STAGE(PG8_SB(0, 0), cB, voffB); PG8_STAGE(PG8_SA(0, 0), cA, voffA); PG8_STAGE(PG8_SB(0, 1), cB + hstep, voffB); PG8_STAGE(PG8_SA(0, 1), cA + hstep, voffA);
        if (wr == 1) PG8_BAR;
        PG8_WAIT_V(4); PG8_BAR;
        PG8_STAGE(PG8_SB(1, 0), cB + kstep, voffB); PG8_STAGE(PG8_SA(1, 0), cA + kstep, voffA); PG8_STAGE(PG8_SB(1, 1), cB + hstep + kstep, voffB);
        PG8_WAIT_V(6); PG8_BAR;
    }
    for (;;) {
        const bool has_next = S.next(ui + 1, nxt);
        const char* nA = has_next ? (const char*)g.A + (size_t)nxt.pm * tstep : cA; const char* nB = has_next ? (const char*)g.Bt + (size_t)nxt.pn * tstep : cB;
        for (int t = 0; t < nt; t += 2) {
            const bool last = (t == nt - 2);
            const char* a1 = cA + (size_t)(t + 1) * kstep;
            const char* a2 = last ? nA : cA + (size_t)(t + 2) * kstep; const char* b2 = last ? nB : cB + (size_t)(t + 2) * kstep;
            const char* a3 = a2 + kstep; const char* b3 = b2 + kstep;
            if (last && has_next) S.a_ready(nxt);
            if constexpr (SP2) {
            PG8_LDB(B0, 0, 0); PG8_LDB(B1, 0, 1); PG8_SCHED; PG8_LDA(At, 0, 0); PG8_STAGE(PG8_SA(1, 1), a1 + hstep, voffA);
            PG8_WAIT_V(8); PG8_WAIT_L(0); PG8_BAR; PG8_MMA(0, 0, At, B0); PG8_MMA(0, 1, At, B1); PG8_BAR; PG8_SCHED;
            PG8_LDA(At, 0, 1); PG8_STAGE(PG8_SB(0, 0), b2, voffB); PG8_STAGE(PG8_SB(0, 1), b2 + hstep, voffB); PG8_STAGE(PG8_SA(0, 0), a2, voffA);
            PG8_WAIT_V(8); PG8_WAIT_L(0); PG8_BAR; PG8_MMA(1, 0, At, B0); PG8_MMA(1, 1, At, B1); PG8_BAR; PG8_SCHED;
            PG8_LDB(B0, 1, 0); PG8_LDB(B1, 1, 1); PG8_SCHED; PG8_LDA(At, 1, 0); PG8_STAGE(PG8_SA(0, 1), a2 + hstep, voffA);
            PG8_WAIT_V(8); PG8_WAIT_L(0); PG8_BAR; PG8_MMA(0, 0, At, B0); PG8_MMA(0, 1, At, B1); PG8_BAR; PG8_SCHED;
            PG8_LDA(At, 1, 1); PG8_STAGE(PG8_SB(1, 0), b3, voffB); PG8_STAGE(PG8_SB(1, 1), b3 + hstep, voffB); PG8_STAGE(PG8_SA(1, 0), a3, voffA);
            PG8_WAIT_V(8); PG8_WAIT_L(0); PG8_BAR; PG8_MMA(1, 0, At, B0); PG8_MMA(1, 1, At, B1); PG8_BAR; PG8_SCHED;
            } else {
            PG8_LDB(B0, 0, 0); PG8_SCHED; PG8_LDA(At, 0, 0); PG8_STAGE(PG8_SA(1, 1), a1 + hstep, voffA);
            PG8_WAIT_L(8); PG8_BAR; PG8_WAIT_L(0); PG8_MMA(0, 0, At, B0); PG8_BAR; PG8_SCHED;
            PG8_LDB(B1, 0, 1); PG8_STAGE(PG8_SB(0, 0), b2, voffB);
            PG8_BAR; PG8_WAIT_L(0); PG8_MMA(0, 1, At, B1); PG8_BAR;
            PG8_LDA(At, 0, 1); PG8_STAGE(PG8_SA(0, 0), a2, voffA);
            PG8_BAR; PG8_WAIT_L(0); PG8_MMA(1, 0, At, B0); PG8_BAR; PG8_SCHED;
            PG8_STAGE(PG8_SB(0, 1), b2 + hstep, voffB);
            PG8_WAIT_V(6); PG8_BAR; PG8_MMA(1, 1, At, B1); PG8_BAR;
            PG8_LDB(B0, 1, 0); PG8_SCHED; PG8_LDA(At, 1, 0); PG8_STAGE(PG8_SA(0, 1), a2 + hstep, voffA);
            PG8_WAIT_L(8); PG8_BAR; PG8_WAIT_L(0); PG8_MMA(0, 0, At, B0); PG8_BAR; PG8_SCHED;
            PG8_LDB(B1, 1, 1); PG8_STAGE(PG8_SB(1, 0), b3, voffB);
            PG8_BAR; PG8_WAIT_L(0); PG8_MMA(0, 1, At, B1); PG8_BAR;
            PG8_LDA(At, 1, 1); PG8_STAGE(PG8_SA(1, 0), a3, voffA);
            PG8_BAR; PG8_WAIT_L(0); PG8_MMA(1, 0, At, B0); PG8_BAR; PG8_SCHED;
            PG8_STAGE(PG8_SB(1, 1), b3 + hstep, voffB);
            PG8_WAIT_V(6); PG8_BAR; PG8_MMA(1, 1, At, B1); PG8_BAR;
            }
        }
        if constexpr (ALIGN_EPI) { if (wr == 0) PG8_BAR; }
        if constexpr (!Epi::AFTER_DRAIN) { E(acc, cur, wr, wc, fr, fq); S.done(cur); }
        if (!has_next) break;
#pragma unroll
        for (int a = 0; a < 2; ++a)
#pragma unroll
            for (int b = 0; b < 2; ++b)
#pragma unroll
                for (int m = 0; m < 4; ++m)
#pragma unroll
                    for (int n = 0; n < 2; ++n) acc[a][b][m][n] = (f32x4){0.f, 0.f, 0.f, 0.f};
        cur = nxt; cA = nA; cB = nB; ++ui;
        if constexpr (ALIGN_EPI) { if (wr == 1) PG8_BAR; }
    }
    PG8_WAIT_V(0);
    if constexpr (!ALIGN_EPI) { if (wr == 0) PG8_BAR; }
    PG8_BAR;
    if constexpr (Epi::AFTER_DRAIN) { E.fused(acc, cur, wr, wc, fr, fq, lds, wid, lane); S.done(cur); }
#undef PG8_SA
#undef PG8_SB
#undef PG8_STAGE
#undef PG8_LDA
#undef PG8_LDB
#undef PG8_MMA
#undef PG8_WAIT_V
#undef PG8_WAIT_L
#undef PG8_BAR
#undef PG8_SCHED
}

struct UnitX { int pm, pn; const bf16_t* A; const bf16_t* Bt; int K; int kind; };
template <class Epi, class Sched, bool ALIGN_EPI = false, bool SP2 = false>
__device__ __forceinline__ void gemm_phase_multi(PG8_LAS unsigned char* lds, const Sched& S, const Epi& E, const int tid) {
    const int wid = __builtin_amdgcn_readfirstlane(tid >> 6), lane = tid & 63, wr = wid >> 2, wc = wid & 3, fr = lane & 15, fq = lane >> 4;
    int sR[2], sRb[2], sC[2];
#pragma unroll
    for (int i = 0; i < 2; ++i) { int R, C; stage_rc(tid * 16 + i * 8192, R, C); sR[i] = R; sRb[i] = Epi::PERM ? ((R & ~31) + perm32(R & 31)) : R; sC[i] = C; }
    unsigned voffA[2], voffB[2], voffAn[2], voffBn[2];
#define PG8_VOFF(dA, dB, KK) do { _Pragma("unroll") for (int _i = 0; _i < 2; ++_i) { dA[_i] = (unsigned)(sR[_i] * (KK) + sC[_i]) * 2u; dB[_i] = (unsigned)(sRb[_i] * (KK) + sC[_i]) * 2u; } } while (0)
    const size_t kstep = (size_t)(BK * 2);
    const unsigned ldsw = (unsigned)wid * 1024u;
    const int aoff = lds_byte(wr * 64 + fr, fq * 8), boff = lds_byte(wc * 32 + fr, fq * 8);
#define PG8_SA(b, h) (((b) * 2 + (h)) * HTB)
#define PG8_SB(b, h) ((4 + (b) * 2 + (h)) * HTB)
#define PG8_STAGE(bufoff, gbase, voff) do { _Pragma("unroll") for (int _i = 0; _i < 2; ++_i) \
        __builtin_amdgcn_global_load_lds((const unsigned*)((const char*)(gbase) + (voff)[_i]), (PG8_LAS unsigned*)(lds + (bufoff) + ldsw + _i * 8192), 16, 0, 0); } while (0)
#define PG8_LDA(dst, b, h) do { _Pragma("unroll") for (int m = 0; m < 4; ++m) _Pragma("unroll") for (int k = 0; k < 2; ++k) dst[m][k] = *(const PG8_LAS bf16x8*)(lds + PG8_SA(b, h) + aoff + m * 2048 + k * 1024); } while (0)
#define PG8_LDB(dst, b, h) do { _Pragma("unroll") for (int n = 0; n < 2; ++n) _Pragma("unroll") for (int k = 0; k < 2; ++k) dst[n][k] = *(const PG8_LAS bf16x8*)(lds + PG8_SB(b, h) + boff + n * 2048 + k * 1024); } while (0)
#define PG8_MMA(ai, bj, At, Bt) do { __builtin_amdgcn_s_setprio(1); _Pragma("unroll") for (int m = 0; m < 4; ++m) _Pragma("unroll") for (int n = 0; n < 2; ++n) _Pragma("unroll") for (int k = 0; k < 2; ++k) \
        acc[ai][bj][m][n] = __builtin_amdgcn_mfma_f32_16x16x32_bf16(Bt[n][k], At[m][k], acc[ai][bj][m][n], 0, 0, 0); __builtin_amdgcn_s_setprio(0); } while (0)
#define PG8_WAIT_V(n) asm volatile("s_waitcnt vmcnt(" #n ")" ::: "memory")
#define PG8_WAIT_L(n) asm volatile("s_waitcnt lgkmcnt(" #n ")" ::: "memory")
#define PG8_BAR __builtin_amdgcn_s_barrier()
#define PG8_SCHED __builtin_amdgcn_sched_barrier(0)
    UnitX cur, nxt; int ui = 0;
    if (!S.next(0, cur)) return;
    int K = cur.K, nt = K / BK; size_t hstep = (size_t)HALF * K * 2, hstepn = hstep; PG8_VOFF(voffA, voffB, K); PG8_VOFF(voffAn, voffBn, K);
    f32x4 acc[2][2][4][2];
#pragma unroll
    for (int a = 0; a < 2; ++a)
#pragma unroll
        for (int b = 0; b < 2; ++b)
#pragma unroll
            for (int m = 0; m < 4; ++m)
#pragma unroll
                for (int n = 0; n < 2; ++n) acc[a][b][m][n] = (f32x4){0.f, 0.f, 0.f, 0.f};
    bf16x8 At[4][2], B0[2][2], B1[2][2];
    const char* cA = (const char*)cur.A + (size_t)cur.pm * 2 * hstep; const char* cB = (const char*)cur.Bt + (size_t)cur.pn * 2 * hstep;
    S.a_ready(cur);
    if constexpr (SP2) {
        PG8_STAGE(PG8_SB(0, 0), cB, voffB); PG8_STAGE(PG8_SB(0, 1), cB + hstep, voffB); PG8_STAGE(PG8_SA(0, 0), cA, voffA); PG8_STAGE(PG8_SA(0, 1), cA + hstep, voffA);
        if (wr == 1) PG8_BAR;
        PG8_WAIT_V(2); PG8_BAR;
        PG8_STAGE(PG8_SB(1, 0), cB + kstep, voffB); PG8_STAGE(PG8_SA(1, 0), cA + kstep, voffA); PG8_STAGE(PG8_SB(1, 1), cB + hstep + kstep, voffB);
        PG8_WAIT_V(6); PG8_BAR;
    } else {
        PG8_STAGE(PG8_SB(0, 0), cB, voffB); PG8_STAGE(PG8_SA(0, 0), cA, voffA); PG8_STAGE(PG8_SB(0, 1), cB + hstep, voffB); PG8_STAGE(PG8_SA(0, 1), cA + hstep, voffA);
        if (wr == 1) PG8_BAR;
        PG8_WAIT_V(4); PG8_BAR;
        PG8_STAGE(PG8_SB(1, 0), cB + kstep, voffB); PG8_STAGE(PG8_SA(1, 0), cA + kstep, voffA); PG8_STAGE(PG8_SB(1, 1), cB + hstep + kstep, voffB);
        PG8_WAIT_V(6); PG8_BAR;
    }
    for (;;) {
        const bool has_next = S.next(ui + 1, nxt);
        if (has_next) { hstepn = (size_t)HALF * nxt.K * 2; PG8_VOFF(voffAn, voffBn, nxt.K); } else { hstepn = hstep; PG8_VOFF(voffAn, voffBn, K); }
        const char* nA = has_next ? (const char*)nxt.A + (size_t)nxt.pm * 2 * hstepn : cA; const char* nB = has_next ? (const char*)nxt.Bt + (size_t)nxt.pn * 2 * hstepn : cB;
        for (int t = 0; t < nt; t += 2) {
            const bool last = (t == nt - 2);
            const char* a1 = cA + (size_t)(t + 1) * kstep;
            const char* a2 = last ? nA : cA + (size_t)(t + 2) * kstep; const char* b2 = last ? nB : cB + (size_t)(t + 2) * kstep;
            const char* a3 = a2 + kstep; const char* b3 = b2 + kstep;
            unsigned vA2[2], vB2[2]; vA2[0] = last ? voffAn[0] : voffA[0]; vA2[1] = last ? voffAn[1] : voffA[1]; vB2[0] = last ? voffBn[0] : voffB[0]; vB2[1] = last ? voffBn[1] : voffB[1];
            const size_t hs2 = last ? hstepn : hstep;
            if (last && has_next) S.a_ready(nxt);
            if constexpr (SP2) {
            PG8_LDB(B0, 0, 0); PG8_LDB(B1, 0, 1); PG8_SCHED; PG8_LDA(At, 0, 0); PG8_STAGE(PG8_SA(1, 1), a1 + hstep, voffA);
            PG8_WAIT_V(8); PG8_WAIT_L(0); PG8_BAR; PG8_MMA(0, 0, At, B0); PG8_MMA(0, 1, At, B1); PG8_BAR; PG8_SCHED;
            PG8_LDA(At, 0, 1); PG8_STAGE(PG8_SB(0, 0), b2, vB2); PG8_STAGE(PG8_SB(0, 1), b2 + hs2, vB2); PG8_STAGE(PG8_SA(0, 0), a2, vA2);
            PG8_WAIT_V(8); PG8_WAIT_L(0); PG8_BAR; PG8_MMA(1, 0, At, B0); PG8_MMA(1, 1, At, B1); PG8_BAR; PG8_SCHED;
            PG8_LDB(B0, 1, 0); PG8_LDB(B1, 1, 1); PG8_SCHED; PG8_LDA(At, 1, 0); PG8_STAGE(PG8_SA(0, 1), a2 + hs2, vA2);
            PG8_WAIT_V(8); PG8_WAIT_L(0); PG8_BAR; PG8_MMA(0, 0, At, B0); PG8_MMA(0, 1, At, B1); PG8_BAR; PG8_SCHED;
            PG8_LDA(At, 1, 1); PG8_STAGE(PG8_SB(1, 0), b3, vB2); PG8_STAGE(PG8_SB(1, 1), b3 + hs2, vB2); PG8_STAGE(PG8_SA(1, 0), a3, vA2);
            PG8_WAIT_V(8); PG8_WAIT_L(0); PG8_BAR; PG8_MMA(1, 0, At, B0); PG8_MMA(1, 1, At, B1); PG8_BAR; PG8_SCHED;
            } else {
            PG8_LDB(B0, 0, 0); PG8_SCHED; PG8_LDA(At, 0, 0); PG8_STAGE(PG8_SA(1, 1), a1 + hstep, voffA);
            PG8_WAIT_L(8); PG8_BAR; PG8_WAIT_L(0); PG8_MMA(0, 0, At, B0); PG8_BAR; PG8_SCHED;
            PG8_LDB(B1, 0, 1); PG8_STAGE(PG8_SB(0, 0), b2, voffB);
            PG8_BAR; PG8_WAIT_L(0); PG8_MMA(0, 1, At, B1); PG8_BAR;
            PG8_LDA(At, 0, 1); PG8_STAGE(PG8_SA(0, 0), a2, voffA);
            PG8_BAR; PG8_WAIT_L(0); PG8_MMA(1, 0, At, B0); PG8_BAR; PG8_SCHED;
            PG8_STAGE(PG8_SB(0, 1), b2 + hstep, voffB);
            PG8_WAIT_V(6); PG8_BAR; PG8_MMA(1, 1, At, B1); PG8_BAR;
            PG8_LDB(B0, 1, 0); PG8_SCHED; PG8_LDA(At, 1, 0); PG8_STAGE(PG8_SA(0, 1), a2 + hstep, voffA);
            PG8_WAIT_L(8); PG8_BAR; PG8_WAIT_L(0); PG8_MMA(0, 0, At, B0); PG8_BAR; PG8_SCHED;
            PG8_LDB(B1, 1, 1); PG8_STAGE(PG8_SB(1, 0), b3, voffB);
            PG8_BAR; PG8_WAIT_L(0); PG8_MMA(0, 1, At, B1); PG8_BAR;
            PG8_LDA(At, 1, 1); PG8_STAGE(PG8_SA(1, 0), a3, voffA);
            PG8_BAR; PG8_WAIT_L(0); PG8_MMA(1, 0, At, B0); PG8_BAR; PG8_SCHED;
            PG8_STAGE(PG8_SB(1, 1), b3 + hstep, voffB);
            PG8_WAIT_V(6); PG8_BAR; PG8_MMA(1, 1, At, B1); PG8_BAR;
            }
        }
        if constexpr (ALIGN_EPI) { if (wr == 0) PG8_BAR; }
        if constexpr (!Epi::AFTER_DRAIN) { E(acc, cur, wr, wc, fr, fq); S.done(cur); }
        if (!has_next) break;
#pragma unroll
        for (int a = 0; a < 2; ++a)
#pragma unroll
            for (int b = 0; b < 2; ++b)
#pragma unroll
                for (int m = 0; m < 4; ++m)
#pragma unroll
                    for (int n = 0; n < 2; ++n) acc[a][b][m][n] = (f32x4){0.f, 0.f, 0.f, 0.f};
        cur = nxt; cA = nA; cB = nB; ++ui; K = cur.K; nt = K / BK; hstep = hstepn; voffA[0] = voffAn[0]; voffA[1] = voffAn[1]; voffB[0] = voffBn[0]; voffB[1] = voffBn[1];
        if constexpr (ALIGN_EPI) { if (wr == 1) PG8_BAR; }
    }
    PG8_WAIT_V(0);
    if constexpr (!ALIGN_EPI) { if (wr == 0) PG8_BAR; }
    PG8_BAR;
    if constexpr (Epi::AFTER_DRAIN) { E.fused(acc, cur, wr, wc, fr, fq, lds, wid, lane); S.done(cur); }
#undef PG8_SA
#undef PG8_SB
#undef PG8_STAGE
#undef PG8_LDA
#undef PG8_LDB
#undef PG8_MMA
#undef PG8_WAIT_V
#undef PG8_WAIT_L
#undef PG8_BAR
#undef PG8_SCHED
#undef PG8_VOFF
}


}
constexpr int BATCH = 4, SEQ = 4096, D = 1024, DRNN = 1280, NH = 20, FF = 4096, DEPTH = 2;
constexpr int M = BATCH * SEQ;
constexpr int DIN = 6656, NP1 = 4608;
constexpr int NSEG = 64;
constexpr int NWAVES = 8;
constexpr size_t KiB = 1024, MiB = 1u << 20;
constexpr size_t WS_SSQ = 0;
constexpr size_t WS_VST = 320 * KiB;
constexpr size_t WS_TS = 704 * KiB;
constexpr size_t WS_BAR = 640 * KiB;
constexpr size_t WS_ATOT = 1 * MiB, WS_HEND = 1 * MiB + 1280 * KiB;
constexpr size_t WS_W = 4 * MiB, W_LAYER = 37 * MiB;
constexpr size_t W_IN = 0, W_G = 9 * MiB, W_A = 13 * MiB, W_B = 15 * MiB + 512 * KiB, W_O = 17 * MiB + 512 * KiB, W_UP = 19 * MiB + 512 * KiB, W_DN = 27 * MiB + 512 * KiB,
                 W_L = 35 * MiB + 512 * KiB, W_S = 36 * MiB;
constexpr size_t WS_HALO = 254 * MiB;
constexpr size_t WS_XB = 78 * MiB;
constexpr size_t WS_XR = 110 * MiB, WS_GR = 150 * MiB, WS_U = 190 * MiB, WS_V = 222 * MiB, WS_END = 256 * MiB;
constexpr size_t WS_F = 110 * MiB;
constexpr size_t WS_S1 = WS_V, WS_S2 = WS_XR;
static_assert(WS_HEND + 1280 * KiB <= WS_W && WS_W + 2 * W_LAYER <= WS_XB && WS_XB + (size_t)M * D * 2 <= WS_XR && WS_F + (size_t)M * FF * 2 <= WS_HALO && WS_V + (size_t)M * D * 2 <= WS_HALO && WS_HALO + (size_t)(M / 64) * 3 * DRNN * 2 <= WS_END, "d_ws map");
static_assert(W_S + 8 * 128 * 128 * 2 <= W_LAYER && W_L + 2 * 20 * 64 * 64 * 2 <= W_S, "weight map");
constexpr int LDS_BYTES = 147456;
constexpr int NPHASE = 16;

#define LAS __attribute__((address_space(3)))
typedef unsigned short bf16;
typedef float f32x4 __attribute__((ext_vector_type(4)));
typedef short bf16x8 __attribute__((ext_vector_type(8)));
typedef unsigned u32x4 __attribute__((ext_vector_type(4)));
typedef unsigned u32x2 __attribute__((ext_vector_type(2)));
#define LDS_WAIT() asm volatile("s_waitcnt lgkmcnt(0)" ::: "memory")
using pg8::cvt_pk_bf16; using pg8::bf_lo; using pg8::bf_hi; using pg8::sigm;

__device__ __forceinline__ float wave_sum(float v) {
#pragma unroll
    for (int o = 1; o < 64; o <<= 1) v += __shfl_xor(v, o);
    return v;
}
struct Args { const float* in[21]; float* out; unsigned char* ws; int ph_lo, ph_hi; };
enum { I_X = 0, I_NMG, I_WIN, I_CW, I_CB, I_LWA, I_LBA, I_LWX, I_LBX, I_LAM, I_LNG, I_LNB, I_WS, I_BS, I_WA, I_WB, I_WO, I_NFG, I_WUP, I_WDN, I_FNG };
typedef const unsigned char __attribute__((address_space(4)))* kptr_t;
#define AIN(kp, i) (*(const float* const __attribute__((address_space(4)))*)((kp) + 8 * (i)))
struct CvtItem { const float* src; const float* ksc; bf16* dst; int ldw, K; };
__device__ __forceinline__ CvtItem cvt_decode(kptr_t kp, unsigned char* wl, int l, int r) {
    constexpr int J0 = 16 * 144, J1 = 16 * 64, J2 = 20 * 32, J3 = 16 * 32, J4 = 16 * 32, J5 = 16 * 128;
    const float* W; const float* ksc = nullptr; bf16* WT; int ldw, K, nblk;
    if (r < J0) { W = AIN(kp, I_WIN) + (size_t)l * D * DIN; ldw = DIN; K = D; nblk = NP1 / 32; WT = (bf16*)(wl + W_IN); ksc = AIN(kp, I_NMG) + l * D; }
    else if ((r -= J0) < J1) { W = AIN(kp, I_WIN) + (size_t)l * D * DIN + NP1; ldw = DIN; K = D; nblk = 2048 / 32; WT = (bf16*)(wl + W_G); ksc = AIN(kp, I_NMG) + l * D; }
    else if ((r -= J1) < J2) { W = AIN(kp, I_WA) + (size_t)l * DRNN * D; ldw = D; K = DRNN; nblk = D / 32; WT = (bf16*)(wl + W_A); }
    else if ((r -= J2) < J3) { W = AIN(kp, I_WB) + (size_t)l * D * D; ldw = D; K = D; nblk = D / 32; WT = (bf16*)(wl + W_B); }
    else if ((r -= J3) < J4) { W = AIN(kp, I_WO) + (size_t)l * D * D; ldw = D; K = D; nblk = D / 32; WT = (bf16*)(wl + W_O); }
    else if ((r -= J4) < J5) { W = AIN(kp, I_WUP) + (size_t)l * D * FF; ldw = FF; K = D; nblk = FF / 32; WT = (bf16*)(wl + W_UP); ksc = AIN(kp, I_NFG) + l * D; }
    else { r -= J5; W = AIN(kp, I_WDN) + (size_t)l * FF * D; ldw = D; K = FF; nblk = D / 32; WT = (bf16*)(wl + W_DN); }
    const int k0 = 64 * (r / nblk), n0 = 32 * (r % nblk);
    CvtItem c; c.src = W + (size_t)k0 * ldw + n0; c.ksc = ksc ? ksc + k0 : nullptr; c.dst = WT + (size_t)n0 * K + k0; c.ldw = ldw; c.K = K; return c;
}
constexpr int CVT_WIN = 16 * 144, CVT_ALL = 16 * 144 + 16 * 64 + 20 * 32 + 16 * 32 + 16 * 32 + 16 * 128 + 64 * 32;
__device__ __forceinline__ void convert_layer(kptr_t kp, unsigned char* ws, int l, int lo, int JL, LAS float* scr, int gw, int NGW, int lane) {
    gw += lo;
    unsigned char* wl = ws + WS_W + (size_t)l * W_LAYER;
    const int lr = lane >> 3, lc = (lane & 7) * 4;
    if (gw >= JL) return;
    CvtItem cur = cvt_decode(kp, wl, l, gw);
    f32x4 v[8];
#pragma unroll
    for (int i = 0; i < 8; ++i) v[i] = *(const f32x4*)(cur.src + (size_t)(lr + 8 * i) * cur.ldw + lc);
    for (int it = gw; it < JL; it += NGW) {
        const bool more = it + NGW < JL; CvtItem nxt = cur; f32x4 vn[8];
        if (more) { nxt = cvt_decode(kp, wl, l, it + NGW);
#pragma unroll
            for (int i = 0; i < 8; ++i) vn[i] = *(const f32x4*)(nxt.src + (size_t)(lr + 8 * i) * nxt.ldw + lc); }
        if (cur.ksc) {
#pragma unroll
            for (int i = 0; i < 8; ++i) v[i] = v[i] * cur.ksc[lr + 8 * i]; }
#pragma unroll
        for (int i = 0; i < 8; ++i) { LAS float* d = scr + (lr + 8 * i) * 33 + lc; d[0] = v[i][0]; d[1] = v[i][1]; d[2] = v[i][2]; d[3] = v[i][3]; }
        LDS_WAIT(); asm volatile("" ::: "memory");
        const int c = lane & 7;
#pragma unroll
        for (int j = 0; j < 4; ++j) { const int n = (lane >> 3) + 8 * j; const LAS float* s = scr + (8 * c) * 33 + n;
            u32x4 o; o.x = cvt_pk_bf16(s[0 * 33], s[1 * 33]); o.y = cvt_pk_bf16(s[2 * 33], s[3 * 33]); o.z = cvt_pk_bf16(s[4 * 33], s[5 * 33]); o.w = cvt_pk_bf16(s[6 * 33], s[7 * 33]);
            *(u32x4*)(cur.dst + (size_t)n * cur.K + 8 * c) = o; }
        LDS_WAIT(); asm volatile("" ::: "memory");
        if (more) { cur = nxt;
#pragma unroll
            for (int i = 0; i < 8; ++i) v[i] = vn[i]; }
    }
}
__device__ __forceinline__ void p0_prologue(kptr_t kp, unsigned char* ws, LAS unsigned char* lds, int gw, int NGW, int wave, int lane) {
    LAS float* scr = (LAS float*)(lds + wave * 16384);
    convert_layer(kp, ws, 0, 0, CVT_WIN, scr, gw, NGW, lane);
    const int gt = gw * 64 + lane, NGT = NGW * 64;
    for (int e = gt; e < DEPTH * 2 * NH * 64 * 64; e += NGT) {
        const int i = e & 63, j = (e >> 6) & 63, h = (e >> 12) % NH, g = ((e >> 12) / NH) & 1, l = (e >> 12) / (2 * NH);
        const float v = AIN(kp, g ? I_LWX : I_LWA)[(((size_t)l * NH + h) * 64 + i) * 64 + j];
        ((bf16*)(ws + WS_W + (size_t)l * W_LAYER + W_L))[(((size_t)g * NH + h) * 64 + j) * 64 + i] = (bf16)(cvt_pk_bf16(v, 0.f) & 0xffffu);
    }
    for (int e = gt; e < DEPTH * 8 * 128 * 128; e += NGT) {
        const int s = e & 127, t = (e >> 7) & 127, l = e >> 17;
        float v = AIN(kp, I_WS)[e]; if ((t >> 6) < (s >> 6)) v = 0.f;
        ((bf16*)(ws + WS_W + (size_t)l * W_LAYER + W_S))[e & 131071] = (bf16)(cvt_pk_bf16(v, 0.f) & 0xffffu);
    }
    { float* z = (float*)(ws + WS_SSQ) + M; for (int e = gt; e < 8 * M; e += NGT) z[e] = 0.f; }
    for (int m = gw; m < M; m += NGW) {
        const f32x4* xr = (const f32x4*)(AIN(kp, I_X) + (size_t)m * D) + lane; u32x2* o = (u32x2*)((bf16*)(ws + WS_XB) + (size_t)m * D) + lane; float s = 0.f;
#pragma unroll
        for (int j = 0; j < 4; ++j) { const f32x4 v = xr[64 * j]; s += (v.x * v.x + v.y * v.y) + (v.z * v.z + v.w * v.w); u32x2 w; w.x = cvt_pk_bf16(v.x, v.y); w.y = cvt_pk_bf16(v.z, v.w); o[64 * j] = w; }
        s = wave_sum(s); if (lane == 0) ((float*)(ws + WS_SSQ))[m] = pg8::tofix(s, pg8::FIX_SSQ);
    }
}

struct SguP { const bf16* V; bf16* U; const bf16* Ws; const float* bs; const float* lng; const float* lnb; const float* vsum; const float* vsq; };
__device__ __forceinline__ unsigned off_b(unsigned row, unsigned ch) { return 256u * row + 16u * (ch ^ (((row & 3) << 2) | ((row >> 2) & 3))); }
__device__ __forceinline__ unsigned tr_addr16(unsigned lane, unsigned c, unsigned ks, unsigned t) { const unsigned g = lane >> 4, q = (lane & 15) >> 2, p = lane & 3; return off_b(32 * ks + 8 * g + 4 * t + q, 2 * c + (p >> 1)) + 8 * (p & 1); }
__device__ __forceinline__ void sgu_dma(const SguP& P, LAS unsigned char* raw, int it, int wave, int lane) {
    const int b = it >> 8, blk = (it >> 3) & 31, g = it & 7, r0 = b * SEQ + blk * 128, c0 = g * 128;
#pragma unroll
    for (int j = 0; j < 4; ++j) { const int row = 16 * wave + 4 * j + (lane >> 4);
        __builtin_amdgcn_global_load_lds((const unsigned*)(P.V + (size_t)(r0 + row) * 1024 + c0 + (lane & 15) * 8), (LAS unsigned*)(raw + (16 * wave + 4 * j) * 256), 16, 0, 0); }
}
__device__ __forceinline__ void sgu_item(const SguP& P, LAS unsigned char* vt, LAS unsigned char* raw, int it_next, int b, int blk, int g, int tid, int wave, int lane) {
    const int r0 = b * SEQ + blk * 128, c0 = g * 128, n = lane & 15, q = lane >> 4;
    const int cc = (tid & 15) * 8;
    const f32x4 g0 = *(const f32x4*)(P.lng + c0 + cc), g1 = *(const f32x4*)(P.lng + c0 + cc + 4), b0 = *(const f32x4*)(P.lnb + c0 + cc), b1 = *(const f32x4*)(P.lnb + c0 + cc + 4);
    float vs1[4], vs2[4];
#pragma unroll
    for (int i = 0; i < 4; ++i) { const int row = r0 + ((tid + 512 * i) >> 4); vs1[i] = P.vsum[row]; vs2[i] = P.vsq[row]; }
    const int nkk = (wave < 4) ? 2 : 4;
    const bf16* Wg = P.Ws + (size_t)g * 128 * 128 + (size_t)(16 * wave + n) * 128 + 8 * q;
    bf16x8 Aw[4];
#pragma unroll
    for (int kk = 0; kk < 4; ++kk) Aw[kk] = (kk < nkk) ? *(const bf16x8*)(Wg + 32 * kk) : (bf16x8){0, 0, 0, 0, 0, 0, 0, 0};
    const int t = 16 * wave + n; const float bias = P.bs[g * 128 + t];
    bf16* ubase = P.U + (size_t)(r0 + t) * 1024 + c0 + 4 * q;
    u32x2 upre[8];
#pragma unroll
    for (int c = 0; c < 8; ++c) upre[c] = *(const u32x2*)(ubase + 16 * c);
    asm volatile("s_waitcnt vmcnt(0)" ::: "memory"); __syncthreads();
#pragma unroll
    for (int i = 0; i < 4; ++i) {
        const int chunk = tid + 512 * i, s = chunk >> 4, ch = chunk & 15;
        const float mu = pg8::unfix(vs1[i], pg8::FIX_V) * (1.0f / 1024.0f), var = fmaxf(pg8::unfix(vs2[i], pg8::FIX_V) * (1.0f / 1024.0f) - mu * mu, 0.f), rstd = __builtin_amdgcn_rsqf(var + 1e-6f);
        const u32x4 v = *(const LAS u32x4*)(raw + chunk * 16);
        float y[8];
        y[0] = (bf_lo(v.x) - mu) * rstd * g0[0] + b0[0]; y[1] = (bf_hi(v.x) - mu) * rstd * g0[1] + b0[1]; y[2] = (bf_lo(v.y) - mu) * rstd * g0[2] + b0[2]; y[3] = (bf_hi(v.y) - mu) * rstd * g0[3] + b0[3];
        y[4] = (bf_lo(v.z) - mu) * rstd * g1[0] + b1[0]; y[5] = (bf_hi(v.z) - mu) * rstd * g1[1] + b1[1]; y[6] = (bf_lo(v.w) - mu) * rstd * g1[2] + b1[2]; y[7] = (bf_hi(v.w) - mu) * rstd * g1[3] + b1[3];
        u32x4 w; w.x = cvt_pk_bf16(y[0], y[1]); w.y = cvt_pk_bf16(y[2], y[3]); w.z = cvt_pk_bf16(y[4], y[5]); w.w = cvt_pk_bf16(y[6], y[7]);
        *(LAS u32x4*)(vt + off_b(s, ch)) = w;
    }
    __syncthreads();
    if (it_next >= 0) sgu_dma(P, raw, it_next, wave, lane);
    const unsigned vb = (unsigned)(size_t)vt;
#pragma unroll
    for (int c = 0; c < 8; ++c) {
        typedef unsigned short u16x4 __attribute__((ext_vector_type(4)));
        u16x4 r[8]; unsigned ad[8];
#pragma unroll
        for (int kk = 0; kk < 4; ++kk) { ad[2 * kk] = vb + tr_addr16(lane, c, kk, 0); ad[2 * kk + 1] = vb + tr_addr16(lane, c, kk, 1); }
        asm volatile("ds_read_b64_tr_b16 %0, %8\n\tds_read_b64_tr_b16 %1, %9\n\tds_read_b64_tr_b16 %2, %10\n\tds_read_b64_tr_b16 %3, %11\n\t"
                     "ds_read_b64_tr_b16 %4, %12\n\tds_read_b64_tr_b16 %5, %13\n\tds_read_b64_tr_b16 %6, %14\n\tds_read_b64_tr_b16 %7, %15\n\ts_waitcnt lgkmcnt(0)"
                     : "=&v"(r[0]), "=&v"(r[1]), "=&v"(r[2]), "=&v"(r[3]), "=&v"(r[4]), "=&v"(r[5]), "=&v"(r[6]), "=&v"(r[7])
                     : "v"(ad[0]), "v"(ad[1]), "v"(ad[2]), "v"(ad[3]), "v"(ad[4]), "v"(ad[5]), "v"(ad[6]), "v"(ad[7]) : "memory");
        f32x4 d = (f32x4){0.f, 0.f, 0.f, 0.f};
#pragma unroll
        for (int kk = 0; kk < 4; ++kk) { if (kk < nkk) { bf16x8 Bv; Bv[0] = (short)r[2 * kk][0]; Bv[1] = (short)r[2 * kk][1]; Bv[2] = (short)r[2 * kk][2]; Bv[3] = (short)r[2 * kk][3];
            Bv[4] = (short)r[2 * kk + 1][0]; Bv[5] = (short)r[2 * kk + 1][1]; Bv[6] = (short)r[2 * kk + 1][2]; Bv[7] = (short)r[2 * kk + 1][3];
            d = __builtin_amdgcn_mfma_f32_16x16x32_bf16(Bv, Aw[kk], d, 0, 0, 0); } }
        const u32x2 uw = upre[c];
        u32x2 o; o.x = cvt_pk_bf16(bf_lo(uw.x) * (d[0] + bias), bf_hi(uw.x) * (d[1] + bias)); o.y = cvt_pk_bf16(bf_lo(uw.y) * (d[2] + bias), bf_hi(uw.y) * (d[3] + bias));
        *(u32x2*)(ubase + 16 * c) = o;
    }
}

struct RnnP { bf16* XR; bf16* GY; const bf16* HALO; const bf16* WL; const float* cw; const float* cb; const float* ba; const float* bx; const float* lam; float* Atot; float* Hend; };
constexpr int XL_LD = 68;
__device__ __forceinline__ float softplus_f(float z) { return fmaxf(z, 0.f) + log1pf(__expf(-fabsf(z))); }
__device__ __forceinline__ void rnn_item(const RnnP& P, LAS float* xl, int b, int h, int seg, int lane) {
    const int n = lane & 15, q = lane >> 4;
    const int cD = h * 64 + 4 * n;
    bf16x8 Wf[2][4][2];
#pragma unroll
    for (int g = 0; g < 2; ++g)
#pragma unroll
        for (int c = 0; c < 4; ++c)
#pragma unroll
            for (int ks = 0; ks < 2; ++ks) Wf[g][c][ks] = *(const bf16x8*)(P.WL + (((size_t)g * NH + h) * 64 + 4 * n + c) * 64 + 32 * ks + 8 * q);
    const f32x4 ba4 = *(const f32x4*)(P.ba + cD), bx4 = *(const f32x4*)(P.bx + cD), lam4 = *(const f32x4*)(P.lam + cD);
    float sp4[4];
#pragma unroll
    for (int c = 0; c < 4; ++c) sp4[c] = 8.0f * softplus_f(-lam4[c]);
    float hin[4] = {0.f, 0.f, 0.f, 0.f}, atot[4] = {1.f, 1.f, 1.f, 1.f};
    LAS float* wlp = xl + 16 * XL_LD;
#pragma unroll
    for (int k = 0; k < 5; ++k) wlp[k * 64 + lane] = (k < 4) ? P.cw[k * DRNN + h * 64 + lane] : P.cb[h * 64 + lane];
    u32x4 xn[2][4];
#define RNN_FETCH(NT) do { const int tl_ = 16 * (NT) + n; _Pragma("unroll") for (int ks = 0; ks < 2; ++ks) _Pragma("unroll") for (int k = 0; k < 4; ++k) { const int tl = tl_ - 3 + k;   \
        const bf16* src = (tl >= 0) ? P.XR + ((size_t)(b * SEQ + seg * 64 + tl)) * DRNN : P.HALO + ((size_t)((b * NSEG + (seg > 0 ? seg - 1 : 0)) * 3 + (tl + 3))) * DRNN; \
        u32x4 xv = *(const u32x4*)(src + h * 64 + 32 * ks + 8 * q); if (tl < 0 && seg == 0) xv = (u32x4){0u, 0u, 0u, 0u}; xn[ks][k] = xv; } } while (0)
    RNN_FETCH(0);
#pragma unroll 1
    for (int nt = 0; nt < 4; ++nt) {
        asm volatile("" ::: "memory");
        const int t0 = seg * 64 + 16 * nt;
        bf16x8 Xf[2];
#pragma unroll
        for (int ks = 0; ks < 2; ++ks) {
            const LAS float* wq = wlp + 32 * ks + 8 * q;
            f32x4 x0 = *(const LAS f32x4*)(wq + 4 * 64), x1 = *(const LAS f32x4*)(wq + 4 * 64 + 4);
#pragma unroll
            for (int k = 0; k < 4; ++k) { const u32x4 xv = xn[ks][k];
                const f32x4 w0 = *(const LAS f32x4*)(wq + k * 64), w1 = *(const LAS f32x4*)(wq + k * 64 + 4);
                x0[0] += bf_lo(xv.x) * w0[0]; x0[1] += bf_hi(xv.x) * w0[1]; x0[2] += bf_lo(xv.y) * w0[2]; x0[3] += bf_hi(xv.y) * w0[3];
                x1[0] += bf_lo(xv.z) * w1[0]; x1[1] += bf_hi(xv.z) * w1[1]; x1[2] += bf_lo(xv.w) * w1[2]; x1[3] += bf_hi(xv.w) * w1[3]; }
            *(LAS f32x4*)(xl + n * XL_LD + 32 * ks + 8 * q) = x0; *(LAS f32x4*)(xl + n * XL_LD + 32 * ks + 8 * q + 4) = x1;
            u32x4 w; w.x = cvt_pk_bf16(x0[0], x0[1]); w.y = cvt_pk_bf16(x0[2], x0[3]); w.z = cvt_pk_bf16(x1[0], x1[1]); w.w = cvt_pk_bf16(x1[2], x1[3]);
            Xf[ks] = __builtin_bit_cast(bf16x8, w);
        }
        if (nt < 3) RNN_FETCH(nt + 1);
        u32x2 gpre[4];
#pragma unroll
        for (int jj = 0; jj < 4; ++jj) gpre[jj] = *(const u32x2*)(P.GY + ((size_t)(b * SEQ + t0 + 4 * q + jj)) * DRNN + cD);
        f32x4 Da[4], Dx[4];
#pragma unroll
        for (int c = 0; c < 4; ++c) {
            Da[c] = __builtin_amdgcn_mfma_f32_16x16x32_bf16(Xf[0], Wf[0][c][0], (f32x4){0.f, 0.f, 0.f, 0.f}, 0, 0, 0); Da[c] = __builtin_amdgcn_mfma_f32_16x16x32_bf16(Xf[1], Wf[0][c][1], Da[c], 0, 0, 0);
            Dx[c] = __builtin_amdgcn_mfma_f32_16x16x32_bf16(Xf[0], Wf[1][c][0], (f32x4){0.f, 0.f, 0.f, 0.f}, 0, 0, 0); Dx[c] = __builtin_amdgcn_mfma_f32_16x16x32_bf16(Xf[1], Wf[1][c][1], Dx[c], 0, 0, 0);
        }
        f32x4 xd[4];
#pragma unroll
        for (int jj = 0; jj < 4; ++jj) xd[jj] = *(const LAS f32x4*)(xl + (4 * q + jj) * XL_LD + 4 * n);
        float hh[4][4], pp[4][4];
#pragma unroll
        for (int c = 0; c < 4; ++c) {
            float av[4], uv[4];
#pragma unroll
            for (int jj = 0; jj < 4; ++jj) {
                const float r = sigm(Da[c][jj] + ba4[c]), ig = sigm(Dx[c][jj] + bx4[c]);
                const float la = -r * sp4[c];
                float d = -la * (1.0f + la * (0.5f + la * (0.16666667f + la * (0.041666668f + la * (0.0083333338f + la * (0.0013888889f + la * 0.0001984127f))))));
                if (__builtin_expect(__any(la < -0.35f), 0)) { if (la < -0.35f) d = 1.0f - __builtin_amdgcn_exp2f(1.44269504f * la); }
                av[jj] = 1.0f - d;
                uv[jj] = __builtin_amdgcn_sqrtf(d * (2.0f - d)) * (ig * xd[jj][c]);
            }
            pp[c][0] = av[0]; hh[c][0] = uv[0];
#pragma unroll
            for (int jj = 1; jj < 4; ++jj) { hh[c][jj] = av[jj] * hh[c][jj - 1] + uv[jj]; pp[c][jj] = av[jj] * pp[c][jj - 1]; }
        }
        float Aq[4], Hq[4], Ax[4], Hx[4];
#pragma unroll
        for (int c = 0; c < 4; ++c) { Aq[c] = pp[c][3]; Hq[c] = hh[c][3]; }
#pragma unroll
        for (int c = 0; c < 4; ++c) { Ax[c] = __shfl_up(Aq[c], 16); Hx[c] = __shfl_up(Hq[c], 16); }
#pragma unroll
        for (int c = 0; c < 4; ++c) if (q >= 1) { Hq[c] = Aq[c] * Hx[c] + Hq[c]; Aq[c] = Aq[c] * Ax[c]; }
#pragma unroll
        for (int c = 0; c < 4; ++c) { Ax[c] = __shfl_up(Aq[c], 32); Hx[c] = __shfl_up(Hq[c], 32); }
#pragma unroll
        for (int c = 0; c < 4; ++c) if (q >= 2) { Hq[c] = Aq[c] * Hx[c] + Hq[c]; Aq[c] = Aq[c] * Ax[c]; }
        float A3[4], H3[4];
#pragma unroll
        for (int c = 0; c < 4; ++c) { Ax[c] = __shfl_up(Aq[c], 16); Hx[c] = __shfl_up(Hq[c], 16); A3[c] = __shfl(Aq[c], 48 + n); H3[c] = __shfl(Hq[c], 48 + n); }
#pragma unroll
        for (int c = 0; c < 4; ++c) {
            if (q == 0) { Ax[c] = 1.f; Hx[c] = 0.f; }
            const float cin = Hx[c] + Ax[c] * hin[c], pin = Ax[c] * atot[c];
#pragma unroll
            for (int jj = 0; jj < 4; ++jj) { hh[c][jj] = hh[c][jj] + pp[c][jj] * cin; pp[c][jj] = pp[c][jj] * pin; }
            hin[c] = H3[c] + A3[c] * hin[c]; atot[c] *= A3[c];
        }
#pragma unroll
        for (int jj = 0; jj < 4; ++jj) { const size_t o = ((size_t)(b * SEQ + t0 + 4 * q + jj)) * DRNN + cD; const u32x2 gw = gpre[jj];
            const float g0 = bf_lo(gw.x), g1 = bf_hi(gw.x), g2 = bf_lo(gw.y), g3 = bf_hi(gw.y);
            u32x2 oy; oy.x = cvt_pk_bf16(hh[0][jj] * g0, hh[1][jj] * g1); oy.y = cvt_pk_bf16(hh[2][jj] * g2, hh[3][jj] * g3); *(u32x2*)(P.GY + o) = oy;
            u32x2 op; op.x = cvt_pk_bf16(pp[0][jj] * g0, pp[1][jj] * g1); op.y = cvt_pk_bf16(pp[2][jj] * g2, pp[3][jj] * g3); *(u32x2*)(P.XR + o) = op; }
    }
    if (q == 0) { const size_t o = ((size_t)(b * NSEG + seg)) * DRNN + cD;
        *(f32x4*)(P.Atot + o) = (f32x4){atot[0], atot[1], atot[2], atot[3]}; *(f32x4*)(P.Hend + o) = (f32x4){hin[0], hin[1], hin[2], hin[3]}; }
}
__device__ __forceinline__ void rnn_apply(const RnnP& P, LAS float* cl, int b, int seg, int tid) {
    if (seg == 0) return;
    {
        float H[3] = {0.f, 0.f, 0.f};
        for (int s0 = 0; s0 < seg; s0 += 16) { float as[3][16], hs[3][16];
#pragma unroll
            for (int k = 0; k < 3; ++k) { const int c = tid + k * NWAVES * 64;
#pragma unroll
                for (int j = 0; j < 16; ++j) { const bool in = (s0 + j < seg) && (c < DRNN); const size_t o = ((size_t)(b * NSEG + (in ? s0 + j : 0))) * DRNN + (in ? c : 0); as[k][j] = in ? P.Atot[o] : 1.f; hs[k][j] = in ? P.Hend[o] : 0.f; } }
#pragma unroll
            for (int k = 0; k < 3; ++k)
#pragma unroll
                for (int j = 0; j < 16; ++j) H[k] = as[k][j] * H[k] + hs[k][j]; }
#pragma unroll
        for (int k = 0; k < 3; ++k) { const int c = tid + k * NWAVES * 64; if (c < DRNN) cl[c] = H[k]; }
    }
    __syncthreads();
    for (int i = tid; i < 64 * (DRNN / 8); i += NWAVES * 64) { const int r = i / (DRNN / 8), ch = (i % (DRNN / 8)) * 8; const size_t o = ((size_t)(b * SEQ + seg * 64 + r)) * DRNN + ch;
        const u32x4 y = *(const u32x4*)(P.GY + o), p = *(const u32x4*)(P.XR + o); const f32x4 c0 = *(const LAS f32x4*)(cl + ch), c1 = *(const LAS f32x4*)(cl + ch + 4);
        u32x4 w; w.x = cvt_pk_bf16(bf_lo(y.x) + bf_lo(p.x) * c0[0], bf_hi(y.x) + bf_hi(p.x) * c0[1]); w.y = cvt_pk_bf16(bf_lo(y.y) + bf_lo(p.y) * c0[2], bf_hi(y.y) + bf_hi(p.y) * c0[3]);
        w.z = cvt_pk_bf16(bf_lo(y.z) + bf_lo(p.z) * c1[0], bf_hi(y.z) + bf_hi(p.z) * c1[1]); w.w = cvt_pk_bf16(bf_lo(y.w) + bf_lo(p.w) * c1[2], bf_hi(y.w) + bf_hi(p.w) * c1[3]);
        *(u32x4*)(P.GY + o) = w; }
    __syncthreads();
}
#define XB_TMO      128
#define XB_XCNT(j)  (256  + 64 * (j))
#define XB_XSUB(j)  (1280 + 64 * (j))
#define XB_XGEN(j)  (2304 + 64 * (j))
#define XB_TOP      3328
#define XB_TOPGEN   3392
#define XCD_BAR_WORDS 3456
#define XB_SPIN_CAP (1u << 18)

__device__ __forceinline__ unsigned xb_ld(unsigned* p)              { return __hip_atomic_load(p, __ATOMIC_RELAXED, __HIP_MEMORY_SCOPE_AGENT); }
__device__ __forceinline__ unsigned xb_add(unsigned* p, unsigned v) { return __hip_atomic_fetch_add(p, v, __ATOMIC_RELAXED, __HIP_MEMORY_SCOPE_AGENT); }
__device__ __forceinline__ unsigned xb_xcc_id() { return (unsigned)__builtin_amdgcn_s_getreg((3 << 11) | 20) & 0xFu; }
#define XB_SPIN(cond, bar) do { unsigned _sp = 0; while (cond) { __builtin_amdgcn_s_sleep(1); \
    if ((++_sp & 255u) == 0u) { if (xb_ld(&(bar)[XB_TMO])) break; if (_sp > XB_SPIN_CAP) { atomicAdd(&(bar)[XB_TMO], 1u); break; } } } } while (0)

struct XcdBarrier {
    unsigned* bar; unsigned x;
    volatile LAS unsigned* st;
};

__device__ __forceinline__ XcdBarrier xcd_barrier_post(unsigned* bar, volatile LAS unsigned* st) {
    XcdBarrier b; b.bar = bar; b.x = xb_xcc_id(); b.st = st;
    if (threadIdx.x == 0) (void)xb_add(&bar[XB_XCNT(b.x)], 1u);
    return b;
}
__device__ __forceinline__ void xcd_barrier_complete(unsigned* bar, unsigned x, unsigned& nloc, unsigned& nx) {
    const unsigned G = gridDim.x * gridDim.y * gridDim.z;
    unsigned sum, cnt, mine, sp = 0u;
    for (;;) {
        sum = 0u; cnt = 0u; mine = 0u;
#pragma unroll
        for (unsigned j = 0; j < 16; ++j) { const unsigned c = xb_ld(&bar[XB_XCNT(j)]); sum += c; cnt += (c > 0u) ? 1u : 0u; mine = (j == x) ? c : mine; }
        if (sum == G) break;
        __builtin_amdgcn_s_sleep(1);
        if ((++sp & 255u) == 0u) { if (xb_ld(&bar[XB_TMO])) break; if (sp > XB_SPIN_CAP) { atomicAdd(&bar[XB_TMO], 1u); break; } }
    }
    nloc = mine > 0u ? mine : 1u; nx = cnt > 0u ? cnt : 1u;
}

__device__ __forceinline__ void xcd_barrier(const XcdBarrier& b) {
    asm volatile("s_waitcnt vmcnt(0)" ::: "memory");
    __syncthreads();
    if (threadIdx.x == 0) {
        unsigned* bar = b.bar;
        __builtin_amdgcn_s_waitcnt(0);
        unsigned nloc = b.st[0], nx = b.st[1];
        if (nloc == 0u) { xcd_barrier_complete(bar, b.x, nloc, nx); b.st[0] = nloc; b.st[1] = nx; }
        const unsigned old = xb_add(&bar[XB_XSUB(b.x)], 1u);
        const unsigned gen = old / nloc;
        if (old + 1u == (gen + 1u) * nloc) {
            __builtin_amdgcn_fence(__ATOMIC_RELEASE, "agent");
            asm volatile("s_waitcnt vmcnt(0)" ::: "memory");
            const unsigned og = xb_add(&bar[XB_TOP], 1u);
            const unsigned tg = og / nx;
            if (og + 1u == (tg + 1u) * nx) xb_add(&bar[XB_TOPGEN], 1u);
            else XB_SPIN(xb_ld(&bar[XB_TOPGEN]) == tg, bar);
            __builtin_amdgcn_fence(__ATOMIC_ACQUIRE, "agent");
            xb_add(&bar[XB_XGEN(b.x)], 1u);
            asm volatile("s_waitcnt vmcnt(0)" ::: "memory");
        } else {
            XB_SPIN(xb_ld(&bar[XB_XGEN(b.x)]) == gen, bar);
            __builtin_amdgcn_fence(__ATOMIC_ACQUIRE, "agent");
            asm volatile("s_waitcnt vmcnt(0)" ::: "memory");
        }
    }
    __syncthreads();
}
#ifndef PH_HI
#define PH_HI NPHASE
#endif
#ifndef PH_MASK
#define PH_MASK 511
#endif

struct P3Sched {
    pg8::StaticOrder S0; const bf16 *XB, *WG, *YA, *WA, *YB, *WB;
    __device__ __forceinline__ bool next(int i, pg8::UnitX& u) const { pg8::Unit t; if (!S0.next(i >> 2, t)) return false; const int s = i & 3; u.pm = t.pm; u.pn = t.pn; u.kind = s;
        if (s == 0) { u.A = XB; u.Bt = WG; u.K = D; } else if (s == 1) { u.A = YA; u.Bt = WA; u.K = DRNN; } else if (s == 2) { u.A = XB; u.Bt = WG + (size_t)D * D; u.K = D; } else { u.A = YB; u.Bt = WB; u.K = D; }
        return true; }
    __device__ __forceinline__ void a_ready(const pg8::UnitX&) const {}
    __device__ __forceinline__ void done(const pg8::UnitX&) const {}
};
struct EpiP3 {
    static constexpr bool PERM = true, AFTER_DRAIN = false;
    pg8::EpiGate8 ga, gb; pg8::EpiMix<false> ma; pg8::EpiMix<true> mb;
    __device__ __forceinline__ void operator()(const pg8::f32x4 (&acc)[2][2][4][2], const pg8::UnitX& u, int wr, int wc, int fr, int fq) const {
        const pg8::Unit t{u.pm, u.pn};
        if (u.kind == 0) ga(acc, t, wr, wc, fr, fq); else if (u.kind == 1) ma(acc, t, wr, wc, fr, fq); else if (u.kind == 2) gb(acc, t, wr, wc, fr, fq); else mb(acc, t, wr, wc, fr, fq);
    }
};

__global__ void __launch_bounds__(NWAVES * 64, 2) fwd_megakernel(Args a) {
    extern __shared__ __attribute__((aligned(16))) unsigned char lds_raw[];
    LAS unsigned char* lds = (LAS unsigned char*)lds_raw;
    cg::grid_group grid = cg::this_grid();
    { LAS unsigned* z = (LAS unsigned*)(lds + 131072); if (threadIdx.x < 64) z[threadIdx.x] = 0u; }
    __syncthreads();
    grid.sync();
    (void)xcd_barrier_post((unsigned*)(*(unsigned char* const __attribute__((address_space(4)))*)((kptr_t)__builtin_amdgcn_kernarg_segment_ptr() + 176) + WS_BAR), (volatile LAS unsigned*)(lds + 131072 + 32));
    int tid = threadIdx.x, G = gridDim.x, bx = blockIdx.x;
    kptr_t kp = (kptr_t)__builtin_amdgcn_kernarg_segment_ptr();
    unsigned char* ws = *(unsigned char* const __attribute__((address_space(4)))*)(kp + 176);
    float* const outp = *(float* const __attribute__((address_space(4)))*)(kp + 168);
    const int ph_lo = *(const int __attribute__((address_space(4)))*)(kp + 184), ph_hi = *(const int __attribute__((address_space(4)))*)(kp + 188);
#define REFRESH_PTRS() asm volatile("" : "+s"(ws), "+s"(kp))
    float* ssq = (float*)(ws + WS_SSQ); float* vst = (float*)(ws + WS_VST);
    bf16* XB = (bf16*)(ws + WS_XB); bf16* XR = (bf16*)(ws + WS_XR); bf16* GR = (bf16*)(ws + WS_GR); bf16* U = (bf16*)(ws + WS_U); bf16* V = (bf16*)(ws + WS_V);
    bf16* F = (bf16*)(ws + WS_F); bf16* S1 = (bf16*)(ws + WS_S1); bf16* S2 = (bf16*)(ws + WS_S2);

    for (int ph = ph_lo; ph < ph_hi; ++ph) {
        if (ph > ph_lo) { XcdBarrier bar; bar.bar = (unsigned*)(ws + WS_BAR); bar.x = xb_xcc_id(); bar.st = (volatile LAS unsigned*)(lds + 131072 + 32); xcd_barrier(bar); }
#ifdef TS_SEL
        if (blockIdx.x == 0 && threadIdx.x == 0) ((unsigned long long*)(ws + WS_TS))[ph] = __builtin_amdgcn_s_memrealtime();
        if (ph == NPHASE - 1) { XcdBarrier bar; bar.bar = (unsigned*)(ws + WS_BAR); bar.x = xb_xcc_id(); bar.st = (volatile LAS unsigned*)(lds + 131072 + 32); xcd_barrier(bar); }
#endif
        asm volatile("" : "+s"(ws)); asm volatile("" : "+s"(kp)); asm volatile("" : "+v"(tid)); asm volatile("" : "+s"(G)); asm volatile("" : "+s"(bx));
        const int lane = tid & 63, wave = __builtin_amdgcn_readfirstlane(tid >> 6);
        const int vcu = (G % 8 == 0) ? (bx % 8) * (G / 8) + bx / 8 : bx;
        const int gw = vcu * NWAVES + wave, NGW = G * NWAVES;
        ssq = (float*)(ws + WS_SSQ); vst = (float*)(ws + WS_VST); XB = (bf16*)(ws + WS_XB); XR = (bf16*)(ws + WS_XR); GR = (bf16*)(ws + WS_GR); U = (bf16*)(ws + WS_U); V = (bf16*)(ws + WS_V);
        F = (bf16*)(ws + WS_F); S1 = (bf16*)(ws + WS_S1); S2 = (bf16*)(ws + WS_S2);
        if (ph == 0) { if (PH_MASK & 256) p0_prologue(kp, ws, lds, gw, NGW, wave, lane); continue; }
        if (ph == NPHASE - 1) {
            const float* gf = AIN(kp, I_FNG);
            for (int m = gw; m < M; m += NGW) { f32x4* xr = (f32x4*)(outp + (size_t)m * D) + lane; const u32x2* xbr = (const u32x2*)(XB + (size_t)m * D) + lane; f32x4 v[4]; float s = 0.f;
#pragma unroll
                for (int j = 0; j < 4; ++j) { const u32x2 w = xbr[64 * j]; v[j] = (f32x4){bf_lo(w.x), bf_hi(w.x), bf_lo(w.y), bf_hi(w.y)}; s += (v[j].x * v[j].x + v[j].y * v[j].y) + (v[j].z * v[j].z + v[j].w * v[j].w); }
                const float rs = __builtin_amdgcn_rsqf(wave_sum(s) * (1.0f / 1024.0f) + pg8::RMS_EPS);
#pragma unroll
                for (int j = 0; j < 4; ++j) { const f32x4 g4 = *((const f32x4*)gf + lane + 64 * j); f32x4 o = v[j] * rs * g4;
#ifdef TS_SEL
                    { const unsigned long long* ts = (const unsigned long long*)(ws + WS_TS); unsigned long long sel = 0; const int ids[] = TS_SEL;
                      for (unsigned k = 0; k < sizeof(ids) / sizeof(int); ++k) sel += ts[ids[k] + 1] - ts[ids[k]];
                      const float frac = (float)sel / (float)(ts[NPHASE - 1] - ts[0]), dlt = 0.02f * sqrtf(frac); o += (f32x4){dlt, -dlt, dlt, -dlt}; }
#endif
                    xr[64 * j] = o; } }
            continue;
        }
        const int l = (ph - 1) / 7, sub = (ph - 1) % 7;
        const unsigned char* wl = ws + WS_W + (size_t)l * W_LAYER;
        if (sub == 0 && (PH_MASK & 1)) {
            pg8::Gemm g{XB, (const bf16*)(wl + W_IN), M, NP1, D}; pg8::StaticOrder S; S.init(M, NP1, G, bx);
            pg8::EpiIn E{XR, GR, U, V, (bf16*)(ws + WS_HALO), ssq + (2 * l) * M, vst + (2 * l) * M, vst + (2 * l + 1) * M};
            pg8::gemm_phase<pg8::EpiIn, pg8::StaticOrder, true, true>(lds, g, S, E, tid);
            {
                const int rounds = (S.nwg + G - 1) / G, nidle = rounds * G - S.nwg, first_idle = G - nidle;
                const bool all = (nidle == 0); const int cg = all ? gw : (bx - first_idle) * NWAVES + wave, cn = all ? NGW : nidle * NWAVES;
                if (all || bx >= first_idle) { LAS float* scr = (LAS float*)(lds + wave * 16384);
                    convert_layer(kp, ws, l, CVT_WIN, CVT_ALL, scr, cg, cn, lane);
                    if (l + 1 < DEPTH) convert_layer(kp, ws, l + 1, 0, CVT_WIN, scr, cg, cn, lane); }
            }
        }
#ifdef NAIVE_MIX
        else if (sub == 1) { naive_vstats(V, vst + (2 * l) * M, vst + (2 * l + 1) * M, gw, NGW, lane); }
        else if (sub == 2) {
            naive_sgu(V, U, AIN(kp, I_WS) + (size_t)l * 8 * 128 * 128, AIN(kp, I_BS) + l * 1024, AIN(kp, I_LNG) + l * 1024, AIN(kp, I_LNB) + l * 1024, vst + (2 * l) * M, vst + (2 * l + 1) * M, gw * 64 + lane, NGW * 64);
            naive_rnn(XR, GR, AIN(kp, I_LWA) + (size_t)l * NH * 4096, AIN(kp, I_LWX) + (size_t)l * NH * 4096, AIN(kp, I_LBA) + l * DRNN, AIN(kp, I_LBX) + l * DRNN, AIN(kp, I_LAM) + l * DRNN, AIN(kp, I_CW) + l * 4 * DRNN, AIN(kp, I_CB) + l * DRNN, gw, NGW, lane);
        }
#endif
        else if (sub == 1 && (PH_MASK & 2)) {
            SguP P{V, U, (const bf16*)(wl + W_S), AIN(kp, I_BS) + l * 1024, AIN(kp, I_LNG) + l * 1024, AIN(kp, I_LNB) + l * 1024, vst + (2 * l) * M, vst + (2 * l + 1) * M};
            { LAS unsigned char* raw = lds + 32768; if (vcu < BATCH * 32 * 8) sgu_dma(P, raw, vcu, wave, lane);
              for (int it = vcu; it < BATCH * 32 * 8; it += G) sgu_item(P, lds, raw, (it + G < BATCH * 32 * 8) ? it + G : -1, it >> 8, (it >> 3) & 31, it & 7, tid, wave, lane);
              __syncthreads(); }
            RnnP R{XR, GR, (const bf16*)(ws + WS_HALO), (const bf16*)(wl + W_L), AIN(kp, I_CW) + l * 4 * DRNN, AIN(kp, I_CB) + l * DRNN, AIN(kp, I_LBA) + l * DRNN, AIN(kp, I_LBX) + l * DRNN, AIN(kp, I_LAM) + l * DRNN,
                   (float*)(ws + WS_ATOT), (float*)(ws + WS_HEND)};
            LAS float* xl = (LAS float*)(lds + 40960 + wave * 6144);
            { const int per = (BATCH * NH * NSEG + G - 1) / G, base = vcu * per, lim = min(base + per, BATCH * NH * NSEG);
              for (int j = wave; j < per; j += NWAVES) { const int it = base + j; if (it < lim) rnn_item(R, xl, (it / NH) % BATCH, it % NH, it / (NH * BATCH), lane); } }
        } else if (sub == 2 && (PH_MASK & 4)) {
            RnnP R{XR, GR, (const bf16*)(ws + WS_HALO), (const bf16*)(wl + W_L), AIN(kp, I_CW) + l * 4 * DRNN, AIN(kp, I_CB) + l * DRNN, AIN(kp, I_LBA) + l * DRNN, AIN(kp, I_LBX) + l * DRNN, AIN(kp, I_LAM) + l * DRNN,
                   (float*)(ws + WS_ATOT), (float*)(ws + WS_HEND)};
            for (int it = vcu; it < BATCH * NSEG; it += G) rnn_apply(R, (LAS float*)lds, it / NSEG, it % NSEG, tid);
        } else if (sub == 3 && (PH_MASK & 8)) {
            pg8::StaticOrder S; S.init(M, D, G, bx);
            unsigned char* G8 = (unsigned char*)outp;
            P3Sched PS{S, XB, (const bf16*)(wl + W_G), GR, (const bf16*)(wl + W_A), U, (const bf16*)(wl + W_B)};
            EpiP3 E{pg8::EpiGate8{G8, ssq + (2 * l) * M}, pg8::EpiGate8{G8 + (size_t)M * D, ssq + (2 * l) * M}, pg8::EpiMix<false>{S1, G8}, pg8::EpiMix<true>{S1, G8 + (size_t)M * D}};
            pg8::gemm_phase_multi<EpiP3, P3Sched, true, true>(lds, PS, E, tid);
        } else if (sub == 4 && (PH_MASK & 16)) {
            pg8::Gemm g{S1, (const bf16*)(wl + W_O), M, D, D}; pg8::StaticOrder S; S.init(M, D, G, bx);
            pg8::EpiRes E{XB, ssq + (2 * l + 1) * M};
            pg8::gemm_phase<pg8::EpiRes, pg8::StaticOrder, true, true>(lds, g, S, E, tid);
        } else if (sub == 5 && (PH_MASK & 32)) {
            pg8::Gemm g{XB, (const bf16*)(wl + W_UP), M, FF, D}; pg8::StaticOrder S; S.init(M, FF, G, bx);
            pg8::EpiAct<1> E{F, FF, ssq + (2 * l + 1) * M};
            pg8::gemm_phase<pg8::EpiAct<1>, pg8::StaticOrder, true, true>(lds, g, S, E, tid);
        } else if (PH_MASK & 64) {
            pg8::Gemm g{F, (const bf16*)(wl + W_DN), M, D, FF}; pg8::StaticOrder S; S.init(M, D, G, bx);
            pg8::EpiRes E{XB, ssq + (2 * l + 2) * M};
            pg8::gemm_phase<pg8::EpiRes, pg8::StaticOrder, true, true>(lds, g, S, E, tid);
        }
    }
}

extern "C" void kernel_launch(void* const* d_in, const int* in_sizes, int n_in, void* d_out, int out_size, void* d_ws, size_t ws_size, hipStream_t stream) {
    static int grid = 0;
    if (grid == 0) {
        if (n_in != 21 || out_size != M * D || ws_size < WS_END) { fprintf(stderr, "kernel_launch: unexpected shapes (n_in %d, out %d, ws %zu); nothing launched\n", n_in, out_size, ws_size); grid = -1; return; }
        int dev = 0, cus = 0, per_cu = 0;
        if (hipGetDevice(&dev) != hipSuccess || hipDeviceGetAttribute(&cus, hipDeviceAttributeMultiprocessorCount, dev) != hipSuccess) { grid = -1; return; }
        if (hipFuncSetAttribute((const void*)fwd_megakernel, hipFuncAttributeMaxDynamicSharedMemorySize, LDS_BYTES) != hipSuccess) { fprintf(stderr, "kernel_launch: hipFuncSetAttribute failed\n"); grid = -1; return; }
        if (hipOccupancyMaxActiveBlocksPerMultiprocessor(&per_cu, (const void*)fwd_megakernel, NWAVES * 64, LDS_BYTES) != hipSuccess || per_cu < 1) per_cu = 1;
        (void)hipGetLastError();
        grid = cus * per_cu;
        fprintf(stderr, "kernel_launch: %d CUs x %d -> grid %d, ws %zu\n", cus, per_cu, grid, ws_size);
    }
    if (grid < 0) return;
#ifdef EXP_POISON
    (void)hipMemsetAsync(d_ws, 0xAA, WS_END, stream); (void)hipMemsetAsync(d_out, 0xAA, (size_t)M * D * 4, stream);
#endif
    if (hipMemsetAsync((char*)d_ws + WS_BAR, 0, 16384, stream) != hipSuccess) { fprintf(stderr, "kernel_launch: hipMemsetAsync failed\n"); return; }
    Args a{};
    for (int i = 0; i < 21; ++i) a.in[i] = (const float*)d_in[i];
    a.out = (float*)d_out; a.ws = (unsigned char*)d_ws; a.ph_lo = 0; a.ph_hi = PH_HI;
    void* args[] = {&a};
    const hipError_t e = hipLaunchCooperativeKernel((const void*)fwd_megakernel, dim3(grid), dim3(NWAVES * 64), args, LDS_BYTES, stream);
    if (e != hipSuccess) fprintf(stderr, "kernel_launch: cooperative launch failed: %s (grid %d)\n", hipGetErrorString(e), grid);
}
```

```cpp
#include <hip/hip_runtime.h>
#include <hip/hip_cooperative_groups.h>
#include <cstdio>
#include <cstdint>
namespace cg = cooperative_groups;
namespace pg8 {
#define PG8_LAS __attribute__((address_space(3)))
typedef unsigned short bf16_t;
typedef short bf16x8 __attribute__((ext_vector_type(8)));
typedef float f32x4 __attribute__((ext_vector_type(4)));
typedef unsigned u32x4 __attribute__((ext_vector_type(4)));
typedef unsigned u32x2 __attribute__((ext_vector_type(2)));
constexpr int BM = 256, BK = 64, HALF = 128, HTB = HALF * BK * 2, STAGE_BYTES = 8 * HTB, NXCD = 8, WGM = 4;
__host__ __device__ __forceinline__ int lds_byte(int r, int c) { const int st = (r >> 4) * 2 + (c >> 5), rr = r & 15, cc = c & 31, ob = rr * 64 + cc * 2; return st * 1024 + (ob ^ (((ob >> 9) & 1) << 5)); }
__host__ __device__ __forceinline__ void stage_rc(int b, int& R, int& C) { const int st = b / 1024, sb = b % 1024, swz = sb ^ (((sb >> 9) & 1) << 5); R = (st >> 1) * 16 + swz / 64; C = (st & 1) * 32 + (swz % 64) / 2; }
__host__ __device__ __forceinline__ int perm32(int rho) { const int n = rho >> 4, i = rho & 15; return 8 * (i >> 2) + 4 * n + (i & 3); }
struct Unit { int pm, pn; };
struct Gemm { const bf16_t* A; const bf16_t* Bt; int M, N, K; };
struct StaticOrder {
    int nM, nN, nwg, G, c;
    __host__ __device__ void init(int M, int N, int G_, int c_) { nM = M / BM; nN = N / BM; nwg = nM * nN; G = G_; c = c_; }
    __host__ __device__ bool next(int i, Unit& u) const {
        const long L = (long)i * G + c; if (L >= nwg) return false;
        int wgid = (int)L; { const int q = nwg / NXCD, r = nwg % NXCD, xcd = wgid % NXCD, off = wgid / NXCD; wgid = (xcd < r ? xcd * (q + 1) : r * (q + 1) + (xcd - r) * q) + off; }
        const int nig = WGM * nN, gid = wgid / nig, fm = gid * WGM, gsz = (nM - fm) < WGM ? (nM - fm) : WGM;
        u.pm = fm + ((wgid % nig) % gsz); u.pn = (wgid % nig) / gsz; return true;
    }
    __device__ __forceinline__ void a_ready(const Unit&) const {}
    __device__ __forceinline__ void done(const Unit&) const {}
};

constexpr float RMS_EPS = 1e-6f;
__device__ __forceinline__ unsigned cvt_pk_bf16(float lo, float hi) { unsigned r; asm volatile("v_cvt_pk_bf16_f32 %0, %1, %2" : "=v"(r) : "v"(lo), "v"(hi)); return r; }
__device__ __forceinline__ float bf_lo(unsigned w) { return __uint_as_float(w << 16); }
__device__ __forceinline__ float bf_hi(unsigned w) { return __uint_as_float(w & 0xffff0000u); }
__device__ __forceinline__ float sigm(float x) { return __builtin_amdgcn_rcpf(1.0f + __builtin_amdgcn_exp2f(-1.44269504f * x)); }
__device__ __forceinline__ float gelu_t(float x) { const float z = x * (1.5957691216f + 0.0713548163f * x * x); return x * __builtin_amdgcn_rcpf(1.0f + __builtin_amdgcn_exp2f(-1.44269504f * z)); }
constexpr float FIX_SSQ = 4096.0f, FIX_V = 65536.0f;
__device__ __forceinline__ float unfix(float slot, float scale) { return (float)(int)__float_as_uint(slot) * (1.0f / scale); }
__device__ __forceinline__ float tofix(float v, float scale) { return __uint_as_float((unsigned)(int)__builtin_rintf(v * scale)); }
__device__ __forceinline__ float rstd_of(float ssq) { return __builtin_amdgcn_rsqf(unfix(ssq, FIX_SSQ) * (1.0f / 1024.0f) + RMS_EPS); }
__device__ __forceinline__ void fadd_fix(float* p, float v, float scale) { (void)__hip_atomic_fetch_add((unsigned*)p, (unsigned)(int)__builtin_rintf(v * scale), __ATOMIC_RELAXED, __HIP_MEMORY_SCOPE_AGENT); }

struct EpiIn {
    static constexpr bool PERM = true, AFTER_DRAIN = false;
    bf16_t* XR; bf16_t* GR; bf16_t* U; bf16_t* V; bf16_t* HALO; const float* ssq; float* vsum; float* vsq;
    __device__ __forceinline__ void operator()(const f32x4 (&acc)[2][2][4][2], const Unit& u, int wr, int wc, int fr, int fq) const {
        const int pn = u.pn; bf16_t* base; int ldc, colt, act;
        if (pn < 5) { base = XR; ldc = 1280; colt = pn * 256; act = 0; }
        else if (pn < 10) { base = GR; ldc = 1280; colt = (pn - 5) * 256; act = 1; }
        else if (pn < 14) { base = U; ldc = 1024; colt = (pn - 10) * 256; act = 1; }
        else { base = V; ldc = 1024; colt = (pn - 14) * 256; act = 2; }
        const int row0 = u.pm * BM + wr * 64 + fr, col0 = colt + wc * 32 + 8 * fq;
        float rs8[8];
#pragma unroll
        for (int i = 0; i < 8; ++i) rs8[i] = ssq[row0 + (i >> 2) * HALF + (i & 3) * 16];
        asm volatile("" ::: "memory");
#pragma unroll
        for (int ai = 0; ai < 2; ++ai)
#pragma unroll
            for (int m = 0; m < 4; ++m) {
                const int row = row0 + ai * HALF + m * 16; const float rs = rstd_of(rs8[ai * 4 + m]);
                bf16_t* rowp = base + (size_t)row * ldc + col0; float s1 = 0.f, s2 = 0.f;
#pragma unroll
                for (int bj = 0; bj < 2; ++bj) { f32x4 v0 = acc[ai][bj][m][0] * rs, v1 = acc[ai][bj][m][1] * rs;
                    if (act) {
#pragma unroll
                        for (int j = 0; j < 4; ++j) { v0[j] = gelu_t(v0[j]); v1[j] = gelu_t(v1[j]); } }
                    if (act == 2) {
#pragma unroll
                        for (int j = 0; j < 4; ++j) { s1 += v0[j] + v1[j]; s2 += v0[j] * v0[j] + v1[j] * v1[j]; } }
                    u32x4 w; w.x = cvt_pk_bf16(v0[0], v0[1]); w.y = cvt_pk_bf16(v0[2], v0[3]); w.z = cvt_pk_bf16(v1[0], v1[1]); w.w = cvt_pk_bf16(v1[2], v1[3]);
                    *(u32x4*)(rowp + bj * HALF) = w;
                    if (pn < 5 && m == 3 && fr >= 13) *(u32x4*)(HALO + ((size_t)(row >> 6) * 3 + (fr - 13)) * 1280 + col0 + bj * HALF) = w; }
                if (act == 2) { s1 += __shfl_xor(s1, 16); s1 += __shfl_xor(s1, 32); s2 += __shfl_xor(s2, 16); s2 += __shfl_xor(s2, 32);
                    if (fq == 0) { fadd_fix(vsum + row, s1, FIX_V); fadd_fix(vsq + row, s2, FIX_V); } }
            }
    }
};
template <int ACT> struct EpiAct {
    static constexpr bool PERM = true, AFTER_DRAIN = false;
    bf16_t* O; int ldc; const float* ssq;
    __device__ __forceinline__ void operator()(const f32x4 (&acc)[2][2][4][2], const Unit& u, int wr, int wc, int fr, int fq) const {
        const int row0 = u.pm * BM + wr * 64 + fr, col0 = u.pn * BM + wc * 32 + 8 * fq;
        float rs8[8];
#pragma unroll
        for (int i = 0; i < 8; ++i) rs8[i] = ssq[row0 + (i >> 2) * HALF + (i & 3) * 16];
        asm volatile("" ::: "memory");
#pragma unroll
        for (int ai = 0; ai < 2; ++ai)
#pragma unroll
            for (int m = 0; m < 4; ++m) {
                const int row = row0 + ai * HALF + m * 16; const float rs = rstd_of(rs8[ai * 4 + m]);
                bf16_t* rowp = O + (size_t)row * ldc + col0;
#pragma unroll
                for (int bj = 0; bj < 2; ++bj) { f32x4 v0 = acc[ai][bj][m][0] * rs, v1 = acc[ai][bj][m][1] * rs;
#pragma unroll
                    for (int j = 0; j < 4; ++j) {
                        if (ACT == 0) { v0[j] = sigm(v0[j]); v1[j] = sigm(v1[j]); }
                        else { const float a = fmaxf(v0[j], 0.f), b = fmaxf(v1[j], 0.f); v0[j] = a * a; v1[j] = b * b; } }
                    u32x4 w; w.x = cvt_pk_bf16(v0[0], v0[1]); w.y = cvt_pk_bf16(v0[2], v0[3]); w.z = cvt_pk_bf16(v1[0], v1[1]); w.w = cvt_pk_bf16(v1[2], v1[3]);
                    *(u32x4*)(rowp + bj * HALF) = w; }
            }
    }
};
struct EpiGate8 {
    static constexpr bool PERM = true, AFTER_DRAIN = false;
    unsigned char* G8; const float* ssq;
    __device__ __forceinline__ void operator()(const f32x4 (&acc)[2][2][4][2], const Unit& u, int wr, int wc, int fr, int fq) const {
        const int row0 = u.pm * BM + wr * 64 + fr, col0 = u.pn * BM + wc * 32 + 8 * fq;
#pragma unroll
        for (int ai = 0; ai < 2; ++ai)
#pragma unroll
            for (int m = 0; m < 4; ++m) {
                const int row = row0 + ai * HALF + m * 16; const float rs = rstd_of(ssq[row]);
                unsigned char* rowp = G8 + (size_t)row * 1024 + col0;
#pragma unroll
                for (int bj = 0; bj < 2; ++bj) { const f32x4 v0 = acc[ai][bj][m][0] * rs, v1 = acc[ai][bj][m][1] * rs; unsigned q[8];
#pragma unroll
                    for (int j = 0; j < 4; ++j) { q[j] = (unsigned)__builtin_rintf(255.0f * sigm(v0[j])); q[4 + j] = (unsigned)__builtin_rintf(255.0f * sigm(v1[j])); }
                    u32x2 w; w.x = q[0] | (q[1] << 8) | (q[2] << 16) | (q[3] << 24); w.y = q[4] | (q[5] << 8) | (q[6] << 16) | (q[7] << 24);
                    *(u32x2*)(rowp + bj * HALF) = w; }
            }
    }
};
template <bool ADD> struct EpiMix {
    static constexpr bool PERM = true, AFTER_DRAIN = false;
    bf16_t* O; const unsigned char* G8;
    __device__ __forceinline__ void operator()(const f32x4 (&acc)[2][2][4][2], const Unit& u, int wr, int wc, int fr, int fq) const {
        const int row0 = u.pm * BM + wr * 64 + fr, col0 = u.pn * BM + wc * 32 + 8 * fq;
#pragma unroll
        for (int ai = 0; ai < 2; ++ai)
#pragma unroll
            for (int m = 0; m < 4; ++m) {
                const size_t off = (size_t)(row0 + ai * HALF + m * 16) * 1024 + col0;
#pragma unroll
                for (int bj = 0; bj < 2; ++bj) { const u32x2 gq = *(const u32x2*)(G8 + off + bj * HALF); const f32x4 a0 = acc[ai][bj][m][0], a1 = acc[ai][bj][m][1];
                    const float k = 1.0f / 255.0f; f32x4 v0, v1;
                    v0[0] = (float)(gq.x & 255u) * k * a0[0]; v0[1] = (float)((gq.x >> 8) & 255u) * k * a0[1]; v0[2] = (float)((gq.x >> 16) & 255u) * k * a0[2]; v0[3] = (float)(gq.x >> 24) * k * a0[3];
                    v1[0] = (float)(gq.y & 255u) * k * a1[0]; v1[1] = (float)((gq.y >> 8) & 255u) * k * a1[1]; v1[2] = (float)((gq.y >> 16) & 255u) * k * a1[2]; v1[3] = (float)(gq.y >> 24) * k * a1[3];
                    if (ADD) { const u32x4 tw = *(const u32x4*)(O + off + bj * HALF);
                        v0[0] += bf_lo(tw.x); v0[1] += bf_hi(tw.x); v0[2] += bf_lo(tw.y); v0[3] += bf_hi(tw.y); v1[0] += bf_lo(tw.z); v1[1] += bf_hi(tw.z); v1[2] += bf_lo(tw.w); v1[3] += bf_hi(tw.w); }
                    u32x4 w; w.x = cvt_pk_bf16(v0[0], v0[1]); w.y = cvt_pk_bf16(v0[2], v0[3]); w.z = cvt_pk_bf16(v1[0], v1[1]); w.w = cvt_pk_bf16(v1[2], v1[3]);
                    *(u32x4*)(O + off + bj * HALF) = w; }
                asm volatile("" ::: "memory");
            }
    }
};
struct EpiRes {
    static constexpr bool PERM = true, AFTER_DRAIN = false;
    bf16_t* xb; float* ssq_out;
    __device__ __forceinline__ void operator()(const f32x4 (&acc)[2][2][4][2], const Unit& u, int wr, int wc, int fr, int fq) const {
        const int row0 = u.pm * BM + wr * 64 + fr, col0 = u.pn * BM + wc * 32 + 8 * fq;
#pragma unroll
        for (int ai = 0; ai < 2; ++ai)
#pragma unroll
            for (int m = 0; m < 4; ++m) {
                const int row = row0 + ai * HALF + m * 16; const size_t off = (size_t)row * 1024 + col0; float s = 0.f;
#pragma unroll
                for (int bj = 0; bj < 2; ++bj) { const u32x4 xw = *(const u32x4*)(xb + off + bj * HALF); const f32x4 a0 = acc[ai][bj][m][0], a1 = acc[ai][bj][m][1];
                    f32x4 v0, v1; v0[0] = bf_lo(xw.x) + a0[0]; v0[1] = bf_hi(xw.x) + a0[1]; v0[2] = bf_lo(xw.y) + a0[2]; v0[3] = bf_hi(xw.y) + a0[3];
                    v1[0] = bf_lo(xw.z) + a1[0]; v1[1] = bf_hi(xw.z) + a1[1]; v1[2] = bf_lo(xw.w) + a1[2]; v1[3] = bf_hi(xw.w) + a1[3];
                    u32x4 w; w.x = cvt_pk_bf16(v0[0], v0[1]); w.y = cvt_pk_bf16(v0[2], v0[3]); w.z = cvt_pk_bf16(v1[0], v1[1]); w.w = cvt_pk_bf16(v1[2], v1[3]);
                    *(u32x4*)(xb + off + bj * HALF) = w;
                    s += (v0[0] * v0[0] + v0[1] * v0[1]) + (v0[2] * v0[2] + v0[3] * v0[3]) + (v1[0] * v1[0] + v1[1] * v1[1]) + (v1[2] * v1[2] + v1[3] * v1[3]); }
                s += __shfl_xor(s, 16); s += __shfl_xor(s, 32);
                if (fq == 0) fadd_fix(ssq_out + row, s, FIX_SSQ);
                asm volatile("" ::: "memory");
            }
    }
};
template <class Epi, class Sched, bool ALIGN_EPI = false, bool SP2 = false>
__device__ __forceinline__ void gemm_phase(PG8_LAS unsigned char* lds, const Gemm g, const Sched& S, const Epi& E, const int tid) {
    const int wid = __builtin_amdgcn_readfirstlane(tid >> 6), lane = tid & 63, wr = wid >> 2, wc = wid & 3, fr = lane & 15, fq = lane >> 4;
    const int K = g.K, nt = K / BK;
    unsigned voffA[2], voffB[2];
#pragma unroll
    for (int i = 0; i < 2; ++i) { int R, C; stage_rc(tid * 16 + i * 8192, R, C); const int Rb = Epi::PERM ? ((R & ~31) + perm32(R & 31)) : R;
        voffA[i] = (unsigned)(R * K + C) * 2u; voffB[i] = (unsigned)(Rb * K + C) * 2u; }
    const size_t kstep = (size_t)(BK * 2);
    const size_t hstep = (size_t)HALF * K * 2;
    const size_t tstep = 2 * hstep;
    const unsigned ldsw = (unsigned)wid * 1024u;
    const int aoff = lds_byte(wr * 64 + fr, fq * 8), boff = lds_byte(wc * 32 + fr, fq * 8);
#define PG8_SA(b, h) (((b) * 2 + (h)) * HTB)
#define PG8_SB(b, h) ((4 + (b) * 2 + (h)) * HTB)
#define PG8_STAGE(bufoff, gbase, voff) do { _Pragma("unroll") for (int _i = 0; _i < 2; ++_i) \
        __builtin_amdgcn_global_load_lds((const unsigned*)((const char*)(gbase) + (voff)[_i]), (PG8_LAS unsigned*)(lds + (bufoff) + ldsw + _i * 8192), 16, 0, 0); } while (0)
#define PG8_LDA(dst, b, h) do { _Pragma("unroll") for (int m = 0; m < 4; ++m) _Pragma("unroll") for (int k = 0; k < 2; ++k) dst[m][k] = *(const PG8_LAS bf16x8*)(lds + PG8_SA(b, h) + aoff + m * 2048 + k * 1024); } while (0)
#define PG8_LDB(dst, b, h) do { _Pragma("unroll") for (int n = 0; n < 2; ++n) _Pragma("unroll") for (int k = 0; k < 2; ++k) dst[n][k] = *(const PG8_LAS bf16x8*)(lds + PG8_SB(b, h) + boff + n * 2048 + k * 1024); } while (0)
#define PG8_MMA(ai, bj, At, Bt) do { __builtin_amdgcn_s_setprio(1); _Pragma("unroll") for (int m = 0; m < 4; ++m) _Pragma("unroll") for (int n = 0; n < 2; ++n) _Pragma("unroll") for (int k = 0; k < 2; ++k) \
        acc[ai][bj][m][n] = __builtin_amdgcn_mfma_f32_16x16x32_bf16(Bt[n][k], At[m][k], acc[ai][bj][m][n], 0, 0, 0); __builtin_amdgcn_s_setprio(0); } while (0)
#define PG8_WAIT_V(n) asm volatile("s_waitcnt vmcnt(" #n ")" ::: "memory")
#define PG8_WAIT_L(n) asm volatile("s_waitcnt lgkmcnt(" #n ")" ::: "memory")
#define PG8_BAR __builtin_amdgcn_s_barrier()
#define PG8_SCHED __builtin_amdgcn_sched_barrier(0)
    Unit cur, nxt; int ui = 0;
    if (!S.next(0, cur)) return;
    f32x4 acc[2][2][4][2];
#pragma unroll
    for (int a = 0; a < 2; ++a)
#pragma unroll
        for (int b = 0; b < 2; ++b)
#pragma unroll
            for (int m = 0; m < 4; ++m)
#pragma unroll
                for (int n = 0; n < 2; ++n) acc[a][b][m][n] = (f32x4){0.f, 0.f, 0.f, 0.f};
    bf16x8 At[4][2], B0[2][2], B1[2][2];
    const char* cA = (const char*)g.A + (size_t)cur.pm * tstep; const char* cB = (const char*)g.Bt + (size_t)cur.pn * tstep;
    S.a_ready(cur);
    if constexpr (SP2) {
        PG8_STAGE(PG8_SB(0, 0), cB, voffB); PG8_STAGE(PG8_SB(0, 1), cB + hstep, voffB); PG8_STAGE(PG8_SA(0, 0), cA, voffA); PG8_STAGE(PG8_SA(0, 1), cA + hstep, voffA);
        if (wr == 1) PG8_BAR;
        PG8_WAIT_V(2); PG8_BAR;
        PG8_STAGE(PG8_SB(1, 0), cB + kstep, voffB); PG8_STAGE(PG8_SA(1, 0), cA + kstep, voffA); PG8_STAGE(PG8_SB(1, 1), cB + hstep + kstep, voffB);
        PG8_WAIT_V(6); PG8_BAR;
    } else {
        PG8_STAGE(PG8_SB(0, 0), cB, voffB); PG8_STAGE(PG8_SA(0, 0), cA, voffA); PG8_STAGE(PG8_SB(0, 1), cB + hstep, voffB); PG8_STAGE(PG8_SA(0, 1), cA + hstep, voffA);
        if (wr == 1) PG8_BAR;
        PG8_WAIT_V(4); PG8_BAR;
        PG8_STAGE(PG8_SB(1, 0), cB + kstep, voffB); PG8_STAGE(PG8_SA(1, 0), cA + kstep, voffA); PG8_STAGE(PG8_SB(1, 1), cB + hstep + kstep, voffB);
        PG8_WAIT_V(6); PG8_BAR;
    }
    for (;;) {
        const bool has_next = S.next(ui + 1, nxt);
        const char* nA = has_next ? (const char*)g.A + (size_t)nxt.pm * tstep : cA; const char* nB = has_next ? (const char*)g.Bt + (size_t)nxt.pn * tstep : cB;
        for (int t = 0; t < nt; t += 2) {
            const bool last = (t == nt - 2);
            const char* a1 = cA + (size_t)(t + 1) * kstep;
            const char* a2 = last ? nA : cA + (size_t)(t + 2) * kstep; const char* b2 = last ? nB : cB + (size_t)(t + 2) * kstep;
            const char* a3 = a2 + kstep; const char* b3 = b2 + kstep;
            if (last && has_next) S.a_ready(nxt);
            if constexpr (SP2) {
            PG8_LDB(B0, 0, 0); PG8_LDB(B1, 0, 1); PG8_SCHED; PG8_LDA(At, 0, 0); PG8_STAGE(PG8_SA(1, 1), a1 + hstep, voffA);
            PG8_WAIT_V(8); PG8_WAIT_L(0); PG8_BAR; PG8_MMA(0, 0, At, B0); PG8_MMA(0, 1, At, B1); PG8_BAR; PG8_SCHED;
            PG8_LDA(At, 0, 1); PG8_STAGE(PG8_SB(0, 0), b2, voffB); PG8_STAGE(PG8_SB(0, 1), b2 + hstep, voffB); PG8_STAGE(PG8_SA(0, 0), a2, voffA);
            PG8_WAIT_V(8); PG8_WAIT_L(0); PG8_BAR; PG8_MMA(1, 0, At, B0); PG8_MMA(1, 1, At, B1); PG8_BAR; PG8_SCHED;
            PG8_LDB(B0, 1, 0); PG8_LDB(B1, 1, 1); PG8_SCHED; PG8_LDA(At, 1, 0); PG8_STAGE(PG8_SA(0, 1), a2 + hstep, voffA);
            PG8_WAIT_V(8); PG8_WAIT_L(0); PG8_BAR; PG8_MMA(0, 0, At, B0); PG8_MMA(0, 1, At, B1); PG8_BAR; PG8_SCHED;
            PG8_LDA(At, 1, 1); PG8_STAGE(PG8_SB(1, 0), b3, voffB); PG8_STAGE(PG8_SB(1, 1), b3 + hstep, voffB); PG8_STAGE(PG8_SA(1, 0), a3, voffA);
            PG8_WAIT_V(8); PG8_WAIT_L(0); PG8_BAR; PG8_MMA(1, 0, At, B0); PG8_MMA(1, 1, At, B1); PG8_BAR; PG8_SCHED;
            } else {
            PG8_LDB(B0, 0, 0); PG8_SCHED; PG8_LDA(At, 0, 0); PG8_STAGE(PG8_SA(1, 1), a1 + hstep, voffA);
            PG8_WAIT_L(8); PG8_BAR; PG8_WAIT_L(0); PG8_MMA(0, 0, At, B0); PG8_BAR; PG8_SCHED;
            PG8_LDB(B1, 0, 1); PG8_STAGE(PG8_SB(0, 0), b2, voffB);
            PG8_BAR; PG8_WAIT_L(0); PG8_MMA(0, 1, At, B1); PG8_BAR;
            PG8_LDA(At, 0, 1); PG8_STAGE(PG8_SA(0, 0), a2, voffA);
            PG8_BAR; PG8_WAIT_L(0); PG8_MMA(1, 0, At, B0); PG8_BAR; PG8_SCHED;
            PG8_STAGE(PG8_SB(0, 1), b2 + hstep, voffB);
            PG8_WAIT_V(6); PG8_BAR; PG8_MMA(1, 1, At, B1); PG8_BAR;
            PG8_LDB(B0, 1, 0); PG8_SCHED; PG8_LDA(At, 1, 0); PG8_STAGE(PG8_SA(0, 1), a2 + hstep, voffA);
            PG8_WAIT_L(8); PG8_BAR; PG8_WAIT_L(0); PG8_MMA(0, 0, At, B0); PG8_BAR; PG8_SCHED;
            PG8_LDB(B1, 1, 1); PG8_STAGE(PG8_SB(1, 0), b3, voffB);
            PG8_BAR; PG8_WAIT_L(0); PG8_MMA(0, 1, At, B1); PG8_BAR;
            PG8_LDA(At, 1, 1); PG8_STAGE(PG8_SA(1, 0), a3, voffA);
            PG8_BAR; PG8_WAIT_L(0); PG8_MMA(1, 0, At, B0); PG8_BAR; PG8_SCHED;
            PG8_STAGE(PG8_SB(1, 1), b3 + hstep, voffB);
            PG8_WAIT_V(6); PG8_BAR; PG8_MMA(1, 1, At, B1); PG8_BAR;
            }
        }
        if constexpr (ALIGN_EPI) { if (wr == 0) PG8_BAR; }
        if constexpr (!Epi::AFTER_DRAIN) { E(acc, cur, wr, wc, fr, fq); S.done(cur); }
        if (!has_next) break;
#pragma unroll
        for (int a = 0; a < 2; ++a)
#pragma unroll
            for (int b = 0; b < 2; ++b)
#pragma unroll
                for (int m = 0; m < 4; ++m)
#pragma unroll
                    for (int n = 0; n < 2; ++n) acc[a][b][m][n] = (f32x4){0.f, 0.f, 0.f, 0.f};
        cur = nxt; cA = nA; cB = nB; ++ui;
        if constexpr (ALIGN_EPI) { if (wr == 1) PG8_BAR; }
    }
    PG8_WAIT_V(0);
    if constexpr (!ALIGN_EPI) { if (wr == 0) PG8_BAR; }
    PG8_BAR;
    if constexpr (Epi::AFTER_DRAIN) { E.fused(acc, cur, wr, wc, fr, fq, lds, wid, lane); S.done(cur); }
#undef PG8_SA
#undef PG8_SB
#undef PG8_STAGE
#undef PG8_LDA
#undef PG8_LDB
#undef PG8_MMA
#undef PG8_WAIT_V
#undef PG8_WAIT_L
#undef PG8_BAR
#undef PG8_SCHED
}

struct UnitX { int pm, pn; const bf16_t* A; const bf16_t* Bt; int K; int kind; };
template <class Epi, class Sched, bool ALIGN_EPI = false, bool SP2 = false>
__device__ __forceinline__ void gemm_phase_multi(PG8_LAS unsigned char* lds, const Sched& S, const Epi& E, const int tid) {
    const int wid = __builtin_amdgcn_readfirstlane(tid >> 6), lane = tid & 63, wr = wid >> 2, wc = wid & 3, fr = lane & 15, fq = lane >> 4;
    int sR[2], sRb[2], sC[2];
#pragma unroll
    for (int i = 0; i < 2; ++i) { int R, C; stage_rc(tid * 16 + i * 8192, R, C); sR[i] = R; sRb[i] = Epi::PERM ? ((R & ~31) + perm32(R & 31)) : R; sC[i] = C; }
    unsigned voffA[2], voffB[2], voffAn[2], voffBn[2];
#define PG8_VOFF(dA, dB, KK) do { _Pragma("unroll") for (int _i = 0; _i < 2; ++_i) { dA[_i] = (unsigned)(sR[_i] * (KK) + sC[_i]) * 2u; dB[_i] = (unsigned)(sRb[_i] * (KK) + sC[_i]) * 2u; } } while (0)
    const size_t kstep = (size_t)(BK * 2);
    const unsigned ldsw = (unsigned)wid * 1024u;
    const int aoff = lds_byte(wr * 64 + fr, fq * 8), boff = lds_byte(wc * 32 + fr, fq * 8);
#define PG8_SA(b, h) (((b) * 2 + (h)) * HTB)
#define PG8_SB(b, h) ((4 + (b) * 2 + (h)) * HTB)
#define PG8_STAGE(bufoff, gbase, voff) do { _Pragma("unroll") for (int _i = 0; _i < 2; ++_i) \
        __builtin_amdgcn_global_load_lds((const unsigned*)((const char*)(gbase) + (voff)[_i]), (PG8_LAS unsigned*)(lds + (bufoff) + ldsw + _i * 8192), 16, 0, 0); } while (0)
#define PG8_LDA(dst, b, h) do { _Pragma("unroll") for (int m = 0; m < 4; ++m) _Pragma("unroll") for (int k = 0; k < 2; ++k) dst[m][k] = *(const PG8_LAS bf16x8*)(lds + PG8_SA(b, h) + aoff + m * 2048 + k * 1024); } while (0)
#define PG8_LDB(dst, b, h) do { _Pragma("unroll") for (int n = 0; n < 2; ++n) _Pragma("unroll") for (int k = 0; k < 2; ++k) dst[n][k] = *(const PG8_LAS bf16x8*)(lds + PG8_SB(b, h) + boff + n * 2048 + k * 1024); } while (0)
#define PG8_MMA(ai, bj, At, Bt) do { __builtin_amdgcn_s_setprio(1); _Pragma("unroll") for (int m = 0; m < 4; ++m) _Pragma("unroll") for (int n = 0; n < 2; ++n) _Pragma("unroll") for (int k = 0; k < 2; ++k) \
        acc[ai][bj][m][n] = __builtin_amdgcn_mfma_f32_16x16x32_bf16(Bt[n][k], At[m][k], acc[ai][bj][m][n], 0, 0, 0); __builtin_amdgcn_s_setprio(0); } while (0)
#define PG8_WAIT_V(n) asm volatile("s_waitcnt vmcnt(" #n ")" ::: "memory")
#define PG8_WAIT_L(n) asm volatile("s_waitcnt lgkmcnt(" #n ")" ::: "memory")
#define PG8_BAR __builtin_amdgcn_s_barrier()
#define PG8_SCHED __builtin_amdgcn_sched_barrier(0)
    UnitX cur, nxt; int ui = 0;
    if (!S.next(0, cur)) return;
    int K = cur.K, nt = K / BK; size_t hstep = (size_t)HALF * K * 2, hstepn = hstep; PG8_VOFF(voffA, voffB, K); PG8_VOFF(voffAn, voffBn, K);
    f32x4 acc[2][2][4][2];
#pragma unroll
    for (int a = 0; a < 2; ++a)
#pragma unroll
        for (int b = 0; b < 2; ++b)
#pragma unroll
            for (int m = 0; m < 4; ++m)
#pragma unroll
                for (int n = 0; n < 2; ++n) acc[a][b][m][n] = (f32x4){0.f, 0.f, 0.f, 0.f};
    bf16x8 At[4][2], B0[2][2], B1[2][2];
    const char* cA = (const char*)cur.A + (size_t)cur.pm * 2 * hstep; const char* cB = (const char*)cur.Bt + (size_t)cur.pn * 2 * hstep;
    S.a_ready(cur);
    if constexpr (SP2) {
        PG8_STAGE(PG8_SB(0, 0), cB, voffB); PG8_STAGE(PG8_SB(0, 1), cB + hstep, voffB); PG8_STAGE(PG8_SA(0, 0), cA, voffA); PG8_STAGE(PG8_SA(0, 1), cA + hstep, voffA);
        if (wr == 1) PG8_BAR;
        PG8_WAIT_V(2); PG8_BAR;
        PG8_STAGE(PG8_SB(1, 0), cB + kstep, voffB); PG8_STAGE(PG8_SA(1, 0), cA + kstep, voffA); PG8_STAGE(PG8_SB(1, 1), cB + hstep + kstep, voffB);
        PG8_WAIT_V(6); PG8_BAR;
    } else {
        PG8_STAGE(PG8_SB(0, 0), cB, voffB); PG8_STAGE(PG8_SA(0, 0), cA, voffA); PG8_STAGE(PG8_SB(0, 1), cB + hstep, voffB); PG8_STAGE(PG8_SA(0, 1), cA + hstep, voffA);
        if (wr == 1) PG8_BAR;
        PG8_WAIT_V(4); PG8_BAR;
        PG8_STAGE(PG8_SB(1, 0), cB + kstep, voffB); PG8_STAGE(PG8_SA(1, 0), cA + kstep, voffA); PG8_STAGE(PG8_SB(1, 1), cB + hstep + kstep, voffB);
        PG8_WAIT_V(6); PG8_BAR;
    }
    for (;;) {
        const bool has_next = S.next(ui + 1, nxt);
        if (has_next) { hstepn = (size_t)HALF * nxt.K * 2; PG8_VOFF(voffAn, voffBn, nxt.K); } else { hstepn = hstep; PG8_VOFF(voffAn, voffBn, K); }
        const char* nA = has_next ? (const char*)nxt.A + (size_t)nxt.pm * 2 * hstepn : cA; const char* nB = has_next ? (const char*)nxt.Bt + (size_t)nxt.pn * 2 * hstepn : cB;
        for (int t = 0; t < nt; t += 2) {
            const bool last = (t == nt - 2);
            const char* a1 = cA + (size_t)(t + 1) * kstep;
            const char* a2 = last ? nA : cA + (size_t)(t + 2) * kstep; const char* b2 = last ? nB : cB + (size_t)(t + 2) * kstep;
            const char* a3 = a2 + kstep; const char* b3 = b2 + kstep;
            unsigned vA2[2], vB2[2]; vA2[0] = last ? voffAn[0] : voffA[0]; vA2[1] = last ? voffAn[1] : voffA[1]; vB2[0] = last ? voffBn[0] : voffB[0]; vB2[1] = last ? voffBn[1] : voffB[1];
            const size_t hs2 = last ? hstepn : hstep;
            if (last && has_next) S.a_ready(nxt);
            if constexpr (SP2) {
            PG8_LDB(B0, 0, 0); PG8_LDB(B1, 0, 1); PG8_SCHED; PG8_LDA(At, 0, 0); PG8_STAGE(PG8_SA(1, 1), a1 + hstep, voffA);
            PG8_WAIT_V(8); PG8_WAIT_L(0); PG8_BAR; PG8_MMA(0, 0, At, B0); PG8_MMA(0, 1, At, B1); PG8_BAR; PG8_SCHED;
            PG8_LDA(At, 0, 1); PG8_STAGE(PG8_SB(0, 0), b2, vB2); PG8_STAGE(PG8_SB(0, 1), b2 + hs2, vB2); PG8_STAGE(PG8_SA(0, 0), a2, vA2);
            PG8_WAIT_V(8); PG8_WAIT_L(0); PG8_BAR; PG8_MMA(1, 0, At, B0); PG8_MMA(1, 1, At, B1); PG8_BAR; PG8_SCHED;
            PG8_LDB(B0, 1, 0); PG8_LDB(B1, 1, 1); PG8_SCHED; PG8_LDA(At, 1, 0); PG8_STAGE(PG8_SA(0, 1), a2 + hs2, vA2);
            PG8_WAIT_V(8); PG8_WAIT_L(0); PG8_BAR; PG8_MMA(0, 0, At, B0); PG8_MMA(0, 1, At, B1); PG8_BAR; PG8_SCHED;
            PG8_LDA(At, 1, 1); PG8_STAGE(PG8_SB(1, 0), b3, vB2); PG8_STAGE(PG8_SB(1, 1), b3 + hs2, vB2); PG8_STAGE(PG8_SA(1, 0), a3, vA2);
            PG8_WAIT_V(8); PG8_WAIT_L(0); PG8_BAR; PG8_MMA(1, 0, At, B0); PG8_MMA(1, 1, At, B1); PG8_BAR; PG8_SCHED;
            } else {
            PG8_LDB(B0, 0, 0); PG8_SCHED; PG8_LDA(At, 0, 0); PG8_STAGE(PG8_SA(1, 1), a1 + hstep, voffA);
            PG8_WAIT_L(8); PG8_BAR; PG8_WAIT_L(0); PG8_MMA(0, 0, At, B0); PG8_BAR; PG8_SCHED;
            PG8_LDB(B1, 0, 1); PG8_STAGE(PG8_SB(0, 0), b2, voffB);
            PG8_BAR; PG8_WAIT_L(0); PG8_MMA(0, 1, At, B1); PG8_BAR;
            PG8_LDA(At, 0, 1); PG8_STAGE(PG8_SA(0, 0), a2, voffA);
            PG8_BAR; PG8_WAIT_L(0); PG8_MMA(1, 0, At, B0); PG8_BAR; PG8_SCHED;
            PG8_STAGE(PG8_SB(0, 1), b2 + hstep, voffB);
            PG8_WAIT_V(6); PG8_BAR; PG8_MMA(1, 1, At, B1); PG8_BAR;
            PG8_LDB(B0, 1, 0); PG8_SCHED; PG8_LDA(At, 1, 0); PG8_STAGE(PG8_SA(0, 1), a2 + hstep, voffA);
            PG8_WAIT_L(8); PG8_BAR; PG8_WAIT_L(0); PG8_MMA(0, 0, At, B0); PG8_BAR; PG8_SCHED;
            PG8_LDB(B1, 1, 1); PG8_STAGE(PG8_SB(1, 0), b3, voffB);
            PG8_BAR; PG8_WAIT_L(0); PG8_MMA(0, 1, At, B1); PG8_BAR;
            PG8_LDA(At, 1, 1); PG8_STAGE(PG8_SA(1, 0), a3, voffA);
            PG8_BAR; PG8_WAIT_L(0); PG8_MMA(1, 0, At, B0); PG8_BAR; PG8_SCHED;
            PG8_STAGE(PG8_SB(1, 1), b3 + hstep, voffB);
            PG8_WAIT_V(6); PG8_BAR; PG8_MMA(1, 1, At, B1); PG8_BAR;
            }
        }
        if constexpr (ALIGN_EPI) { if (wr == 0) PG8_BAR; }
        if constexpr (!Epi::AFTER_DRAIN) { E(acc, cur, wr, wc, fr, fq); S.done(cur); }
        if (!has_next) break;
#pragma unroll
        for (int a = 0; a < 2; ++a)
#pragma unroll
            for (int b = 0; b < 2; ++b)
#pragma unroll
                for (int m = 0; m < 4; ++m)
#pragma unroll
                    for (int n = 0; n < 2; ++n) acc[a][b][m][n] = (f32x4){0.f, 0.f, 0.f, 0.f};
        cur = nxt; cA = nA; cB = nB; ++ui; K = cur.K; nt = K / BK; hstep = hstepn; voffA[0] = voffAn[0]; voffA[1] = voffAn[1]; voffB[0] = voffBn[0]; voffB[1] = voffBn[1];
        if constexpr (ALIGN_EPI) { if (wr == 1) PG8_BAR; }
    }
    PG8_WAIT_V(0);
    if constexpr (!ALIGN_EPI) { if (wr == 0) PG8_BAR; }
    PG8_BAR;
    if constexpr (Epi::AFTER_DRAIN) { E.fused(acc, cur, wr, wc, fr, fq, lds, wid, lane); S.done(cur); }
#undef PG8_SA
#undef PG8_SB
#undef PG8_STAGE
#undef PG8_LDA
#undef PG8_LDB
#undef PG8_MMA
#undef PG8_WAIT_V
#undef PG8_WAIT_L
#undef PG8_BAR
#undef PG8_SCHED
#undef PG8_VOFF
}


}
constexpr int BATCH = 4, SEQ = 4096, D = 1024, DRNN = 1280, NH = 20, FF = 4096, DEPTH = 2;
constexpr int M = BATCH * SEQ;
constexpr int DIN = 6656, NP1 = 4608;
constexpr int NSEG = 64;
constexpr int NWAVES = 8;
constexpr size_t KiB = 1024, MiB = 1u << 20;
constexpr size_t WS_SSQ = 0;
constexpr size_t WS_VST = 320 * KiB;
constexpr size_t WS_TS = 704 * KiB;
constexpr size_t WS_BAR = 640 * KiB;
constexpr size_t WS_ATOT = 1 * MiB, WS_HEND = 1 * MiB + 1280 * KiB;
constexpr size_t WS_W = 4 * MiB, W_LAYER = 37 * MiB;
constexpr size_t W_IN = 0, W_G = 9 * MiB, W_A = 13 * MiB, W_B = 15 * MiB + 512 * KiB, W_O = 17 * MiB + 512 * KiB, W_UP = 19 * MiB + 512 * KiB, W_DN = 27 * MiB + 512 * KiB,
                 W_L = 35 * MiB + 512 * KiB, W_S = 36 * MiB;
constexpr size_t WS_HALO = 254 * MiB;
constexpr size_t WS_XB = 78 * MiB;
constexpr size_t WS_XR = 110 * MiB, WS_GR = 150 * MiB, WS_U = 190 * MiB, WS_V = 222 * MiB, WS_END = 256 * MiB;
constexpr size_t WS_F = 110 * MiB;
constexpr size_t WS_S1 = WS_V, WS_S2 = WS_XR;
static_assert(WS_HEND + 1280 * KiB <= WS_W && WS_W + 2 * W_LAYER <= WS_XB && WS_XB + (size_t)M * D * 2 <= WS_XR && WS_F + (size_t)M * FF * 2 <= WS_HALO && WS_V + (size_t)M * D * 2 <= WS_HALO && WS_HALO + (size_t)(M / 64) * 3 * DRNN * 2 <= WS_END, "d_ws map");
static_assert(W_S + 8 * 128 * 128 * 2 <= W_LAYER && W_L + 2 * 20 * 64 * 64 * 2 <= W_S, "weight map");
constexpr int LDS_BYTES = 147456;
constexpr int NPHASE = 16;

#define LAS __attribute__((address_space(3)))
typedef unsigned short bf16;
typedef float f32x4 __attribute__((ext_vector_type(4)));
typedef short bf16x8 __attribute__((ext_vector_type(8)));
typedef unsigned u32x4 __attribute__((ext_vector_type(4)));
typedef unsigned u32x2 __attribute__((ext_vector_type(2)));
#define LDS_WAIT() asm volatile("s_waitcnt lgkmcnt(0)" ::: "memory")
using pg8::cvt_pk_bf16; using pg8::bf_lo; using pg8::bf_hi; using pg8::sigm;

__device__ __forceinline__ float wave_sum(float v) {
#pragma unroll
    for (int o = 1; o < 64; o <<= 1) v += __shfl_xor(v, o);
    return v;
}
struct Args { const float* in[21]; float* out; unsigned char* ws; int ph_lo, ph_hi; };
enum { I_X = 0, I_NMG, I_WIN, I_CW, I_CB, I_LWA, I_LBA, I_LWX, I_LBX, I_LAM, I_LNG, I_LNB, I_WS, I_BS, I_WA, I_WB, I_WO, I_NFG, I_WUP, I_WDN, I_FNG };
typedef const unsigned char __attribute__((address_space(4)))* kptr_t;
#define AIN(kp, i) (*(const float* const __attribute__((address_space(4)))*)((kp) + 8 * (i)))
struct CvtItem { const float* src; const float* ksc; bf16* dst; int ldw, K; };
__device__ __forceinline__ CvtItem cvt_decode(kptr_t kp, unsigned char* wl, int l, int r) {
    constexpr int J0 = 16 * 144, J1 = 16 * 64, J2 = 20 * 32, J3 = 16 * 32, J4 = 16 * 32, J5 = 16 * 128;
    const float* W; const float* ksc = nullptr; bf16* WT; int ldw, K, nblk;
    if (r < J0) { W = AIN(kp, I_WIN) + (size_t)l * D * DIN; ldw = DIN; K = D; nblk = NP1 / 32; WT = (bf16*)(wl + W_IN); ksc = AIN(kp, I_NMG) + l * D; }
    else if ((r -= J0) < J1) { W = AIN(kp, I_WIN) + (size_t)l * D * DIN + NP1; ldw = DIN; K = D; nblk = 2048 / 32; WT = (bf16*)(wl + W_G); ksc = AIN(kp, I_NMG) + l * D; }
    else if ((r -= J1) < J2) { W = AIN(kp, I_WA) + (size_t)l * DRNN * D; ldw = D; K = DRNN; nblk = D / 32; WT = (bf16*)(wl + W_A); }
    else if ((r -= J2) < J3) { W = AIN(kp, I_WB) + (size_t)l * D * D; ldw = D; K = D; nblk = D / 32; WT = (bf16*)(wl + W_B); }
    else if ((r -= J3) < J4) { W = AIN(kp, I_WO) + (size_t)l * D * D; ldw = D; K = D; nblk = D / 32; WT = (bf16*)(wl + W_O); }
    else if ((r -= J4) < J5) { W = AIN(kp, I_WUP) + (size_t)l * D * FF; ldw = FF; K = D; nblk = FF / 32; WT = (bf16*)(wl + W_UP); ksc = AIN(kp, I_NFG) + l * D; }
    else { r -= J5; W = AIN(kp, I_WDN) + (size_t)l * FF * D; ldw = D; K = FF; nblk = D / 32; WT = (bf16*)(wl + W_DN); }
    const int k0 = 64 * (r / nblk), n0 = 32 * (r % nblk);
    CvtItem c; c.src = W + (size_t)k0 * ldw + n0; c.ksc = ksc ? ksc + k0 : nullptr; c.dst = WT + (size_t)n0 * K + k0; c.ldw = ldw; c.K = K; return c;
}
constexpr int CVT_WIN = 16 * 144, CVT_ALL = 16 * 144 + 16 * 64 + 20 * 32 + 16 * 32 + 16 * 32 + 16 * 128 + 64 * 32;
__device__ __forceinline__ void convert_layer(kptr_t kp, unsigned char* ws, int l, int lo, int JL, LAS float* scr, int gw, int NGW, int lane) {
    gw += lo;
    unsigned char* wl = ws + WS_W + (size_t)l * W_LAYER;
    const int lr = lane >> 3, lc = (lane & 7) * 4;
    if (gw >= JL) return;
    CvtItem cur = cvt_decode(kp, wl, l, gw);
    f32x4 v[8];
#pragma unroll
    for (int i = 0; i < 8; ++i) v[i] = *(const f32x4*)(cur.src + (size_t)(lr + 8 * i) * cur.ldw + lc);
    for (int it = gw; it < JL; it += NGW) {
        const bool more = it + NGW < JL; CvtItem nxt = cur; f32x4 vn[8];
        if (more) { nxt = cvt_decode(kp, wl, l, it + NGW);
#pragma unroll
            for (int i = 0; i < 8; ++i) vn[i] = *(const f32x4*)(nxt.src + (size_t)(lr + 8 * i) * nxt.ldw + lc); }
        if (cur.ksc) {
#pragma unroll
            for (int i = 0; i < 8; ++i) v[i] = v[i] * cur.ksc[lr + 8 * i]; }
#pragma unroll
        for (int i = 0; i < 8; ++i) { LAS float* d = scr + (lr + 8 * i) * 33 + lc; d[0] = v[i][0]; d[1] = v[i][1]; d[2] = v[i][2]; d[3] = v[i][3]; }
        LDS_WAIT(); asm volatile("" ::: "memory");
        const int c = lane & 7;
#pragma unroll
        for (int j = 0; j < 4; ++j) { const int n = (lane >> 3) + 8 * j; const LAS float* s = scr + (8 * c) * 33 + n;
            u32x4 o; o.x = cvt_pk_bf16(s[0 * 33], s[1 * 33]); o.y = cvt_pk_bf16(s[2 * 33], s[3 * 33]); o.z = cvt_pk_bf16(s[4 * 33], s[5 * 33]); o.w = cvt_pk_bf16(s[6 * 33], s[7 * 33]);
            *(u32x4*)(cur.dst + (size_t)n * cur.K + 8 * c) = o; }
        LDS_WAIT(); asm volatile("" ::: "memory");
        if (more) { cur = nxt;
#pragma unroll
            for (int i = 0; i < 8; ++i) v[i] = vn[i]; }
    }
}
__device__ __forceinline__ void p0_prologue(kptr_t kp, unsigned char* ws, LAS unsigned char* lds, int gw, int NGW, int wave, int lane) {
    LAS float* scr = (LAS float*)(lds + wave * 16384);
    convert_layer(kp, ws, 0, 0, CVT_WIN, scr, gw, NGW, lane);
    const int gt = gw * 64 + lane, NGT = NGW * 64;
    for (int e = gt; e < DEPTH * 2 * NH * 64 * 64; e += NGT) {
        const int i = e & 63, j = (e >> 6) & 63, h = (e >> 12) % NH, g = ((e >> 12) / NH) & 1, l = (e >> 12) / (2 * NH);
        const float v = AIN(kp, g ? I_LWX : I_LWA)[(((size_t)l * NH + h) * 64 + i) * 64 + j];
        ((bf16*)(ws + WS_W + (size_t)l * W_LAYER + W_L))[(((size_t)g * NH + h) * 64 + j) * 64 + i] = (bf16)(cvt_pk_bf16(v, 0.f) & 0xffffu);
    }
    for (int e = gt; e < DEPTH * 8 * 128 * 128; e += NGT) {
        const int s = e & 127, t = (e >> 7) & 127, l = e >> 17;
        float v = AIN(kp, I_WS)[e]; if ((t >> 6) < (s >> 6)) v = 0.f;
        ((bf16*)(ws + WS_W + (size_t)l * W_LAYER + W_S))[e & 131071] = (bf16)(cvt_pk_bf16(v, 0.f) & 0xffffu);
    }
    { float* z = (float*)(ws + WS_SSQ) + M; for (int e = gt; e < 8 * M; e += NGT) z[e] = 0.f; }
    for (int m = gw; m < M; m += NGW) {
        const f32x4* xr = (const f32x4*)(AIN(kp, I_X) + (size_t)m * D) + lane; u32x2* o = (u32x2*)((bf16*)(ws + WS_XB) + (size_t)m * D) + lane; float s = 0.f;
#pragma unroll
        for (int j = 0; j < 4; ++j) { const f32x4 v = xr[64 * j]; s += (v.x * v.x + v.y * v.y) + (v.z * v.z + v.w * v.w); u32x2 w; w.x = cvt_pk_bf16(v.x, v.y); w.y = cvt_pk_bf16(v.z, v.w); o[64 * j] = w; }
        s = wave_sum(s); if (lane == 0) ((float*)(ws + WS_SSQ))[m] = pg8::tofix(s, pg8::FIX_SSQ);
    }
}

struct SguP { const bf16* V; bf16* U; const bf16* Ws; const float* bs; const float* lng; const float* lnb; const float* vsum; const float* vsq; };
__device__ __forceinline__ unsigned off_b(unsigned row, unsigned ch) { return 256u * row + 16u * (ch ^ (((row & 3) << 2) | ((row >> 2) & 3))); }
__device__ __forceinline__ unsigned tr_addr16(unsigned lane, unsigned c, unsigned ks, unsigned t) { const unsigned g = lane >> 4, q = (lane & 15) >> 2, p = lane & 3; return off_b(32 * ks + 8 * g + 4 * t + q, 2 * c + (p >> 1)) + 8 * (p & 1); }
__device__ __forceinline__ void sgu_dma(const SguP& P, LAS unsigned char* raw, int it, int wave, int lane) {
    const int b = it >> 8, blk = (it >> 3) & 31, g = it & 7, r0 = b * SEQ + blk * 128, c0 = g * 128;
#pragma unroll
    for (int j = 0; j < 4; ++j) { const int row = 16 * wave + 4 * j + (lane >> 4);
        __builtin_amdgcn_global_load_lds((const unsigned*)(P.V + (size_t)(r0 + row) * 1024 + c0 + (lane & 15) * 8), (LAS unsigned*)(raw + (16 * wave + 4 * j) * 256), 16, 0, 0); }
}
__device__ __forceinline__ void sgu_item(const SguP& P, LAS unsigned char* vt, LAS unsigned char* raw, int it_next, int b, int blk, int g, int tid, int wave, int lane) {
    const int r0 = b * SEQ + blk * 128, c0 = g * 128, n = lane & 15, q = lane >> 4;
    const int cc = (tid & 15) * 8;
    const f32x4 g0 = *(const f32x4*)(P.lng + c0 + cc), g1 = *(const f32x4*)(P.lng + c0 + cc + 4), b0 = *(const f32x4*)(P.lnb + c0 + cc), b1 = *(const f32x4*)(P.lnb + c0 + cc + 4);
    float vs1[4], vs2[4];
#pragma unroll
    for (int i = 0; i < 4; ++i) { const int row = r0 + ((tid + 512 * i) >> 4); vs1[i] = P.vsum[row]; vs2[i] = P.vsq[row]; }
    const int nkk = (wave < 4) ? 2 : 4;
    const bf16* Wg = P.Ws + (size_t)g * 128 * 128 + (size_t)(16 * wave + n) * 128 + 8 * q;
    bf16x8 Aw[4];
#pragma unroll
    for (int kk = 0; kk < 4; ++kk) Aw[kk] = (kk < nkk) ? *(const bf16x8*)(Wg + 32 * kk) : (bf16x8){0, 0, 0, 0, 0, 0, 0, 0};
    const int t = 16 * wave + n; const float bias = P.bs[g * 128 + t];
    bf16* ubase = P.U + (size_t)(r0 + t) * 1024 + c0 + 4 * q;
    u32x2 upre[8];
#pragma unroll
    for (int c = 0; c < 8; ++c) upre[c] = *(const u32x2*)(ubase + 16 * c);
    asm volatile("s_waitcnt vmcnt(0)" ::: "memory"); __syncthreads();
#pragma unroll
    for (int i = 0; i < 4; ++i) {
        const int chunk = tid + 512 * i, s = chunk >> 4, ch = chunk & 15;
        const float mu = pg8::unfix(vs1[i], pg8::FIX_V) * (1.0f / 1024.0f), var = fmaxf(pg8::unfix(vs2[i], pg8::FIX_V) * (1.0f / 1024.0f) - mu * mu, 0.f), rstd = __builtin_amdgcn_rsqf(var + 1e-6f);
        const u32x4 v = *(const LAS u32x4*)(raw + chunk * 16);
        float y[8];
        y[0] = (bf_lo(v.x) - mu) * rstd * g0[0] + b0[0]; y[1] = (bf_hi(v.x) - mu) * rstd * g0[1] + b0[1]; y[2] = (bf_lo(v.y) - mu) * rstd * g0[2] + b0[2]; y[3] = (bf_hi(v.y) - mu) * rstd * g0[3] + b0[3];
        y[4] = (bf_lo(v.z) - mu) * rstd * g1[0] + b1[0]; y[5] = (bf_hi(v.z) - mu) * rstd * g1[1] + b1[1]; y[6] = (bf_lo(v.w) - mu) * rstd * g1[2] + b1[2]; y[7] = (bf_hi(v.w) - mu) * rstd * g1[3] + b1[3];
        u32x4 w; w.x = cvt_pk_bf16(y[0], y[1]); w.y = cvt_pk_bf16(y[2], y[3]); w.z = cvt_pk_bf16(y[4], y[5]); w.w = cvt_pk_bf16(y[6], y[7]);
        *(LAS u32x4*)(vt + off_b(s, ch)) = w;
    }
    __syncthreads();
    if (it_next >= 0) sgu_dma(P, raw, it_next, wave, lane);
    const unsigned vb = (unsigned)(size_t)vt;
#pragma unroll
    for (int c = 0; c < 8; ++c) {
        typedef unsigned short u16x4 __attribute__((ext_vector_type(4)));
        u16x4 r[8]; unsigned ad[8];
#pragma unroll
        for (int kk = 0; kk < 4; ++kk) { ad[2 * kk] = vb + tr_addr16(lane, c, kk, 0); ad[2 * kk + 1] = vb + tr_addr16(lane, c, kk, 1); }
        asm volatile("ds_read_b64_tr_b16 %0, %8\n\tds_read_b64_tr_b16 %1, %9\n\tds_read_b64_tr_b16 %2, %10\n\tds_read_b64_tr_b16 %3, %11\n\t"
                     "ds_read_b64_tr_b16 %4, %12\n\tds_read_b64_tr_b16 %5, %13\n\tds_read_b64_tr_b16 %6, %14\n\tds_read_b64_tr_b16 %7, %15\n\ts_waitcnt lgkmcnt(0)"
                     : "=&v"(r[0]), "=&v"(r[1]), "=&v"(r[2]), "=&v"(r[3]), "=&v"(r[4]), "=&v"(r[5]), "=&v"(r[6]), "=&v"(r[7])
                     : "v"(ad[0]), "v"(ad[1]), "v"(ad[2]), "v"(ad[3]), "v"(ad[4]), "v"(ad[5]), "v"(ad[6]), "v"(ad[7]) : "memory");
        f32x4 d = (f32x4){0.f, 0.f, 0.f, 0.f};
#pragma unroll
        for (int kk = 0; kk < 4; ++kk) { if (kk < nkk) { bf16x8 Bv; Bv[0] = (short)r[2 * kk][0]; Bv[1] = (short)r[2 * kk][1]; Bv[2] = (short)r[2 * kk][2]; Bv[3] = (short)r[2 * kk][3];
            Bv[4] = (short)r[2 * kk + 1][0]; Bv[5] = (short)r[2 * kk + 1][1]; Bv[6] = (short)r[2 * kk + 1][2]; Bv[7] = (short)r[2 * kk + 1][3];
            d = __builtin_amdgcn_mfma_f32_16x16x32_bf16(Bv, Aw[kk], d, 0, 0, 0); } }
        const u32x2 uw = upre[c];
        u32x2 o; o.x = cvt_pk_bf16(bf_lo(uw.x) * (d[0] + bias), bf_hi(uw.x) * (d[1] + bias)); o.y = cvt_pk_bf16(bf_lo(uw.y) * (d[2] + bias), bf_hi(uw.y) * (d[3] + bias));
        *(u32x2*)(ubase + 16 * c) = o;
    }
}

struct RnnP { bf16* XR; bf16* GY; const bf16* HALO; const bf16* WL; const float* cw; const float* cb; const float* ba; const float* bx; const float* lam; float* Atot; float* Hend; };
constexpr int XL_LD = 68;
__device__ __forceinline__ float softplus_f(float z) { return fmaxf(z, 0.f) + log1pf(__expf(-fabsf(z))); }
__device__ __forceinline__ void rnn_item(const RnnP& P, LAS float* xl, int b, int h, int seg, int lane) {
    const int n = lane & 15, q = lane >> 4;
    const int cD = h * 64 + 4 * n;
    bf16x8 Wf[2][4][2];
#pragma unroll
    for (int g = 0; g < 2; ++g)
#pragma unroll
        for (int c = 0; c < 4; ++c)
#pragma unroll
            for (int ks = 0; ks < 2; ++ks) Wf[g][c][ks] = *(const bf16x8*)(P.WL + (((size_t)g * NH + h) * 64 + 4 * n + c) * 64 + 32 * ks + 8 * q);
    const f32x4 ba4 = *(const f32x4*)(P.ba + cD), bx4 = *(const f32x4*)(P.bx + cD), lam4 = *(const f32x4*)(P.lam + cD);
    float sp4[4];
#pragma unroll
    for (int c = 0; c < 4; ++c) sp4[c] = 8.0f * softplus_f(-lam4[c]);
    float hin[4] = {0.f, 0.f, 0.f, 0.f}, atot[4] = {1.f, 1.f, 1.f, 1.f};
    LAS float* wlp = xl + 16 * XL_LD;
#pragma unroll
    for (int k = 0; k < 5; ++k) wlp[k * 64 + lane] = (k < 4) ? P.cw[k * DRNN + h * 64 + lane] : P.cb[h * 64 + lane];
    u32x4 xn[2][4];
#define RNN_FETCH(NT) do { const int tl_ = 16 * (NT) + n; _Pragma("unroll") for (int ks = 0; ks < 2; ++ks) _Pragma("unroll") for (int k = 0; k < 4; ++k) { const int tl = tl_ - 3 + k;   \
        const bf16* src = (tl >= 0) ? P.XR + ((size_t)(b * SEQ + seg * 64 + tl)) * DRNN : P.HALO + ((size_t)((b * NSEG + (seg > 0 ? seg - 1 : 0)) * 3 + (tl + 3))) * DRNN; \
        u32x4 xv = *(const u32x4*)(src + h * 64 + 32 * ks + 8 * q); if (tl < 0 && seg == 0) xv = (u32x4){0u, 0u, 0u, 0u}; xn[ks][k] = xv; } } while (0)
    RNN_FETCH(0);
#pragma unroll 1
    for (int nt = 0; nt < 4; ++nt) {
        asm volatile("" ::: "memory");
        const int t0 = seg * 64 + 16 * nt;
        bf16x8 Xf[2];
#pragma unroll
        for (int ks = 0; ks < 2; ++ks) {
            const LAS float* wq = wlp + 32 * ks + 8 * q;
            f32x4 x0 = *(const LAS f32x4*)(wq + 4 * 64), x1 = *(const LAS f32x4*)(wq + 4 * 64 + 4);
#pragma unroll
            for (int k = 0; k < 4; ++k) { const u32x4 xv = xn[ks][k];
                const f32x4 w0 = *(const LAS f32x4*)(wq + k * 64), w1 = *(const LAS f32x4*)(wq + k * 64 + 4);
                x0[0] += bf_lo(xv.x) * w0[0]; x0[1] += bf_hi(xv.x) * w0[1]; x0[2] += bf_lo(xv.y) * w0[2]; x0[3] += bf_hi(xv.y) * w0[3];
                x1[0] += bf_lo(xv.z) * w1[0]; x1[1] += bf_hi(xv.z) * w1[1]; x1[2] += bf_lo(xv.w) * w1[2]; x1[3] += bf_hi(xv.w) * w1[3]; }
            *(LAS f32x4*)(xl + n * XL_LD + 32 * ks + 8 * q) = x0; *(LAS f32x4*)(xl + n * XL_LD + 32 * ks + 8 * q + 4) = x1;
            u32x4 w; w.x = cvt_pk_bf16(x0[0], x0[1]); w.y = cvt_pk_bf16(x0[2], x0[3]); w.z = cvt_pk_bf16(x1[0], x1[1]); w.w = cvt_pk_bf16(x1[2], x1[3]);
            Xf[ks] = __builtin_bit_cast(bf16x8, w);
        }
        if (nt < 3) RNN_FETCH(nt + 1);
        u32x2 gpre[4];
#pragma unroll
        for (int jj = 0; jj < 4; ++jj) gpre[jj] = *(const u32x2*)(P.GY + ((size_t)(b * SEQ + t0 + 4 * q + jj)) * DRNN + cD);
        f32x4 Da[4], Dx[4];
#pragma unroll
        for (int c = 0; c < 4; ++c) {
            Da[c] = __builtin_amdgcn_mfma_f32_16x16x32_bf16(Xf[0], Wf[0][c][0], (f32x4){0.f, 0.f, 0.f, 0.f}, 0, 0, 0); Da[c] = __builtin_amdgcn_mfma_f32_16x16x32_bf16(Xf[1], Wf[0][c][1], Da[c], 0, 0, 0);
            Dx[c] = __builtin_amdgcn_mfma_f32_16x16x32_bf16(Xf[0], Wf[1][c][0], (f32x4){0.f, 0.f, 0.f, 0.f}, 0, 0, 0); Dx[c] = __builtin_amdgcn_mfma_f32_16x16x32_bf16(Xf[1], Wf[1][c][1], Dx[c], 0, 0, 0);
        }
        f32x4 xd[4];
#pragma unroll
        for (int jj = 0; jj < 4; ++jj) xd[jj] = *(const LAS f32x4*)(xl + (4 * q + jj) * XL_LD + 4 * n);
        float hh[4][4], pp[4][4];
#pragma unroll
        for (int c = 0; c < 4; ++c) {
            float av[4], uv[4];
#pragma unroll
            for (int jj = 0; jj < 4; ++jj) {
                const float r = sigm(Da[c][jj] + ba4[c]), ig = sigm(Dx[c][jj] + bx4[c]);
                const float la = -r * sp4[c];
                float d = -la * (1.0f + la * (0.5f + la * (0.16666667f + la * (0.041666668f + la * (0.0083333338f + la * (0.0013888889f + la * 0.0001984127f))))));
                if (__builtin_expect(__any(la < -0.35f), 0)) { if (la < -0.35f) d = 1.0f - __builtin_amdgcn_exp2f(1.44269504f * la); }
                av[jj] = 1.0f - d;
                uv[jj] = __builtin_amdgcn_sqrtf(d * (2.0f - d)) * (ig * xd[jj][c]);
            }
            pp[c][0] = av[0]; hh[c][0] = uv[0];
#pragma unroll
            for (int jj = 1; jj < 4; ++jj) { hh[c][jj] = av[jj] * hh[c][jj - 1] + uv[jj]; pp[c][jj] = av[jj] * pp[c][jj - 1]; }
        }
        float Aq[4], Hq[4], Ax[4], Hx[4];
#pragma unroll
        for (int c = 0; c < 4; ++c) { Aq[c] = pp[c][3]; Hq[c] = hh[c][3]; }
#pragma unroll
        for (int c = 0; c < 4; ++c) { Ax[c] = __shfl_up(Aq[c], 16); Hx[c] = __shfl_up(Hq[c], 16); }
#pragma unroll
        for (int c = 0; c < 4; ++c) if (q >= 1) { Hq[c] = Aq[c] * Hx[c] + Hq[c]; Aq[c] = Aq[c] * Ax[c]; }
#pragma unroll
        for (int c = 0; c < 4; ++c) { Ax[c] = __shfl_up(Aq[c], 32); Hx[c] = __shfl_up(Hq[c], 32); }
#pragma unroll
        for (int c = 0; c < 4; ++c) if (q >= 2) { Hq[c] = Aq[c] * Hx[c] + Hq[c]; Aq[c] = Aq[c] * Ax[c]; }
        float A3[4], H3[4];
#pragma unroll
        for (int c = 0; c < 4; ++c) { Ax[c] = __shfl_up(Aq[c], 16); Hx[c] = __shfl_up(Hq[c], 16); A3[c] = __shfl(Aq[c], 48 + n); H3[c] = __shfl(Hq[c], 48 + n); }
#pragma unroll
        for (int c = 0; c < 4; ++c) {
            if (q == 0) { Ax[c] = 1.f; Hx[c] = 0.f; }
            const float cin = Hx[c] + Ax[c] * hin[c], pin = Ax[c] * atot[c];
#pragma unroll
            for (int jj = 0; jj < 4; ++jj) { hh[c][jj] = hh[c][jj] + pp[c][jj] * cin; pp[c][jj] = pp[c][jj] * pin; }
            hin[c] = H3[c] + A3[c] * hin[c]; atot[c] *= A3[c];
        }
#pragma unroll
        for (int jj = 0; jj < 4; ++jj) { const size_t o = ((size_t)(b * SEQ + t0 + 4 * q + jj)) * DRNN + cD; const u32x2 gw = gpre[jj];
            const float g0 = bf_lo(gw.x), g1 = bf_hi(gw.x), g2 = bf_lo(gw.y), g3 = bf_hi(gw.y);
            u32x2 oy; oy.x = cvt_pk_bf16(hh[0][jj] * g0, hh[1][jj] * g1); oy.y = cvt_pk_bf16(hh[2][jj] * g2, hh[3][jj] * g3); *(u32x2*)(P.GY + o) = oy;
            u32x2 op; op.x = cvt_pk_bf16(pp[0][jj] * g0, pp[1][jj] * g1); op.y = cvt_pk_bf16(pp[2][jj] * g2, pp[3][jj] * g3); *(u32x2*)(P.XR + o) = op; }
    }
    if (q == 0) { const size_t o = ((size_t)(b * NSEG + seg)) * DRNN + cD;
        *(f32x4*)(P.Atot + o) = (f32x4){atot[0], atot[1], atot[2], atot[3]}; *(f32x4*)(P.Hend + o) = (f32x4){hin[0], hin[1], hin[2], hin[3]}; }
}
__device__ __forceinline__ void rnn_apply(const RnnP& P, LAS float* cl, int b, int seg, int tid) {
    if (seg == 0) return;
    {
        float H[3] = {0.f, 0.f, 0.f};
        for (int s0 = 0; s0 < seg; s0 += 16) { float as[3][16], hs[3][16];
#pragma unroll
            for (int k = 0; k < 3; ++k) { const int c = tid + k * NWAVES * 64;
#pragma unroll
                for (int j = 0; j < 16; ++j) { const bool in = (s0 + j < seg) && (c < DRNN); const size_t o = ((size_t)(b * NSEG + (in ? s0 + j : 0))) * DRNN + (in ? c : 0); as[k][j] = in ? P.Atot[o] : 1.f; hs[k][j] = in ? P.Hend[o] : 0.f; } }
#pragma unroll
            for (int k = 0; k < 3; ++k)
#pragma unroll
                for (int j = 0; j < 16; ++j) H[k] = as[k][j] * H[k] + hs[k][j]; }
#pragma unroll
        for (int k = 0; k < 3; ++k) { const int c = tid + k * NWAVES * 64; if (c < DRNN) cl[c] = H[k]; }
    }
    __syncthreads();
    for (int i = tid; i < 64 * (DRNN / 8); i += NWAVES * 64) { const int r = i / (DRNN / 8), ch = (i % (DRNN / 8)) * 8; const size_t o = ((size_t)(b * SEQ + seg * 64 + r)) * DRNN + ch;
        const u32x4 y = *(const u32x4*)(P.GY + o), p = *(const u32x4*)(P.XR + o); const f32x4 c0 = *(const LAS f32x4*)(cl + ch), c1 = *(const LAS f32x4*)(cl + ch + 4);
        u32x4 w; w.x = cvt_pk_bf16(bf_lo(y.x) + bf_lo(p.x) * c0[0], bf_hi(y.x) + bf_hi(p.x) * c0[1]); w.y = cvt_pk_bf16(bf_lo(y.y) + bf_lo(p.y) * c0[2], bf_hi(y.y) + bf_hi(p.y) * c0[3]);
        w.z = cvt_pk_bf16(bf_lo(y.z) + bf_lo(p.z) * c1[0], bf_hi(y.z) + bf_hi(p.z) * c1[1]); w.w = cvt_pk_bf16(bf_lo(y.w) + bf_lo(p.w) * c1[2], bf_hi(y.w) + bf_hi(p.w) * c1[3]);
        *(u32x4*)(P.GY + o) = w; }
    __syncthreads();
}
#define XB_TMO      128
#define XB_XCNT(j)  (256  + 64 * (j))
#define XB_XSUB(j)  (1280 + 64 * (j))
#define XB_XGEN(j)  (2304 + 64 * (j))
#define XB_TOP      3328
#define XB_TOPGEN   3392
#define XCD_BAR_WORDS 3456
#define XB_SPIN_CAP (1u << 18)

__device__ __forceinline__ unsigned xb_ld(unsigned* p)              { return __hip_atomic_load(p, __ATOMIC_RELAXED, __HIP_MEMORY_SCOPE_AGENT); }
__device__ __forceinline__ unsigned xb_add(unsigned* p, unsigned v) { return __hip_atomic_fetch_add(p, v, __ATOMIC_RELAXED, __HIP_MEMORY_SCOPE_AGENT); }
__device__ __forceinline__ unsigned xb_xcc_id() { return (unsigned)__builtin_amdgcn_s_getreg((3 << 11) | 20) & 0xFu; }
#define XB_SPIN(cond, bar) do { unsigned _sp = 0; while (cond) { __builtin_amdgcn_s_sleep(1); \
    if ((++_sp & 255u) == 0u) { if (xb_ld(&(bar)[XB_TMO])) break; if (_sp > XB_SPIN_CAP) { atomicAdd(&(bar)[XB_TMO], 1u); break; } } } } while (0)

struct XcdBarrier {
    unsigned* bar; unsigned x;
    volatile LAS unsigned* st;
};

__device__ __forceinline__ XcdBarrier xcd_barrier_post(unsigned* bar, volatile LAS unsigned* st) {
    XcdBarrier b; b.bar = bar; b.x = xb_xcc_id(); b.st = st;
    if (threadIdx.x == 0) (void)xb_add(&bar[XB_XCNT(b.x)], 1u);
    return b;
}
__device__ __forceinline__ void xcd_barrier_complete(unsigned* bar, unsigned x, unsigned& nloc, unsigned& nx) {
    const unsigned G = gridDim.x * gridDim.y * gridDim.z;
    unsigned sum, cnt, mine, sp = 0u;
    for (;;) {
        sum = 0u; cnt = 0u; mine = 0u;
#pragma unroll
        for (unsigned j = 0; j < 16; ++j) { const unsigned c = xb_ld(&bar[XB_XCNT(j)]); sum += c; cnt += (c > 0u) ? 1u : 0u; mine = (j == x) ? c : mine; }
        if (sum == G) break;
        __builtin_amdgcn_s_sleep(1);
        if ((++sp & 255u) == 0u) { if (xb_ld(&bar[XB_TMO])) break; if (sp > XB_SPIN_CAP) { atomicAdd(&bar[XB_TMO], 1u); break; } }
    }
    nloc = mine > 0u ? mine : 1u; nx = cnt > 0u ? cnt : 1u;
}

__device__ __forceinline__ void xcd_barrier(const XcdBarrier& b) {
    asm volatile("s_waitcnt vmcnt(0)" ::: "memory");
    __syncthreads();
    if (threadIdx.x == 0) {
        unsigned* bar = b.bar;
        __builtin_amdgcn_s_waitcnt(0);
        unsigned nloc = b.st[0], nx = b.st[1];
        if (nloc == 0u) { xcd_barrier_complete(bar, b.x, nloc, nx); b.st[0] = nloc; b.st[1] = nx; }
        const unsigned old = xb_add(&bar[XB_XSUB(b.x)], 1u);
        const unsigned gen = old / nloc;
        if (old + 1u == (gen + 1u) * nloc) {
            __builtin_amdgcn_fence(__ATOMIC_RELEASE, "agent");
            asm volatile("s_waitcnt vmcnt(0)" ::: "memory");
            const unsigned og = xb_add(&bar[XB_TOP], 1u);
            const unsigned tg = og / nx;
            if (og + 1u == (tg + 1u) * nx) xb_add(&bar[XB_TOPGEN], 1u);
            else XB_SPIN(xb_ld(&bar[XB_TOPGEN]) == tg, bar);
            __builtin_amdgcn_fence(__ATOMIC_ACQUIRE, "agent");
            xb_add(&bar[XB_XGEN(b.x)], 1u);
            asm volatile("s_waitcnt vmcnt(0)" ::: "memory");
        } else {
            XB_SPIN(xb_ld(&bar[XB_XGEN(b.x)]) == gen, bar);
            __builtin_amdgcn_fence(__ATOMIC_ACQUIRE, "agent");
            asm volatile("s_waitcnt vmcnt(0)" ::: "memory");
        }
    }
    __syncthreads();
}
#ifndef PH_HI
#define PH_HI NPHASE
#endif
#ifndef PH_MASK
#define PH_MASK 511
#endif

struct P3Sched {
    pg8::StaticOrder S0; const bf16 *XB, *WG, *YA, *WA, *YB, *WB;
    __device__ __forceinline__ bool next(int i, pg8::UnitX& u) const { pg8::Unit t; if (!S0.next(i >> 2, t)) return false; const int s = i & 3; u.pm = t.pm; u.pn = t.pn; u.kind = s;
        if (s == 0) { u.A = XB; u.Bt = WG; u.K = D; } else if (s == 1) { u.A = YA; u.Bt = WA; u.K = DRNN; } else if (s == 2) { u.A = XB; u.Bt = WG + (size_t)D * D; u.K = D; } else { u.A = YB; u.Bt = WB; u.K = D; }
        return true; }
    __device__ __forceinline__ void a_ready(const pg8::UnitX&) const {}
    __device__ __forceinline__ void done(const pg8::UnitX&) const {}
};
struct EpiP3 {
    static constexpr bool PERM = true, AFTER_DRAIN = false;
    pg8::EpiGate8 ga, gb; pg8::EpiMix<false> ma; pg8::EpiMix<true> mb;
    __device__ __forceinline__ void operator()(const pg8::f32x4 (&acc)[2][2][4][2], const pg8::UnitX& u, int wr, int wc, int fr, int fq) const {
        const pg8::Unit t{u.pm, u.pn};
        if (u.kind == 0) ga(acc, t, wr, wc, fr, fq); else if (u.kind == 1) ma(acc, t, wr, wc, fr, fq); else if (u.kind == 2) gb(acc, t, wr, wc, fr, fq); else mb(acc, t, wr, wc, fr, fq);
    }
};

__global__ void __launch_bounds__(NWAVES * 64, 2) fwd_megakernel(Args a) {
    extern __shared__ __attribute__((aligned(16))) unsigned char lds_raw[];
    LAS unsigned char* lds = (LAS unsigned char*)lds_raw;
    cg::grid_group grid = cg::this_grid();
    { LAS unsigned* z = (LAS unsigned*)(lds + 131072); if (threadIdx.x < 64) z[threadIdx.x] = 0u; }
    if (blockIdx.x == 0) { unsigned* bw = (unsigned*)(*(unsigned char* const __attribute__((address_space(4)))*)((kptr_t)__builtin_amdgcn_kernarg_segment_ptr() + 176) + WS_BAR);
        for (int i = threadIdx.x; i < XCD_BAR_WORDS; i += NWAVES * 64) __hip_atomic_store(bw + i, 0u, __ATOMIC_RELAXED, __HIP_MEMORY_SCOPE_AGENT);
        __builtin_amdgcn_fence(__ATOMIC_RELEASE, "agent"); asm volatile("s_waitcnt vmcnt(0)" ::: "memory"); }
    __syncthreads();
    grid.sync();
    (void)xcd_barrier_post((unsigned*)(*(unsigned char* const __attribute__((address_space(4)))*)((kptr_t)__builtin_amdgcn_kernarg_segment_ptr() + 176) + WS_BAR), (volatile LAS unsigned*)(lds + 131072 + 32));
    int tid = threadIdx.x, G = gridDim.x, bx = blockIdx.x;
    kptr_t kp = (kptr_t)__builtin_amdgcn_kernarg_segment_ptr();
    unsigned char* ws = *(unsigned char* const __attribute__((address_space(4)))*)(kp + 176);
    float* const outp = *(float* const __attribute__((address_space(4)))*)(kp + 168);
    const int ph_lo = *(const int __attribute__((address_space(4)))*)(kp + 184), ph_hi = *(const int __attribute__((address_space(4)))*)(kp + 188);
#define REFRESH_PTRS() asm volatile("" : "+s"(ws), "+s"(kp))
    float* ssq = (float*)(ws + WS_SSQ); float* vst = (float*)(ws + WS_VST);
    bf16* XB = (bf16*)(ws + WS_XB); bf16* XR = (bf16*)(ws + WS_XR); bf16* GR = (bf16*)(ws + WS_GR); bf16* U = (bf16*)(ws + WS_U); bf16* V = (bf16*)(ws + WS_V);
    bf16* F = (bf16*)(ws + WS_F); bf16* S1 = (bf16*)(ws + WS_S1); bf16* S2 = (bf16*)(ws + WS_S2);

    for (int ph = ph_lo; ph < ph_hi; ++ph) {
        if (ph > ph_lo) { XcdBarrier bar; bar.bar = (unsigned*)(ws + WS_BAR); bar.x = xb_xcc_id(); bar.st = (volatile LAS unsigned*)(lds + 131072 + 32); xcd_barrier(bar); }
#ifdef TS_SEL
        if (blockIdx.x == 0 && threadIdx.x == 0) ((unsigned long long*)(ws + WS_TS))[ph] = __builtin_amdgcn_s_memrealtime();
        if (ph == NPHASE - 1) { XcdBarrier bar; bar.bar = (unsigned*)(ws + WS_BAR); bar.x = xb_xcc_id(); bar.st = (volatile LAS unsigned*)(lds + 131072 + 32); xcd_barrier(bar); }
#endif
        asm volatile("" : "+s"(ws)); asm volatile("" : "+s"(kp)); asm volatile("" : "+v"(tid)); asm volatile("" : "+s"(G)); asm volatile("" : "+s"(bx));
        const int lane = tid & 63, wave = __builtin_amdgcn_readfirstlane(tid >> 6);
        const int vcu = (G % 8 == 0) ? (bx % 8) * (G / 8) + bx / 8 : bx;
        const int gw = vcu * NWAVES + wave, NGW = G * NWAVES;
        ssq = (float*)(ws + WS_SSQ); vst = (float*)(ws + WS_VST); XB = (bf16*)(ws + WS_XB); XR = (bf16*)(ws + WS_XR); GR = (bf16*)(ws + WS_GR); U = (bf16*)(ws + WS_U); V = (bf16*)(ws + WS_V);
        F = (bf16*)(ws + WS_F); S1 = (bf16*)(ws + WS_S1); S2 = (bf16*)(ws + WS_S2);
        if (ph == 0) { if (PH_MASK & 256) p0_prologue(kp, ws, lds, gw, NGW, wave, lane); continue; }
        if (ph == NPHASE - 1) {
            const float* gf = AIN(kp, I_FNG);
            for (int m = gw; m < M; m += NGW) { f32x4* xr = (f32x4*)(outp + (size_t)m * D) + lane; const u32x2* xbr = (const u32x2*)(XB + (size_t)m * D) + lane; f32x4 v[4]; float s = 0.f;
#pragma unroll
                for (int j = 0; j < 4; ++j) { const u32x2 w = xbr[64 * j]; v[j] = (f32x4){bf_lo(w.x), bf_hi(w.x), bf_lo(w.y), bf_hi(w.y)}; s += (v[j].x * v[j].x + v[j].y * v[j].y) + (v[j].z * v[j].z + v[j].w * v[j].w); }
                const float rs = __builtin_amdgcn_rsqf(wave_sum(s) * (1.0f / 1024.0f) + pg8::RMS_EPS);
#pragma unroll
                for (int j = 0; j < 4; ++j) { const f32x4 g4 = *((const f32x4*)gf + lane + 64 * j); f32x4 o = v[j] * rs * g4;
#ifdef TS_SEL
                    { const unsigned long long* ts = (const unsigned long long*)(ws + WS_TS); unsigned long long sel = 0; const int ids[] = TS_SEL;
                      for (unsigned k = 0; k < sizeof(ids) / sizeof(int); ++k) sel += ts[ids[k] + 1] - ts[ids[k]];
                      const float frac = (float)sel / (float)(ts[NPHASE - 1] - ts[0]), dlt = 0.02f * sqrtf(frac); o += (f32x4){dlt, -dlt, dlt, -dlt}; }
#endif
                    xr[64 * j] = o; } }
            continue;
        }
        const int l = (ph - 1) / 7, sub = (ph - 1) % 7;
        const unsigned char* wl = ws + WS_W + (size_t)l * W_LAYER;
        if (sub == 0 && (PH_MASK & 1)) {
            pg8::Gemm g{XB, (const bf16*)(wl + W_IN), M, NP1, D}; pg8::StaticOrder S; S.init(M, NP1, G, bx);
            pg8::EpiIn E{XR, GR, U, V, (bf16*)(ws + WS_HALO), ssq + (2 * l) * M, vst + (2 * l) * M, vst + (2 * l + 1) * M};
            pg8::gemm_phase<pg8::EpiIn, pg8::StaticOrder, true, true>(lds, g, S, E, tid);
            {
                const int rounds = (S.nwg + G - 1) / G, nidle = rounds * G - S.nwg, first_idle = G - nidle;
                const bool all = (nidle == 0); const int cg = all ? gw : (bx - first_idle) * NWAVES + wave, cn = all ? NGW : nidle * NWAVES;
                if (all || bx >= first_idle) { LAS float* scr = (LAS float*)(lds + wave * 16384);
                    convert_layer(kp, ws, l, CVT_WIN, CVT_ALL, scr, cg, cn, lane);
                    if (l + 1 < DEPTH) convert_layer(kp, ws, l + 1, 0, CVT_WIN, scr, cg, cn, lane); }
            }
        }
#ifdef NAIVE_MIX
        else if (sub == 1) { naive_vstats(V, vst + (2 * l) * M, vst + (2 * l + 1) * M, gw, NGW, lane); }
        else if (sub == 2) {
            naive_sgu(V, U, AIN(kp, I_WS) + (size_t)l * 8 * 128 * 128, AIN(kp, I_BS) + l * 1024, AIN(kp, I_LNG) + l * 1024, AIN(kp, I_LNB) + l * 1024, vst + (2 * l) * M, vst + (2 * l + 1) * M, gw * 64 + lane, NGW * 64);
            naive_rnn(XR, GR, AIN(kp, I_LWA) + (size_t)l * NH * 4096, AIN(kp, I_LWX) + (size_t)l * NH * 4096, AIN(kp, I_LBA) + l * DRNN, AIN(kp, I_LBX) + l * DRNN, AIN(kp, I_LAM) + l * DRNN, AIN(kp, I_CW) + l * 4 * DRNN, AIN(kp, I_CB) + l * DRNN, gw, NGW, lane);
        }
#endif
        else if (sub == 1 && (PH_MASK & 2)) {
            SguP P{V, U, (const bf16*)(wl + W_S), AIN(kp, I_BS) + l * 1024, AIN(kp, I_LNG) + l * 1024, AIN(kp, I_LNB) + l * 1024, vst + (2 * l) * M, vst + (2 * l + 1) * M};
            { LAS unsigned char* raw = lds + 32768; if (vcu < BATCH * 32 * 8) sgu_dma(P, raw, vcu, wave, lane);
              for (int it = vcu; it < BATCH * 32 * 8; it += G) sgu_item(P, lds, raw, (it + G < BATCH * 32 * 8) ? it + G : -1, it >> 8, (it >> 3) & 31, it & 7, tid, wave, lane);
              __syncthreads(); }
            RnnP R{XR, GR, (const bf16*)(ws + WS_HALO), (const bf16*)(wl + W_L), AIN(kp, I_CW) + l * 4 * DRNN, AIN(kp, I_CB) + l * DRNN, AIN(kp, I_LBA) + l * DRNN, AIN(kp, I_LBX) + l * DRNN, AIN(kp, I_LAM) + l * DRNN,
                   (float*)(ws + WS_ATOT), (float*)(ws + WS_HEND)};
            LAS float* xl = (LAS float*)(lds + 40960 + wave * 6144);
            { const int per = (BATCH * NH * NSEG + G - 1) / G, base = vcu * per, lim = min(base + per, BATCH * NH * NSEG);
              for (int j = wave; j < per; j += NWAVES) { const int it = base + j; if (it < lim) rnn_item(R, xl, (it / NH) % BATCH, it % NH, it / (NH * BATCH), lane); } }
        } else if (sub == 2 && (PH_MASK & 4)) {
            RnnP R{XR, GR, (const bf16*)(ws + WS_HALO), (const bf16*)(wl + W_L), AIN(kp, I_CW) + l * 4 * DRNN, AIN(kp, I_CB) + l * DRNN, AIN(kp, I_LBA) + l * DRNN, AIN(kp, I_LBX) + l * DRNN, AIN(kp, I_LAM) + l * DRNN,
                   (float*)(ws + WS_ATOT), (float*)(ws + WS_HEND)};
            for (int it = vcu; it < BATCH * NSEG; it += G) rnn_apply(R, (LAS float*)lds, it / NSEG, it % NSEG, tid);
        } else if (sub == 3 && (PH_MASK & 8)) {
            pg8::StaticOrder S; S.init(M, D, G, bx);
            unsigned char* G8 = (unsigned char*)outp;
            P3Sched PS{S, XB, (const bf16*)(wl + W_G), GR, (const bf16*)(wl + W_A), U, (const bf16*)(wl + W_B)};
            EpiP3 E{pg8::EpiGate8{G8, ssq + (2 * l) * M}, pg8::EpiGate8{G8 + (size_t)M * D, ssq + (2 * l) * M}, pg8::EpiMix<false>{S1, G8}, pg8::EpiMix<true>{S1, G8 + (size_t)M * D}};
            pg8::gemm_phase_multi<EpiP3, P3Sched, true, true>(lds, PS, E, tid);
        } else if (sub == 4 && (PH_MASK & 16)) {
            pg8::Gemm g{S1, (const bf16*)(wl + W_O), M, D, D}; pg8::StaticOrder S; S.init(M, D, G, bx);
            pg8::EpiRes E{XB, ssq + (2 * l + 1) * M};
            pg8::gemm_phase<pg8::EpiRes, pg8::StaticOrder, true, true>(lds, g, S, E, tid);
        } else if (sub == 5 && (PH_MASK & 32)) {
            pg8::Gemm g{XB, (const bf16*)(wl + W_UP), M, FF, D}; pg8::StaticOrder S; S.init(M, FF, G, bx);
            pg8::EpiAct<1> E{F, FF, ssq + (2 * l + 1) * M};
            pg8::gemm_phase<pg8::EpiAct<1>, pg8::StaticOrder, true, true>(lds, g, S, E, tid);
        } else if (PH_MASK & 64) {
            pg8::Gemm g{F, (const bf16*)(wl + W_DN), M, D, FF}; pg8::StaticOrder S; S.init(M, D, G, bx);
            pg8::EpiRes E{XB, ssq + (2 * l + 2) * M};
            pg8::gemm_phase<pg8::EpiRes, pg8::StaticOrder, true, true>(lds, g, S, E, tid);
        }
    }
}

extern "C" void kernel_launch(void* const* d_in, const int* in_sizes, int n_in, void* d_out, int out_size, void* d_ws, size_t ws_size, hipStream_t stream) {
    static int grid = 0;
    if (grid == 0) {
        if (n_in != 21 || out_size != M * D || ws_size < WS_END) { fprintf(stderr, "kernel_launch: unexpected shapes (n_in %d, out %d, ws %zu); nothing launched\n", n_in, out_size, ws_size); grid = -1; return; }
        int dev = 0, cus = 0, per_cu = 0;
        if (hipGetDevice(&dev) != hipSuccess || hipDeviceGetAttribute(&cus, hipDeviceAttributeMultiprocessorCount, dev) != hipSuccess) { grid = -1; return; }
        if (hipFuncSetAttribute((const void*)fwd_megakernel, hipFuncAttributeMaxDynamicSharedMemorySize, LDS_BYTES) != hipSuccess) { fprintf(stderr, "kernel_launch: hipFuncSetAttribute failed\n"); grid = -1; return; }
        if (hipOccupancyMaxActiveBlocksPerMultiprocessor(&per_cu, (const void*)fwd_megakernel, NWAVES * 64, LDS_BYTES) != hipSuccess || per_cu < 1) per_cu = 1;
        (void)hipGetLastError();
        grid = cus * per_cu;
        fprintf(stderr, "kernel_launch: %d CUs x %d -> grid %d, ws %zu\n", cus, per_cu, grid, ws_size);
    }
    if (grid < 0) return;
#ifdef EXP_POISON
    (void)hipMemsetAsync(d_ws, 0xAA, WS_END, stream); (void)hipMemsetAsync(d_out, 0xAA, (size_t)M * D * 4, stream);
#endif
    Args a{};
    for (int i = 0; i < 21; ++i) a.in[i] = (const float*)d_in[i];
    a.out = (float*)d_out; a.ws = (unsigned char*)d_ws; a.ph_lo = 0; a.ph_hi = PH_HI;
    void* args[] = {&a};
    const hipError_t e = hipLaunchCooperativeKernel((const void*)fwd_megakernel, dim3(grid), dim3(NWAVES * 64), args, LDS_BYTES, stream);
    if (e != hipSuccess) fprintf(stderr, "kernel_launch: cooperative launch failed: %s (grid %d)\n", hipGetErrorString(e), grid);
}
```

```cpp
#include <hip/hip_runtime.h>
#include <hip/hip_cooperative_groups.h>
#include <cstdio>
#include <cstdint>
namespace cg = cooperative_groups;
namespace pg8 {
#define PG8_LAS __attribute__((address_space(3)))
typedef unsigned short bf16_t;
typedef short bf16x8 __attribute__((ext_vector_type(8)));
typedef float f32x4 __attribute__((ext_vector_type(4)));
typedef unsigned u32x4 __attribute__((ext_vector_type(4)));
typedef unsigned u32x2 __attribute__((ext_vector_type(2)));
constexpr int BM = 256, BK = 64, HALF = 128, HTB = HALF * BK * 2, STAGE_BYTES = 8 * HTB, NXCD = 8, WGM = 4;
__host__ __device__ __forceinline__ int lds_byte(int r, int c) { const int st = (r >> 4) * 2 + (c >> 5), rr = r & 15, cc = c & 31, ob = rr * 64 + cc * 2; return st * 1024 + (ob ^ (((ob >> 9) & 1) << 5)); }
__host__ __device__ __forceinline__ void stage_rc(int b, int& R, int& C) { const int st = b / 1024, sb = b % 1024, swz = sb ^ (((sb >> 9) & 1) << 5); R = (st >> 1) * 16 + swz / 64; C = (st & 1) * 32 + (swz % 64) / 2; }
__host__ __device__ __forceinline__ int perm32(int rho) { const int n = rho >> 4, i = rho & 15; return 8 * (i >> 2) + 4 * n + (i & 3); }
struct Unit { int pm, pn; };
struct Gemm { const bf16_t* A; const bf16_t* Bt; int M, N, K; };
struct StaticOrder {
    int nM, nN, nwg, G, c;
    __host__ __device__ void init(int M, int N, int G_, int c_) { nM = M / BM; nN = N / BM; nwg = nM * nN; G = G_; c = c_; }
    __host__ __device__ bool next(int i, Unit& u) const {
        const long L = (long)i * G + c; if (L >= nwg) return false;
        int wgid = (int)L; { const int q = nwg / NXCD, r = nwg % NXCD, xcd = wgid % NXCD, off = wgid / NXCD; wgid = (xcd < r ? xcd * (q + 1) : r * (q + 1) + (xcd - r) * q) + off; }
        const int nig = WGM * nN, gid = wgid / nig, fm = gid * WGM, gsz = (nM - fm) < WGM ? (nM - fm) : WGM;
        u.pm = fm + ((wgid % nig) % gsz); u.pn = (wgid % nig) / gsz; return true;
    }
    __device__ __forceinline__ void a_ready(const Unit&) const {}
    __device__ __forceinline__ void done(const Unit&) const {}
};

constexpr float RMS_EPS = 1e-6f;
__device__ __forceinline__ unsigned cvt_pk_bf16(float lo, float hi) { unsigned r; asm volatile("v_cvt_pk_bf16_f32 %0, %1, %2" : "=v"(r) : "v"(lo), "v"(hi)); return r; }
__device__ __forceinline__ float bf_lo(unsigned w) { return __uint_as_float(w << 16); }
__device__ __forceinline__ float bf_hi(unsigned w) { return __uint_as_float(w & 0xffff0000u); }
__device__ __forceinline__ float sigm(float x) { return __builtin_amdgcn_rcpf(1.0f + __builtin_amdgcn_exp2f(-1.44269504f * x)); }
__device__ __forceinline__ float gelu_t(float x) { const float z = x * (1.5957691216f + 0.0713548163f * x * x); return x * __builtin_amdgcn_rcpf(1.0f + __builtin_amdgcn_exp2f(-1.44269504f * z)); }
constexpr float FIX_SSQ = 4096.0f, FIX_V = 65536.0f;
__device__ __forceinline__ float unfix(float slot, float scale) { return (float)(int)__float_as_uint(slot) * (1.0f / scale); }
__device__ __forceinline__ float tofix(float v, float scale) { return __uint_as_float((unsigned)(int)__builtin_rintf(v * scale)); }
__device__ __forceinline__ float rstd_of(float ssq) { return __builtin_amdgcn_rsqf(unfix(ssq, FIX_SSQ) * (1.0f / 1024.0f) + RMS_EPS); }
__device__ __forceinline__ void fadd_fix(float* p, float v, float scale) { (void)__hip_atomic_fetch_add((unsigned*)p, (unsigned)(int)__builtin_rintf(v * scale), __ATOMIC_RELAXED, __HIP_MEMORY_SCOPE_AGENT); }

struct EpiIn {
    static constexpr bool PERM = true, AFTER_DRAIN = false;
    bf16_t* XR; bf16_t* GR; bf16_t* U; bf16_t* V; bf16_t* HALO; const float* ssq; float* vsum; float* vsq;
    __device__ __forceinline__ void operator()(const f32x4 (&acc)[2][2][4][2], const Unit& u, int wr, int wc, int fr, int fq) const {
        const int pn = u.pn; bf16_t* base; int ldc, colt, act;
        if (pn < 5) { base = XR; ldc = 1280; colt = pn * 256; act = 0; }
        else if (pn < 10) { base = GR; ldc = 1280; colt = (pn - 5) * 256; act = 1; }
        else if (pn < 14) { base = U; ldc = 1024; colt = (pn - 10) * 256; act = 1; }
        else { base = V; ldc = 1024; colt = (pn - 14) * 256; act = 2; }
        const int row0 = u.pm * BM + wr * 64 + fr, col0 = colt + wc * 32 + 8 * fq;
        float rs8[8];
#pragma unroll
        for (int i = 0; i < 8; ++i) rs8[i] = ssq[row0 + (i >> 2) * HALF + (i & 3) * 16];
        asm volatile("" ::: "memory");
#pragma unroll
        for (int ai = 0; ai < 2; ++ai)
#pragma unroll
            for (int m = 0; m < 4; ++m) {
                const int row = row0 + ai * HALF + m * 16; const float rs = rstd_of(rs8[ai * 4 + m]);
                bf16_t* rowp = base + (size_t)row * ldc + col0; float s1 = 0.f, s2 = 0.f;
#pragma unroll
                for (int bj = 0; bj < 2; ++bj) { f32x4 v0 = acc[ai][bj][m][0] * rs, v1 = acc[ai][bj][m][1] * rs;
                    if (act) {
#pragma unroll
                        for (int j = 0; j < 4; ++j) { v0[j] = gelu_t(v0[j]); v1[j] = gelu_t(v1[j]); } }
                    if (act == 2) {
#pragma unroll
                        for (int j = 0; j < 4; ++j) { s1 += v0[j] + v1[j]; s2 += v0[j] * v0[j] + v1[j] * v1[j]; } }
                    u32x4 w; w.x = cvt_pk_bf16(v0[0], v0[1]); w.y = cvt_pk_bf16(v0[2], v0[3]); w.z = cvt_pk_bf16(v1[0], v1[1]); w.w = cvt_pk_bf16(v1[2], v1[3]);
                    *(u32x4*)(rowp + bj * HALF) = w;
                    if (pn < 5 && m == 3 && fr >= 13) *(u32x4*)(HALO + ((size_t)(row >> 6) * 3 + (fr - 13)) * 1280 + col0 + bj * HALF) = w; }
                if (act == 2) { s1 += __shfl_xor(s1, 16); s1 += __shfl_xor(s1, 32); s2 += __shfl_xor(s2, 16); s2 += __shfl_xor(s2, 32);
                    if (fq == 0) { fadd_fix(vsum + row, s1, FIX_V); fadd_fix(vsq + row, s2, FIX_V); } }
            }
    }
};
template <int ACT> struct EpiAct {
    static constexpr bool PERM = true, AFTER_DRAIN = false;
    bf16_t* O; int ldc; const float* ssq;
    __device__ __forceinline__ void operator()(const f32x4 (&acc)[2][2][4][2], const Unit& u, int wr, int wc, int fr, int fq) const {
        const int row0 = u.pm * BM + wr * 64 + fr, col0 = u.pn * BM + wc * 32 + 8 * fq;
        float rs8[8];
#pragma unroll
        for (int i = 0; i < 8; ++i) rs8[i] = ssq[row0 + (i >> 2) * HALF + (i & 3) * 16];
        asm volatile("" ::: "memory");
#pragma unroll
        for (int ai = 0; ai < 2; ++ai)
#pragma unroll
            for (int m = 0; m < 4; ++m) {
                const int row = row0 + ai * HALF + m * 16; const float rs = rstd_of(rs8[ai * 4 + m]);
                bf16_t* rowp = O + (size_t)row * ldc + col0;
#pragma unroll
                for (int bj = 0; bj < 2; ++bj) { f32x4 v0 = acc[ai][bj][m][0] * rs, v1 = acc[ai][bj][m][1] * rs;
#pragma unroll
                    for (int j = 0; j < 4; ++j) {
                        if (ACT == 0) { v0[j] = sigm(v0[j]); v1[j] = sigm(v1[j]); }
                        else { const float a = fmaxf(v0[j], 0.f), b = fmaxf(v1[j], 0.f); v0[j] = a * a; v1[j] = b * b; } }
                    u32x4 w; w.x = cvt_pk_bf16(v0[0], v0[1]); w.y = cvt_pk_bf16(v0[2], v0[3]); w.z = cvt_pk_bf16(v1[0], v1[1]); w.w = cvt_pk_bf16(v1[2], v1[3]);
                    *(u32x4*)(rowp + bj * HALF) = w; }
            }
    }
};
struct EpiGate8 {
    static constexpr bool PERM = true, AFTER_DRAIN = false;
    unsigned char* G8; const float* ssq;
    __device__ __forceinline__ void operator()(const f32x4 (&acc)[2][2][4][2], const Unit& u, int wr, int wc, int fr, int fq) const {
        const int row0 = u.pm * BM + wr * 64 + fr, col0 = u.pn * BM + wc * 32 + 8 * fq;
#pragma unroll
        for (int ai = 0; ai < 2; ++ai)
#pragma unroll
            for (int m = 0; m < 4; ++m) {
                const int row = row0 + ai * HALF + m * 16; const float rs = rstd_of(ssq[row]);
                unsigned char* rowp = G8 + (size_t)row * 1024 + col0;
#pragma unroll
                for (int bj = 0; bj < 2; ++bj) { const f32x4 v0 = acc[ai][bj][m][0] * rs, v1 = acc[ai][bj][m][1] * rs; unsigned q[8];
#pragma unroll
                    for (int j = 0; j < 4; ++j) { q[j] = (unsigned)__builtin_rintf(255.0f * sigm(v0[j])); q[4 + j] = (unsigned)__builtin_rintf(255.0f * sigm(v1[j])); }
                    u32x2 w; w.x = q[0] | (q[1] << 8) | (q[2] << 16) | (q[3] << 24); w.y = q[4] | (q[5] << 8) | (q[6] << 16) | (q[7] << 24);
                    *(u32x2*)(rowp + bj * HALF) = w; }
            }
    }
};
template <bool ADD> struct EpiMix {
    static constexpr bool PERM = true, AFTER_DRAIN = false;
    bf16_t* O; const unsigned char* G8;
    __device__ __forceinline__ void operator()(const f32x4 (&acc)[2][2][4][2], const Unit& u, int wr, int wc, int fr, int fq) const {
        const int row0 = u.pm * BM + wr * 64 + fr, col0 = u.pn * BM + wc * 32 + 8 * fq;
#pragma unroll
        for (int ai = 0; ai < 2; ++ai)
#pragma unroll
            for (int m = 0; m < 4; ++m) {
                const size_t off = (size_t)(row0 + ai * HALF + m * 16) * 1024 + col0;
#pragma unroll
                for (int bj = 0; bj < 2; ++bj) { const u32x2 gq = *(const u32x2*)(G8 + off + bj * HALF); const f32x4 a0 = acc[ai][bj][m][0], a1 = acc[ai][bj][m][1];
                    const float k = 1.0f / 255.0f; f32x4 v0, v1;
                    v0[0] = (float)(gq.x & 255u) * k * a0[0]; v0[1] = (float)((gq.x >> 8) & 255u) * k * a0[1]; v0[2] = (float)((gq.x >> 16) & 255u) * k * a0[2]; v0[3] = (float)(gq.x >> 24) * k * a0[3];
                    v1[0] = (float)(gq.y & 255u) * k * a1[0]; v1[1] = (float)((gq.y >> 8) & 255u) * k * a1[1]; v1[2] = (float)((gq.y >> 16) & 255u) * k * a1[2]; v1[3] = (float)(gq.y >> 24) * k * a1[3];
                    if (ADD) { const u32x4 tw = *(const u32x4*)(O + off + bj * HALF);
                        v0[0] += bf_lo(tw.x); v0[1] += bf_hi(tw.x); v0[2] += bf_lo(tw.y); v0[3] += bf_hi(tw.y); v1[0] += bf_lo(tw.z); v1[1] += bf_hi(tw.z); v1[2] += bf_lo(tw.w); v1[3] += bf_hi(tw.w); }
                    u32x4 w; w.x = cvt_pk_bf16(v0[0], v0[1]); w.y = cvt_pk_bf16(v0[2], v0[3]); w.z = cvt_pk_bf16(v1[0], v1[1]); w.w = cvt_pk_bf16(v1[2], v1[3]);
                    *(u32x4*)(O + off + bj * HALF) = w; }
                asm volatile("" ::: "memory");
            }
    }
};
struct EpiRes {
    static constexpr bool PERM = true, AFTER_DRAIN = false;
    bf16_t* xb; float* ssq_out;
    __device__ __forceinline__ void operator()(const f32x4 (&acc)[2][2][4][2], const Unit& u, int wr, int wc, int fr, int fq) const {
        const int row0 = u.pm * BM + wr * 64 + fr, col0 = u.pn * BM + wc * 32 + 8 * fq;
#pragma unroll
        for (int ai = 0; ai < 2; ++ai)
#pragma unroll
            for (int m = 0; m < 4; ++m) {
                const int row = row0 + ai * HALF + m * 16; const size_t off = (size_t)row * 1024 + col0; float s = 0.f;
#pragma unroll
                for (int bj = 0; bj < 2; ++bj) { const u32x4 xw = *(const u32x4*)(xb + off + bj * HALF); const f32x4 a0 = acc[ai][bj][m][0], a1 = acc[ai][bj][m][1];
                    f32x4 v0, v1; v0[0] = bf_lo(xw.x) + a0[0]; v0[1] = bf_hi(xw.x) + a0[1]; v0[2] = bf_lo(xw.y) + a0[2]; v0[3] = bf_hi(xw.y) + a0[3];
                    v1[0] = bf_lo(xw.z) + a1[0]; v1[1] = bf_hi(xw.z) + a1[1]; v1[2] = bf_lo(xw.w) + a1[2]; v1[3] = bf_hi(xw.w) + a1[3];
                    u32x4 w; w.x = cvt_pk_bf16(v0[0], v0[1]); w.y = cvt_pk_bf16(v0[2], v0[3]); w.z = cvt_pk_bf16(v1[0], v1[1]); w.w = cvt_pk_bf16(v1[2], v1[3]);
                    *(u32x4*)(xb + off + bj * HALF) = w;
                    s += (v0[0] * v0[0] + v0[1] * v0[1]) + (v0[2] * v0[2] + v0[3] * v0[3]) + (v1[0] * v1[0] + v1[1] * v1[1]) + (v1[2] * v1[2] + v1[3] * v1[3]); }
                s += __shfl_xor(s, 16); s += __shfl_xor(s, 32);
                if (fq == 0) fadd_fix(ssq_out + row, s, FIX_SSQ);
                asm volatile("" ::: "memory");
            }
    }
};
template <class Epi, class Sched, bool ALIGN_EPI = false, bool SP2 = false>
__device__ __forceinline__ void gemm_phase(PG8_LAS unsigned char* lds, const Gemm g, const Sched& S, const Epi& E, const int tid) {
    const int wid = __builtin_amdgcn_readfirstlane(tid >> 6), lane = tid & 63, wr = wid >> 2, wc = wid & 3, fr = lane & 15, fq = lane >> 4;
    const int K = g.K, nt = K / BK;
    unsigned voffA[2], voffB[2];
#pragma unroll
    for (int i = 0; i < 2; ++i) { int R, C; stage_rc(tid * 16 + i * 8192, R, C); const int Rb = Epi::PERM ? ((R & ~31) + perm32(R & 31)) : R;
        voffA[i] = (unsigned)(R * K + C) * 2u; voffB[i] = (unsigned)(Rb * K + C) * 2u; }
    const size_t kstep = (size_t)(BK * 2);
    const size_t hstep = (size_t)HALF * K * 2;
    const size_t tstep = 2 * hstep;
    const unsigned ldsw = (unsigned)wid * 1024u;
    const int aoff = lds_byte(wr * 64 + fr, fq * 8), boff = lds_byte(wc * 32 + fr, fq * 8);
#define PG8_SA(b, h) (((b) * 2 + (h)) * HTB)
#define PG8_SB(b, h) ((4 + (b) * 2 + (h)) * HTB)
#define PG8_STAGE(bufoff, gbase, voff) do { _Pragma("unroll") for (int _i = 0; _i < 2; ++_i) \
        __builtin_amdgcn_global_load_lds((const unsigned*)((const char*)(gbase) + (voff)[_i]), (PG8_LAS unsigned*)(lds + (bufoff) + ldsw + _i * 8192), 16, 0, 0); } while (0)
#define PG8_LDA(dst, b, h) do { _Pragma("unroll") for (int m = 0; m < 4; ++m) _Pragma("unroll") for (int k = 0; k < 2; ++k) dst[m][k] = *(const PG8_LAS bf16x8*)(lds + PG8_SA(b, h) + aoff + m * 2048 + k * 1024); } while (0)
#define PG8_LDB(dst, b, h) do { _Pragma("unroll") for (int n = 0; n < 2; ++n) _Pragma("unroll") for (int k = 0; k < 2; ++k) dst[n][k] = *(const PG8_LAS bf16x8*)(lds + PG8_SB(b, h) + boff + n * 2048 + k * 1024); } while (0)
#define PG8_MMA(ai, bj, At, Bt) do { __builtin_amdgcn_s_setprio(1); _Pragma("unroll") for (int m = 0; m < 4; ++m) _Pragma("unroll") for (int n = 0; n < 2; ++n) _Pragma("unroll") for (int k = 0; k < 2; ++k) \
        acc[ai][bj][m][n] = __builtin_amdgcn_mfma_f32_16x16x32_bf16(Bt[n][k], At[m][k], acc[ai][bj][m][n], 0, 0, 0); __builtin_amdgcn_s_setprio(0); } while (0)
#define PG8_WAIT_V(n) asm volatile("s_waitcnt vmcnt(" #n ")" ::: "memory")
#define PG8_WAIT_L(n) asm volatile("s_waitcnt lgkmcnt(" #n ")" ::: "memory")
#define PG8_BAR __builtin_amdgcn_s_barrier()
#define PG8_SCHED __builtin_amdgcn_sched_barrier(0)
    Unit cur, nxt; int ui = 0;
    if (!S.next(0, cur)) return;
    f32x4 acc[2][2][4][2];
#pragma unroll
    for (int a = 0; a < 2; ++a)
#pragma unroll
        for (int b = 0; b < 2; ++b)
#pragma unroll
            for (int m = 0; m < 4; ++m)
#pragma unroll
                for (int n = 0; n < 2; ++n) acc[a][b][m][n] = (f32x4){0.f, 0.f, 0.f, 0.f};
    bf16x8 At[4][2], B0[2][2], B1[2][2];
    const char* cA = (const char*)g.A + (size_t)cur.pm * tstep; const char* cB = (const char*)g.Bt + (size_t)cur.pn * tstep;
    S.a_ready(cur);
    if constexpr (SP2) {
        PG8_STAGE(PG8_SB(0, 0), cB, voffB); PG8_STAGE(PG8_SB(0, 1), cB + hstep, voffB); PG8_STAGE(PG8_SA(0, 0), cA, voffA); PG8_STAGE(PG8_SA(0, 1), cA + hstep, voffA);
        if (wr == 1) PG8_BAR;
        PG8_WAIT_V(2); PG8_BAR;
        PG8_STAGE(PG8_SB(1, 0), cB + kstep, voffB); PG8_STAGE(PG8_SA(1, 0), cA + kstep, voffA); PG8_STAGE(PG8_SB(1, 1), cB + hstep + kstep, voffB);
        PG8_WAIT_V(6); PG8_BAR;
    } else {
        PG8_STAGE(PG8_SB(0, 0), cB, voffB); PG8_STAGE(PG8_SA(0, 0), cA, voffA); PG8_STAGE(PG8_SB(0, 1), cB + hstep, voffB); PG8_STAGE(PG8_SA(0, 1), cA + hstep, voffA);
        if (wr == 1) PG8_BAR;
        PG8_WAIT_V(4); PG8_BAR;
        PG8_STAGE(PG8_SB(1, 0), cB + kstep, voffB); PG8_STAGE(PG8_SA(1, 0), cA + kstep, voffA); PG8_STAGE(PG8_SB(1, 1), cB + hstep + kstep, voffB);
        PG8_WAIT_V(6); PG8_BAR;
    }
    for (;;) {
        const bool has_next = S.next(ui + 1, nxt);
        const char* nA = has_next ? (const char*)g.A + (size_t)nxt.pm * tstep : cA; const char* nB = has_next ? (const char*)g.Bt + (size_t)nxt.pn * tstep : cB;
        for (int t = 0; t < nt; t += 2) {
            const bool last = (t == nt - 2);
            const char* a1 = cA + (size_t)(t + 1) * kstep;
            const char* a2 = last ? nA : cA + (size_t)(t + 2) * kstep; const char* b2 = last ? nB : cB + (size_t)(t + 2) * kstep;
            const char* a3 = a2 + kstep; const char* b3 = b2 + kstep;
            if (last && has_next) S.a_ready(nxt);
            if constexpr (SP2) {
            PG8_LDB(B0, 0, 0); PG8_LDB(B1, 0, 1); PG8_SCHED; PG8_LDA(At, 0, 0); PG8_STAGE(PG8_SA(1, 1), a1 + hstep, voffA);
            PG8_WAIT_V(8); PG8_WAIT_L(0); PG8_BAR; PG8_MMA(0, 0, At, B0); PG8_MMA(0, 1, At, B1); PG8_BAR; PG8_SCHED;
            PG8_LDA(At, 0, 1); PG8_STAGE(PG8_SB(0, 0), b2, voffB); PG8_STAGE(PG8_SB(0, 1), b2 + hstep, voffB); PG8_STAGE(PG8_SA(0, 0), a2, voffA);
            PG8_WAIT_V(8); PG8_WAIT_L(0); PG8_BAR; PG8_MMA(1, 0, At, B0); PG8_MMA(1, 1, At, B1); PG8_BAR; PG8_SCHED;
            PG8_LDB(B0, 1, 0); PG8_LDB(B1, 1, 1); PG8_SCHED; PG8_LDA(At, 1, 0); PG8_STAGE(PG8_SA(0, 1), a2 + hstep, voffA);
            PG8_WAIT_V(8); PG8_WAIT_L(0); PG8_BAR; PG8_MMA(0, 0, At, B0); PG8_MMA(0, 1, At, B1); PG8_BAR; PG8_SCHED;
            PG8_LDA(At, 1, 1); PG8_STAGE(PG8_SB(1, 0), b3, voffB); PG8_STAGE(PG8_SB(1, 1), b3 + hstep, voffB); PG8_STAGE(PG8_SA(1, 0), a3, voffA);
            PG8_WAIT_V(8); PG8_WAIT_L(0); PG8_BAR; PG8_MMA(1, 0, At, B0); PG8_MMA(1, 1, At, B1); PG8_BAR; PG8_SCHED;
            } else {
            PG8_LDB(B0, 0, 0); PG8_SCHED; PG8_LDA(At, 0, 0); PG8_STAGE(PG8_SA(1, 1), a1 + hstep, voffA);
            PG8_WAIT_L(8); PG8_BAR; PG8_WAIT_L(0); PG8_MMA(0, 0, At, B0); PG8_BAR; PG8_SCHED;
            PG8_LDB(B1, 0, 1); PG8_STAGE(PG8_SB(0, 0), b2, voffB);
            PG8_BAR; PG8_WAIT_L(0); PG8_MMA(0, 1, At, B1); PG8_BAR;
            PG8_LDA(At, 0, 1); PG8_STAGE(PG8_SA(0, 0), a2, voffA);
            PG8_BAR; PG8_WAIT_L(0); PG8_MMA(1, 0, At, B0); PG8_BAR; PG8_SCHED;
            PG8_STAGE(PG8_SB(0, 1), b2 + hstep, voffB);
            PG8_WAIT_V(6); PG8_BAR; PG8_MMA(1, 1, At, B1); PG8_BAR;
            PG8_LDB(B0, 1, 0); PG8_SCHED; PG8_LDA(At, 1, 0); PG8_STAGE(PG8_SA(0, 1), a2 + hstep, voffA);
            PG8_WAIT_L(8); PG8_BAR; PG8_WAIT_L(0); PG8_MMA(0, 0, At, B0); PG8_BAR; PG8_SCHED;
            PG8_LDB(B1, 1, 1); PG8_STAGE(PG8_SB(1, 0), b3, voffB);
            PG8_BAR; PG8_WAIT_L(0); PG8_MMA(0, 1, At, B1); PG8_BAR;
            PG8_LDA(At, 1, 1); PG8_STAGE(PG8_SA(1, 0), a3, voffA);
            PG8_BAR; PG8_WAIT_L(0); PG8_MMA(1, 0, At, B0); PG8_BAR; PG8_SCHED;
            PG8_STAGE(PG8_SB(1, 1), b3 + hstep, voffB);
            PG8_WAIT_V(6); PG8_BAR; PG8_MMA(1, 1, At, B1); PG8_BAR;
            }
        }
        if constexpr (ALIGN_EPI) { if (wr == 0) PG8_BAR; }
        if constexpr (!Epi::AFTER_DRAIN) { E(acc, cur, wr, wc, fr, fq); S.done(cur); }
        if (!has_next) break;
#pragma unroll
        for (int a = 0; a < 2; ++a)
#pragma unroll
            for (int b = 0; b < 2; ++b)
#pragma unroll
                for (int m = 0; m < 4; ++m)
#pragma unroll
                    for (int n = 0; n < 2; ++n) acc[a][b][m][n] = (f32x4){0.f, 0.f, 0.f, 0.f};
        cur = nxt; cA = nA; cB = nB; ++ui;
        if constexpr (ALIGN_EPI) { if (wr == 1) PG8_BAR; }
    }
    PG8_WAIT_V(0);
    if constexpr (!ALIGN_EPI) { if (wr == 0) PG8_BAR; }
    PG8_BAR;
    if constexpr (Epi::AFTER_DRAIN) { E.fused(acc, cur, wr, wc, fr, fq, lds, wid, lane); S.done(cur); }
#undef PG8_SA
#undef PG8_SB
#undef PG8_STAGE
#undef PG8_LDA
#undef PG8_LDB
#undef PG8_MMA
#undef PG8_WAIT_V
#undef PG8_WAIT_L
#undef PG8_BAR
#undef PG8_SCHED
}

struct UnitX { int pm, pn; const bf16_t* A; const bf16_t* Bt; int K; int kind; };
template <class Epi, class Sched, bool ALIGN_EPI = false, bool SP2 = false>
__device__ __forceinline__ void gemm_phase_multi(PG8_LAS unsigned char* lds, const Sched& S, const Epi& E, const int tid) {
    const int wid = __builtin_amdgcn_readfirstlane(tid >> 6), lane = tid & 63, wr = wid >> 2, wc = wid & 3, fr = lane & 15, fq = lane >> 4;
    int sR[2], sRb[2], sC[2];
#pragma unroll
    for (int i = 0; i < 2; ++i) { int R, C; stage_rc(tid * 16 + i * 8192, R, C); sR[i] = R; sRb[i] = Epi::PERM ? ((R & ~31) + perm32(R & 31)) : R; sC[i] = C; }
    unsigned voffA[2], voffB[2], voffAn[2], voffBn[2];
#define PG8_VOFF(dA, dB, KK) do { _Pragma("unroll") for (int _i = 0; _i < 2; ++_i) { dA[_i] = (unsigned)(sR[_i] * (KK) + sC[_i]) * 2u; dB[_i] = (unsigned)(sRb[_i] * (KK) + sC[_i]) * 2u; } } while (0)
    const size_t kstep = (size_t)(BK * 2);
    const unsigned ldsw = (unsigned)wid * 1024u;
    const int aoff = lds_byte(wr * 64 + fr, fq * 8), boff = lds_byte(wc * 32 + fr, fq * 8);
#define PG8_SA(b, h) (((b) * 2 + (h)) * HTB)
#define PG8_SB(b, h) ((4 + (b) * 2 + (h)) * HTB)
#define PG8_STAGE(bufoff, gbase, voff) do { _Pragma("unroll") for (int _i = 0; _i < 2; ++_i) \
        __builtin_amdgcn_global_load_lds((const unsigned*)((const char*)(gbase) + (voff)[_i]), (PG8_LAS unsigned*)(lds + (bufoff) + ldsw + _i * 8192), 16, 0, 0); } while (0)
#define PG8_LDA(dst, b, h) do { _Pragma("unroll") for (int m = 0; m < 4; ++m) _Pragma("unroll") for (int k = 0; k < 2; ++k) dst[m][k] = *(const PG8_LAS bf16x8*)(lds + PG8_SA(b, h) + aoff + m * 2048 + k * 1024); } while (0)
#define PG8_LDB(dst, b, h) do { _Pragma("unroll") for (int n = 0; n < 2; ++n) _Pragma("unroll") for (int k = 0; k < 2; ++k) dst[n][k] = *(const PG8_LAS bf16x8*)(lds + PG8_SB(b, h) + boff + n * 2048 + k * 1024); } while (0)
#define PG8_MMA(ai, bj, At, Bt) do { __builtin_amdgcn_s_setprio(1); _Pragma("unroll") for (int m = 0; m < 4; ++m) _Pragma("unroll") for (int n = 0; n < 2; ++n) _Pragma("unroll") for (int k = 0; k < 2; ++k) \
        acc[ai][bj][m][n] = __builtin_amdgcn_mfma_f32_16x16x32_bf16(Bt[n][k], At[m][k], acc[ai][bj][m][n], 0, 0, 0); __builtin_amdgcn_s_setprio(0); } while (0)
#define PG8_WAIT_V(n) asm volatile("s_waitcnt vmcnt(" #n ")" ::: "memory")
#define PG8_WAIT_L(n) asm volatile("s_waitcnt lgkmcnt(" #n ")" ::: "memory")
#define PG8_BAR __builtin_amdgcn_s_barrier()
#define PG8_SCHED __builtin_amdgcn_sched_barrier(0)
    UnitX cur, nxt; int ui = 0;
    if (!S.next(0, cur)) return;
    int K = cur.K, nt = K / BK; size_t hstep = (size_t)HALF * K * 2, hstepn = hstep; PG8_VOFF(voffA, voffB, K); PG8_VOFF(voffAn, voffBn, K);
    f32x4 acc[2][2][4][2];
#pragma unroll
    for (int a = 0; a < 2; ++a)
#pragma unroll
        for (int b = 0; b < 2; ++b)
#pragma unroll
            for (int m = 0; m < 4; ++m)
#pragma unroll
                for (int n = 0; n < 2; ++n) acc[a][b][m][n] = (f32x4){0.f, 0.f, 0.f, 0.f};
    bf16x8 At[4][2], B0[2][2], B1[2][2];
    const char* cA = (const char*)cur.A + (size_t)cur.pm * 2 * hstep; const char* cB = (const char*)cur.Bt + (size_t)cur.pn * 2 * hstep;
    S.a_ready(cur);
    if constexpr (SP2) {
        PG8_STAGE(PG8_SB(0, 0), cB, voffB); PG8_STAGE(PG8_SB(0, 1), cB + hstep, voffB); PG8_STAGE(PG8_SA(0, 0), cA, voffA); PG8_STAGE(PG8_SA(0, 1), cA + hstep, voffA);
        if (wr == 1) PG8_BAR;
        PG8_WAIT_V(2); PG8_BAR;
        PG8_STAGE(PG8_SB(1, 0), cB + kstep, voffB); PG8_STAGE(PG8_SA(1, 0), cA + kstep, voffA); PG8_STAGE(PG8_SB(1, 1), cB + hstep + kstep, voffB);
        PG8_WAIT_V(6); PG8_BAR;
    } else {
        PG8_STAGE(PG8_SB(0, 0), cB, voffB); PG8_STAGE(PG8_SA(0, 0), cA, voffA); PG8_STAGE(PG8_SB(0, 1), cB + hstep, voffB); PG8_STAGE(PG8_SA(0, 1), cA + hstep, voffA);
        if (wr == 1) PG8_BAR;
        PG8_WAIT_V(4); PG8_BAR;
        PG8_STAGE(PG8_SB(1, 0), cB + kstep, voffB); PG8_STAGE(PG8_SA(1, 0), cA + kstep, voffA); PG8_STAGE(PG8_SB(1, 1), cB + hstep + kstep, voffB);
        PG8_WAIT_V(6); PG8_BAR;
    }
    for (;;) {
        const bool has_next = S.next(ui + 1, nxt);
        if (has_next) { hstepn = (size_t)HALF * nxt.K * 2; PG8_VOFF(voffAn, voffBn, nxt.K); } else { hstepn = hstep; PG8_VOFF(voffAn, voffBn, K); }
        const char* nA = has_next ? (const char*)nxt.A + (size_t)nxt.pm * 2 * hstepn : cA; const char* nB = has_next ? (const char*)nxt.Bt + (size_t)nxt.pn * 2 * hstepn : cB;
        for (int t = 0; t < nt; t += 2) {
            const bool last = (t == nt - 2);
            const char* a1 = cA + (size_t)(t + 1) * kstep;
            const char* a2 = last ? nA : cA + (size_t)(t + 2) * kstep; const char* b2 = last ? nB : cB + (size_t)(t + 2) * kstep;
            const char* a3 = a2 + kstep; const char* b3 = b2 + kstep;
            unsigned vA2[2], vB2[2]; vA2[0] = last ? voffAn[0] : voffA[0]; vA2[1] = last ? voffAn[1] : voffA[1]; vB2[0] = last ? voffBn[0] : voffB[0]; vB2[1] = last ? voffBn[1] : voffB[1];
            const size_t hs2 = last ? hstepn : hstep;
            if (last && has_next) S.a_ready(nxt);
            if constexpr (SP2) {
            PG8_LDB(B0, 0, 0); PG8_LDB(B1, 0, 1); PG8_SCHED; PG8_LDA(At, 0, 0); PG8_STAGE(PG8_SA(1, 1), a1 + hstep, voffA);
            PG8_WAIT_V(8); PG8_WAIT_L(0); PG8_BAR; PG8_MMA(0, 0, At, B0); PG8_MMA(0, 1, At, B1); PG8_BAR; PG8_SCHED;
            PG8_LDA(At, 0, 1); PG8_STAGE(PG8_SB(0, 0), b2, vB2); PG8_STAGE(PG8_SB(0, 1), b2 + hs2, vB2); PG8_STAGE(PG8_SA(0, 0), a2, vA2);
            PG8_WAIT_V(8); PG8_WAIT_L(0); PG8_BAR; PG8_MMA(1, 0, At, B0); PG8_MMA(1, 1, At, B1); PG8_BAR; PG8_SCHED;
            PG8_LDB(B0, 1, 0); PG8_LDB(B1, 1, 1); PG8_SCHED; PG8_LDA(At, 1, 0); PG8_STAGE(PG8_SA(0, 1), a2 + hs2, vA2);
            PG8_WAIT_V(8); PG8_WAIT_L(0); PG8_BAR; PG8_MMA(0, 0, At, B0); PG8_MMA(0, 1, At, B1); PG8_BAR; PG8_SCHED;
            PG8_LDA(At, 1, 1); PG8_STAGE(PG8_SB(1, 0), b3, vB2); PG8_STAGE(PG8_SB(1, 1), b3 + hs2, vB2); PG8_STAGE(PG8_SA(1, 0), a3, vA2);
            PG8_WAIT_V(8); PG8_WAIT_L(0); PG8_BAR; PG8_MMA(1, 0, At, B0); PG8_MMA(1, 1, At, B1); PG8_BAR; PG8_SCHED;
            } else {
            PG8_LDB(B0, 0, 0); PG8_SCHED; PG8_LDA(At, 0, 0); PG8_STAGE(PG8_SA(1, 1), a1 + hstep, voffA);
            PG8_WAIT_L(8); PG8_BAR; PG8_WAIT_L(0); PG8_MMA(0, 0, At, B0); PG8_BAR; PG8_SCHED;
            PG8_LDB(B1, 0, 1); PG8_STAGE(PG8_SB(0, 0), b2, voffB);
            PG8_BAR; PG8_WAIT_L(0); PG8_MMA(0, 1, At, B1); PG8_BAR;
            PG8_LDA(At, 0, 1); PG8_STAGE(PG8_SA(0, 0), a2, voffA);
            PG8_BAR; PG8_WAIT_L(0); PG8_MMA(1, 0, At, B0); PG8_BAR; PG8_SCHED;
            PG8_STAGE(PG8_SB(0, 1), b2 + hstep, voffB);
            PG8_WAIT_V(6); PG8_BAR; PG8_MMA(1, 1, At, B1); PG8_BAR;
            PG8_LDB(B0, 1, 0); PG8_SCHED; PG8_LDA(At, 1, 0); PG8_STAGE(PG8_SA(0, 1), a2 + hstep, voffA);
            PG8_WAIT_L(8); PG8_BAR; PG8_WAIT_L(0); PG8_MMA(0, 0, At, B0); PG8_BAR; PG8_SCHED;
            PG8_LDB(B1, 1, 1); PG8_STAGE(PG8_SB(1, 0), b3, voffB);
            PG8_BAR; PG8_WAIT_L(0); PG8_MMA(0, 1, At, B1); PG8_BAR;
            PG8_LDA(At, 1, 1); PG8_STAGE(PG8_SA(1, 0), a3, voffA);
            PG8_BAR; PG8_WAIT_L(0); PG8_MMA(1, 0, At, B0); PG8_BAR; PG8_SCHED;
            PG8_STAGE(PG8_SB(1, 1), b3 + hstep, voffB);
            PG8_WAIT_V(6); PG8_BAR; PG8_MMA(1, 1, At, B1); PG8_BAR;
            }
        }
        if constexpr (ALIGN_EPI) { if (wr == 0) PG8_BAR; }
        if constexpr (!Epi::AFTER_DRAIN) { E(acc, cur, wr, wc, fr, fq); S.done(cur); }
        if (!has_next) break;
#pragma unroll
        for (int a = 0; a < 2; ++a)
#pragma unroll
            for (int b = 0; b < 2; ++b)
#pragma unroll
                for (int m = 0; m < 4; ++m)
#pragma unroll
                    for (int n = 0; n < 2; ++n) acc[a][b][m][n] = (f32x4){0.f, 0.f, 0.f, 0.f};
        cur = nxt; cA = nA; cB = nB; ++ui; K = cur.K; nt = K / BK; hstep = hstepn; voffA[0] = voffAn[0]; voffA[1] = voffAn[1]; voffB[0] = voffBn[0]; voffB[1] = voffBn[1];
        if constexpr (ALIGN_EPI) { if (wr == 1) PG8_BAR; }
    }
    PG8_WAIT_V(0);
    if constexpr (!ALIGN_EPI) { if (wr == 0) PG8_BAR; }
    PG8_BAR;
    if constexpr (Epi::AFTER_DRAIN) { E.fused(acc, cur, wr, wc, fr, fq, lds, wid, lane); S.done(cur); }
#undef PG8_SA
#undef PG8_SB
#undef PG8_STAGE
#undef PG8_LDA
#undef PG8_LDB
#undef PG8_MMA
#undef PG8_WAIT_V
#undef PG8_WAIT_L
#undef PG8_BAR
#undef PG8_SCHED
#undef PG8_VOFF
}


}
constexpr int BATCH = 4, SEQ = 4096, D = 1024, DRNN = 1280, NH = 20, FF = 4096, DEPTH = 2;
constexpr int M = BATCH * SEQ;
constexpr int DIN = 6656, NP1 = 4608;
constexpr int NSEG = 64;
constexpr int NWAVES = 8;
constexpr size_t KiB = 1024, MiB = 1u << 20;
constexpr size_t WS_SSQ = 0;
constexpr size_t WS_VST = 320 * KiB;
constexpr size_t WS_TS = 704 * KiB;
constexpr size_t WS_BAR = 640 * KiB;
constexpr size_t WS_ATOT = 1 * MiB, WS_HEND = 1 * MiB + 1280 * KiB;
constexpr size_t WS_W = 4 * MiB, W_LAYER = 37 * MiB;
constexpr size_t W_IN = 0, W_G = 9 * MiB, W_A = 13 * MiB, W_B = 15 * MiB + 512 * KiB, W_O = 17 * MiB + 512 * KiB, W_UP = 19 * MiB + 512 * KiB, W_DN = 27 * MiB + 512 * KiB,
                 W_L = 35 * MiB + 512 * KiB, W_S = 36 * MiB;
constexpr size_t WS_HALO = 254 * MiB;
constexpr size_t WS_XB = 78 * MiB;
constexpr size_t WS_XR = 110 * MiB, WS_GR = 150 * MiB, WS_U = 190 * MiB, WS_V = 222 * MiB, WS_END = 256 * MiB;
constexpr size_t WS_F = 110 * MiB;
constexpr size_t WS_S1 = WS_V, WS_S2 = WS_XR;
static_assert(WS_HEND + 1280 * KiB <= WS_W && WS_W + 2 * W_LAYER <= WS_XB && WS_XB + (size_t)M * D * 2 <= WS_XR && WS_F + (size_t)M * FF * 2 <= WS_HALO && WS_V + (size_t)M * D * 2 <= WS_HALO && WS_HALO + (size_t)(M / 64) * 3 * DRNN * 2 <= WS_END, "d_ws map");
static_assert(W_S + 8 * 128 * 128 * 2 <= W_LAYER && W_L + 2 * 20 * 64 * 64 * 2 <= W_S, "weight map");
constexpr int LDS_BYTES = 147456;
constexpr int NPHASE = 16;

#define LAS __attribute__((address_space(3)))
typedef unsigned short bf16;
typedef float f32x4 __attribute__((ext_vector_type(4)));
typedef short bf16x8 __attribute__((ext_vector_type(8)));
typedef unsigned u32x4 __attribute__((ext_vector_type(4)));
typedef unsigned u32x2 __attribute__((ext_vector_type(2)));
#define LDS_WAIT() asm volatile("s_waitcnt lgkmcnt(0)" ::: "memory")
using pg8::cvt_pk_bf16; using pg8::bf_lo; using pg8::bf_hi; using pg8::sigm;

__device__ __forceinline__ float wave_sum(float v) {
#pragma unroll
    for (int o = 1; o < 64; o <<= 1) v += __shfl_xor(v, o);
    return v;
}
struct Args { const float* in[21]; float* out; unsigned char* ws; int ph_lo, ph_hi; };
enum { I_X = 0, I_NMG, I_WIN, I_CW, I_CB, I_LWA, I_LBA, I_LWX, I_LBX, I_LAM, I_LNG, I_LNB, I_WS, I_BS, I_WA, I_WB, I_WO, I_NFG, I_WUP, I_WDN, I_FNG };
typedef const unsigned char __attribute__((address_space(4)))* kptr_t;
#define AIN(kp, i) (*(const float* const __attribute__((address_space(4)))*)((kp) + 8 * (i)))
struct CvtItem { const float* src; const float* ksc; bf16* dst; int ldw, K; };
__device__ __forceinline__ CvtItem cvt_decode(kptr_t kp, unsigned char* wl, int l, int r) {
    constexpr int J0 = 16 * 144, J1 = 16 * 64, J2 = 20 * 32, J3 = 16 * 32, J4 = 16 * 32, J5 = 16 * 128;
    const float* W; const float* ksc = nullptr; bf16* WT; int ldw, K, nblk;
    if (r < J0) { W = AIN(kp, I_WIN) + (size_t)l * D * DIN; ldw = DIN; K = D; nblk = NP1 / 32; WT = (bf16*)(wl + W_IN); ksc = AIN(kp, I_NMG) + l * D; }
    else if ((r -= J0) < J1) { W = AIN(kp, I_WIN) + (size_t)l * D * DIN + NP1; ldw = DIN; K = D; nblk = 2048 / 32; WT = (bf16*)(wl + W_G); ksc = AIN(kp, I_NMG) + l * D; }
    else if ((r -= J1) < J2) { W = AIN(kp, I_WA) + (size_t)l * DRNN * D; ldw = D; K = DRNN; nblk = D / 32; WT = (bf16*)(wl + W_A); }
    else if ((r -= J2) < J3) { W = AIN(kp, I_WB) + (size_t)l * D * D; ldw = D; K = D; nblk = D / 32; WT = (bf16*)(wl + W_B); }
    else if ((r -= J3) < J4) { W = AIN(kp, I_WO) + (size_t)l * D * D; ldw = D; K = D; nblk = D / 32; WT = (bf16*)(wl + W_O); }
    else if ((r -= J4) < J5) { W = AIN(kp, I_WUP) + (size_t)l * D * FF; ldw = FF; K = D; nblk = FF / 32; WT = (bf16*)(wl + W_UP); ksc = AIN(kp, I_NFG) + l * D; }
    else { r -= J5; W = AIN(kp, I_WDN) + (size_t)l * FF * D; ldw = D; K = FF; nblk = D / 32; WT = (bf16*)(wl + W_DN); }
    const int k0 = 64 * (r / nblk), n0 = 32 * (r % nblk);
    CvtItem c; c.src = W + (size_t)k0 * ldw + n0; c.ksc = ksc ? ksc + k0 : nullptr; c.dst = WT + (size_t)n0 * K + k0; c.ldw = ldw; c.K = K; return c;
}
constexpr int CVT_WIN = 16 * 144, CVT_ALL = 16 * 144 + 16 * 64 + 20 * 32 + 16 * 32 + 16 * 32 + 16 * 128 + 64 * 32;
__device__ __forceinline__ void convert_layer(kptr_t kp, unsigned char* ws, int l, int lo, int JL, LAS float* scr, int gw, int NGW, int lane) {
    gw += lo;
    unsigned char* wl = ws + WS_W + (size_t)l * W_LAYER;
    const int lr = lane >> 3, lc = (lane & 7) * 4;
    if (gw >= JL) return;
    CvtItem cur = cvt_decode(kp, wl, l, gw);
    f32x4 v[8];
#pragma unroll
    for (int i = 0; i < 8; ++i) v[i] = *(const f32x4*)(cur.src + (size_t)(lr + 8 * i) * cur.ldw + lc);
    for (int it = gw; it < JL; it += NGW) {
        const bool more = it + NGW < JL; CvtItem nxt = cur; f32x4 vn[8];
        if (more) { nxt = cvt_decode(kp, wl, l, it + NGW);
#pragma unroll
            for (int i = 0; i < 8; ++i) vn[i] = *(const f32x4*)(nxt.src + (size_t)(lr + 8 * i) * nxt.ldw + lc); }
        if (cur.ksc) {
#pragma unroll
            for (int i = 0; i < 8; ++i) v[i] = v[i] * cur.ksc[lr + 8 * i]; }
#pragma unroll
        for (int i = 0; i < 8; ++i) { LAS float* d = scr + (lr + 8 * i) * 33 + lc; d[0] = v[i][0]; d[1] = v[i][1]; d[2] = v[i][2]; d[3] = v[i][3]; }
        LDS_WAIT(); asm volatile("" ::: "memory");
        const int c = lane & 7;
#pragma unroll
        for (int j = 0; j < 4; ++j) { const int n = (lane >> 3) + 8 * j; const LAS float* s = scr + (8 * c) * 33 + n;
            u32x4 o; o.x = cvt_pk_bf16(s[0 * 33], s[1 * 33]); o.y = cvt_pk_bf16(s[2 * 33], s[3 * 33]); o.z = cvt_pk_bf16(s[4 * 33], s[5 * 33]); o.w = cvt_pk_bf16(s[6 * 33], s[7 * 33]);
            *(u32x4*)(cur.dst + (size_t)n * cur.K + 8 * c) = o; }
        LDS_WAIT(); asm volatile("" ::: "memory");
        if (more) { cur = nxt;
#pragma unroll
            for (int i = 0; i < 8; ++i) v[i] = vn[i]; }
    }
}
__device__ __forceinline__ void p0_prologue(kptr_t kp, unsigned char* ws, LAS unsigned char* lds, int gw, int NGW, int wave, int lane) {
    LAS float* scr = (LAS float*)(lds + wave * 16384);
    convert_layer(kp, ws, 0, 0, CVT_WIN, scr, gw, NGW, lane);
    const int gt = gw * 64 + lane, NGT = NGW * 64;
    for (int e = gt; e < DEPTH * 2 * NH * 64 * 64; e += NGT) {
        const int i = e & 63, j = (e >> 6) & 63, h = (e >> 12) % NH, g = ((e >> 12) / NH) & 1, l = (e >> 12) / (2 * NH);
        const float v = AIN(kp, g ? I_LWX : I_LWA)[(((size_t)l * NH + h) * 64 + i) * 64 + j];
        ((bf16*)(ws + WS_W + (size_t)l * W_LAYER + W_L))[(((size_t)g * NH + h) * 64 + j) * 64 + i] = (bf16)(cvt_pk_bf16(v, 0.f) & 0xffffu);
    }
    for (int e = gt; e < DEPTH * 8 * 128 * 128; e += NGT) {
        const int s = e & 127, t = (e >> 7) & 127, l = e >> 17;
        float v = AIN(kp, I_WS)[e]; if ((t >> 6) < (s >> 6)) v = 0.f;
        ((bf16*)(ws + WS_W + (size_t)l * W_LAYER + W_S))[e & 131071] = (bf16)(cvt_pk_bf16(v, 0.f) & 0xffffu);
    }
    { float* z = (float*)(ws + WS_SSQ) + M; for (int e = gt; e < 8 * M; e += NGT) z[e] = 0.f; }
    for (int m = gw; m < M; m += NGW) {
        const f32x4* xr = (const f32x4*)(AIN(kp, I_X) + (size_t)m * D) + lane; u32x2* o = (u32x2*)((bf16*)(ws + WS_XB) + (size_t)m * D) + lane; float s = 0.f;
#pragma unroll
        for (int j = 0; j < 4; ++j) { const f32x4 v = xr[64 * j]; s += (v.x * v.x + v.y * v.y) + (v.z * v.z + v.w * v.w); u32x2 w; w.x = cvt_pk_bf16(v.x, v.y); w.y = cvt_pk_bf16(v.z, v.w); o[64 * j] = w; }
        s = wave_sum(s); if (lane == 0) ((float*)(ws + WS_SSQ))[m] = pg8::tofix(s, pg8::FIX_SSQ);
    }
}

struct SguP { const bf16* V; bf16* U; const bf16* Ws; const float* bs; const float* lng; const float* lnb; const float* vsum; const float* vsq; };
__device__ __forceinline__ unsigned off_b(unsigned row, unsigned ch) { return 256u * row + 16u * (ch ^ (((row & 3) << 2) | ((row >> 2) & 3))); }
__device__ __forceinline__ unsigned tr_addr16(unsigned lane, unsigned c, unsigned ks, unsigned t) { const unsigned g = lane >> 4, q = (lane & 15) >> 2, p = lane & 3; return off_b(32 * ks + 8 * g + 4 * t + q, 2 * c + (p >> 1)) + 8 * (p & 1); }
__device__ __forceinline__ void sgu_dma(const SguP& P, LAS unsigned char* raw, int it, int wave, int lane) {
    const int b = it >> 8, blk = (it >> 3) & 31, g = it & 7, r0 = b * SEQ + blk * 128, c0 = g * 128;
#pragma unroll
    for (int j = 0; j < 4; ++j) { const int row = 16 * wave + 4 * j + (lane >> 4);
        __builtin_amdgcn_global_load_lds((const unsigned*)(P.V + (size_t)(r0 + row) * 1024 + c0 + (lane & 15) * 8), (LAS unsigned*)(raw + (16 * wave + 4 * j) * 256), 16, 0, 0); }
}
__device__ __forceinline__ void sgu_item(const SguP& P, LAS unsigned char* vt, LAS unsigned char* raw, int it_next, int b, int blk, int g, int tid, int wave, int lane) {
    const int r0 = b * SEQ + blk * 128, c0 = g * 128, n = lane & 15, q = lane >> 4;
    const int cc = (tid & 15) * 8;
    const f32x4 g0 = *(const f32x4*)(P.lng + c0 + cc), g1 = *(const f32x4*)(P.lng + c0 + cc + 4), b0 = *(const f32x4*)(P.lnb + c0 + cc), b1 = *(const f32x4*)(P.lnb + c0 + cc + 4);
    float vs1[4], vs2[4];
#pragma unroll
    for (int i = 0; i < 4; ++i) { const int row = r0 + ((tid + 512 * i) >> 4); vs1[i] = P.vsum[row]; vs2[i] = P.vsq[row]; }
    const int nkk = (wave < 4) ? 2 : 4;
    const bf16* Wg = P.Ws + (size_t)g * 128 * 128 + (size_t)(16 * wave + n) * 128 + 8 * q;
    bf16x8 Aw[4];
#pragma unroll
    for (int kk = 0; kk < 4; ++kk) Aw[kk] = (kk < nkk) ? *(const bf16x8*)(Wg + 32 * kk) : (bf16x8){0, 0, 0, 0, 0, 0, 0, 0};
    const int t = 16 * wave + n; const float bias = P.bs[g * 128 + t];
    bf16* ubase = P.U + (size_t)(r0 + t) * 1024 + c0 + 4 * q;
    u32x2 upre[8];
#pragma unroll
    for (int c = 0; c < 8; ++c) upre[c] = *(const u32x2*)(ubase + 16 * c);
    asm volatile("s_waitcnt vmcnt(0)" ::: "memory"); __syncthreads();
#pragma unroll
    for (int i = 0; i < 4; ++i) {
        const int chunk = tid + 512 * i, s = chunk >> 4, ch = chunk & 15;
        const float mu = pg8::unfix(vs1[i], pg8::FIX_V) * (1.0f / 1024.0f), var = fmaxf(pg8::unfix(vs2[i], pg8::FIX_V) * (1.0f / 1024.0f) - mu * mu, 0.f), rstd = __builtin_amdgcn_rsqf(var + 1e-6f);
        const u32x4 v = *(const LAS u32x4*)(raw + chunk * 16);
        float y[8];
        y[0] = (bf_lo(v.x) - mu) * rstd * g0[0] + b0[0]; y[1] = (bf_hi(v.x) - mu) * rstd * g0[1] + b0[1]; y[2] = (bf_lo(v.y) - mu) * rstd * g0[2] + b0[2]; y[3] = (bf_hi(v.y) - mu) * rstd * g0[3] + b0[3];
        y[4] = (bf_lo(v.z) - mu) * rstd * g1[0] + b1[0]; y[5] = (bf_hi(v.z) - mu) * rstd * g1[1] + b1[1]; y[6] = (bf_lo(v.w) - mu) * rstd * g1[2] + b1[2]; y[7] = (bf_hi(v.w) - mu) * rstd * g1[3] + b1[3];
        u32x4 w; w.x = cvt_pk_bf16(y[0], y[1]); w.y = cvt_pk_bf16(y[2], y[3]); w.z = cvt_pk_bf16(y[4], y[5]); w.w = cvt_pk_bf16(y[6], y[7]);
        *(LAS u32x4*)(vt + off_b(s, ch)) = w;
    }
    __syncthreads();
    if (it_next >= 0) sgu_dma(P, raw, it_next, wave, lane);
    const unsigned vb = (unsigned)(size_t)vt;
#pragma unroll
    for (int c = 0; c < 8; ++c) {
        typedef unsigned short u16x4 __attribute__((ext_vector_type(4)));
        u16x4 r[8]; unsigned ad[8];
#pragma unroll
        for (int kk = 0; kk < 4; ++kk) { ad[2 * kk] = vb + tr_addr16(lane, c, kk, 0); ad[2 * kk + 1] = vb + tr_addr16(lane, c, kk, 1); }
        asm volatile("ds_read_b64_tr_b16 %0, %8\n\tds_read_b64_tr_b16 %1, %9\n\tds_read_b64_tr_b16 %2, %10\n\tds_read_b64_tr_b16 %3, %11\n\t"
                     "ds_read_b64_tr_b16 %4, %12\n\tds_read_b64_tr_b16 %5, %13\n\tds_read_b64_tr_b16 %6, %14\n\tds_read_b64_tr_b16 %7, %15\n\ts_waitcnt lgkmcnt(0)"
                     : "=&v"(r[0]), "=&v"(r[1]), "=&v"(r[2]), "=&v"(r[3]), "=&v"(r[4]), "=&v"(r[5]), "=&v"(r[6]), "=&v"(r[7])
                     : "v"(ad[0]), "v"(ad[1]), "v"(ad[2]), "v"(ad[3]), "v"(ad[4]), "v"(ad[5]), "v"(ad[6]), "v"(ad[7]) : "memory");
        f32x4 d = (f32x4){0.f, 0.f, 0.f, 0.f};
#pragma unroll
        for (int kk = 0; kk < 4; ++kk) { if (kk < nkk) { bf16x8 Bv; Bv[0] = (short)r[2 * kk][0]; Bv[1] = (short)r[2 * kk][1]; Bv[2] = (short)r[2 * kk][2]; Bv[3] = (short)r[2 * kk][3];
            Bv[4] = (short)r[2 * kk + 1][0]; Bv[5] = (short)r[2 * kk + 1][1]; Bv[6] = (short)r[2 * kk + 1][2]; Bv[7] = (short)r[2 * kk + 1][3];
            d = __builtin_amdgcn_mfma_f32_16x16x32_bf16(Bv, Aw[kk], d, 0, 0, 0); } }
        const u32x2 uw = upre[c];
        u32x2 o; o.x = cvt_pk_bf16(bf_lo(uw.x) * (d[0] + bias), bf_hi(uw.x) * (d[1] + bias)); o.y = cvt_pk_bf16(bf_lo(uw.y) * (d[2] + bias), bf_hi(uw.y) * (d[3] + bias));
        *(u32x2*)(ubase + 16 * c) = o;
    }
}

struct RnnP { bf16* XR; bf16* GY; const bf16* HALO; const bf16* WL; const float* cw; const float* cb; const float* ba; const float* bx; const float* lam; float* Atot; float* Hend; };
constexpr int XL_LD = 68;
__device__ __forceinline__ float softplus_f(float z) { return fmaxf(z, 0.f) + log1pf(__expf(-fabsf(z))); }
__device__ __forceinline__ void rnn_item(const RnnP& P, LAS float* xl, int b, int h, int seg, int lane) {
    const int n = lane & 15, q = lane >> 4;
    const int cD = h * 64 + 4 * n;
    bf16x8 Wf[2][4][2];
#pragma unroll
    for (int g = 0; g < 2; ++g)
#pragma unroll
        for (int c = 0; c < 4; ++c)
#pragma unroll
            for (int ks = 0; ks < 2; ++ks) Wf[g][c][ks] = *(const bf16x8*)(P.WL + (((size_t)g * NH + h) * 64 + 4 * n + c) * 64 + 32 * ks + 8 * q);
    const f32x4 ba4 = *(const f32x4*)(P.ba + cD), bx4 = *(const f32x4*)(P.bx + cD), lam4 = *(const f32x4*)(P.lam + cD);
    float sp4[4];
#pragma unroll
    for (int c = 0; c < 4; ++c) sp4[c] = 8.0f * softplus_f(-lam4[c]);
    float hin[4] = {0.f, 0.f, 0.f, 0.f}, atot[4] = {1.f, 1.f, 1.f, 1.f};
    LAS float* wlp = xl + 16 * XL_LD;
#pragma unroll
    for (int k = 0; k < 5; ++k) wlp[k * 64 + lane] = (k < 4) ? P.cw[k * DRNN + h * 64 + lane] : P.cb[h * 64 + lane];
    u32x4 xn[2][4];
#define RNN_FETCH(NT) do { const int tl_ = 16 * (NT) + n; _Pragma("unroll") for (int ks = 0; ks < 2; ++ks) _Pragma("unroll") for (int k = 0; k < 4; ++k) { const int tl = tl_ - 3 + k;   \
        const bf16* src = (tl >= 0) ? P.XR + ((size_t)(b * SEQ + seg * 64 + tl)) * DRNN : P.HALO + ((size_t)((b * NSEG + (seg > 0 ? seg - 1 : 0)) * 3 + (tl + 3))) * DRNN; \
        u32x4 xv = *(const u32x4*)(src + h * 64 + 32 * ks + 8 * q); if (tl < 0 && seg == 0) xv = (u32x4){0u, 0u, 0u, 0u}; xn[ks][k] = xv; } } while (0)
    RNN_FETCH(0);
#pragma unroll 1
    for (int nt = 0; nt < 4; ++nt) {
        asm volatile("" ::: "memory");
        const int t0 = seg * 64 + 16 * nt;
        bf16x8 Xf[2];
#pragma unroll
        for (int ks = 0; ks < 2; ++ks) {
            const LAS float* wq = wlp + 32 * ks + 8 * q;
            f32x4 x0 = *(const LAS f32x4*)(wq + 4 * 64), x1 = *(const LAS f32x4*)(wq + 4 * 64 + 4);
#pragma unroll
            for (int k = 0; k < 4; ++k) { const u32x4 xv = xn[ks][k];
                const f32x4 w0 = *(const LAS f32x4*)(wq + k * 64), w1 = *(const LAS f32x4*)(wq + k * 64 + 4);
                x0[0] += bf_lo(xv.x) * w0[0]; x0[1] += bf_hi(xv.x) * w0[1]; x0[2] += bf_lo(xv.y) * w0[2]; x0[3] += bf_hi(xv.y) * w0[3];
                x1[0] += bf_lo(xv.z) * w1[0]; x1[1] += bf_hi(xv.z) * w1[1]; x1[2] += bf_lo(xv.w) * w1[2]; x1[3] += bf_hi(xv.w) * w1[3]; }
            *(LAS f32x4*)(xl + n * XL_LD + 32 * ks + 8 * q) = x0; *(LAS f32x4*)(xl + n * XL_LD + 32 * ks + 8 * q + 4) = x1;
            u32x4 w; w.x = cvt_pk_bf16(x0[0], x0[1]); w.y = cvt_pk_bf16(x0[2], x0[3]); w.z = cvt_pk_bf16(x1[0], x1[1]); w.w = cvt_pk_bf16(x1[2], x1[3]);
            Xf[ks] = __builtin_bit_cast(bf16x8, w);
        }
        if (nt < 3) RNN_FETCH(nt + 1);
        u32x2 gpre[4];
#pragma unroll
        for (int jj = 0; jj < 4; ++jj) gpre[jj] = *(const u32x2*)(P.GY + ((size_t)(b * SEQ + t0 + 4 * q + jj)) * DRNN + cD);
        f32x4 Da[4], Dx[4];
#pragma unroll
        for (int c = 0; c < 4; ++c) {
            Da[c] = __builtin_amdgcn_mfma_f32_16x16x32_bf16(Xf[0], Wf[0][c][0], (f32x4){0.f, 0.f, 0.f, 0.f}, 0, 0, 0); Da[c] = __builtin_amdgcn_mfma_f32_16x16x32_bf16(Xf[1], Wf[0][c][1], Da[c], 0, 0, 0);
            Dx[c] = __builtin_amdgcn_mfma_f32_16x16x32_bf16(Xf[0], Wf[1][c][0], (f32x4){0.f, 0.f, 0.f, 0.f}, 0, 0, 0); Dx[c] = __builtin_amdgcn_mfma_f32_16x16x32_bf16(Xf[1], Wf[1][c][1], Dx[c], 0, 0, 0);
        }
        f32x4 xd[4];
#pragma unroll
        for (int jj = 0; jj < 4; ++jj) xd[jj] = *(const LAS f32x4*)(xl + (4 * q + jj) * XL_LD + 4 * n);
        float hh[4][4], pp[4][4];
#pragma unroll
        for (int c = 0; c < 4; ++c) {
            float av[4], uv[4];
#pragma unroll
            for (int jj = 0; jj < 4; ++jj) {
                const float r = sigm(Da[c][jj] + ba4[c]), ig = sigm(Dx[c][jj] + bx4[c]);
                const float la = -r * sp4[c];
                float d = -la * (1.0f + la * (0.5f + la * (0.16666667f + la * (0.041666668f + la * (0.0083333338f + la * (0.0013888889f + la * 0.0001984127f))))));
                if (__builtin_expect(__any(la < -0.35f), 0)) { if (la < -0.35f) d = 1.0f - __builtin_amdgcn_exp2f(1.44269504f * la); }
                av[jj] = 1.0f - d;
                uv[jj] = __builtin_amdgcn_sqrtf(d * (2.0f - d)) * (ig * xd[jj][c]);
            }
            pp[c][0] = av[0]; hh[c][0] = uv[0];
#pragma unroll
            for (int jj = 1; jj < 4; ++jj) { hh[c][jj] = av[jj] * hh[c][jj - 1] + uv[jj]; pp[c][jj] = av[jj] * pp[c][jj - 1]; }
        }
        float Aq[4], Hq[4], Ax[4], Hx[4];
#pragma unroll
        for (int c = 0; c < 4; ++c) { Aq[c] = pp[c][3]; Hq[c] = hh[c][3]; }
#pragma unroll
        for (int c = 0; c < 4; ++c) { Ax[c] = __shfl_up(Aq[c], 16); Hx[c] = __shfl_up(Hq[c], 16); }
#pragma unroll
        for (int c = 0; c < 4; ++c) if (q >= 1) { Hq[c] = Aq[c] * Hx[c] + Hq[c]; Aq[c] = Aq[c] * Ax[c]; }
#pragma unroll
        for (int c = 0; c < 4; ++c) { Ax[c] = __shfl_up(Aq[c], 32); Hx[c] = __shfl_up(Hq[c], 32); }
#pragma unroll
        for (int c = 0; c < 4; ++c) if (q >= 2) { Hq[c] = Aq[c] * Hx[c] + Hq[c]; Aq[c] = Aq[c] * Ax[c]; }
        float A3[4], H3[4];
#pragma unroll
        for (int c = 0; c < 4; ++c) { Ax[c] = __shfl_up(Aq[c], 16); Hx[c] = __shfl_up(Hq[c], 16); A3[c] = __shfl(Aq[c], 48 + n); H3[c] = __shfl(Hq[c], 48 + n); }
#pragma unroll
        for (int c = 0; c < 4; ++c) {
            if (q == 0) { Ax[c] = 1.f; Hx[c] = 0.f; }
            const float cin = Hx[c] + Ax[c] * hin[c], pin = Ax[c] * atot[c];
#pragma unroll
            for (int jj = 0; jj < 4; ++jj) { hh[c][jj] = hh[c][jj] + pp[c][jj] * cin; pp[c][jj] = pp[c][jj] * pin; }
            hin[c] = H3[c] + A3[c] * hin[c]; atot[c] *= A3[c];
        }
#pragma unroll
        for (int jj = 0; jj < 4; ++jj) { const size_t o = ((size_t)(b * SEQ + t0 + 4 * q + jj)) * DRNN + cD; const u32x2 gw = gpre[jj];
            const float g0 = bf_lo(gw.x), g1 = bf_hi(gw.x), g2 = bf_lo(gw.y), g3 = bf_hi(gw.y);
            u32x2 oy; oy.x = cvt_pk_bf16(hh[0][jj] * g0, hh[1][jj] * g1); oy.y = cvt_pk_bf16(hh[2][jj] * g2, hh[3][jj] * g3); *(u32x2*)(P.GY + o) = oy;
            u32x2 op; op.x = cvt_pk_bf16(pp[0][jj] * g0, pp[1][jj] * g1); op.y = cvt_pk_bf16(pp[2][jj] * g2, pp[3][jj] * g3); *(u32x2*)(P.XR + o) = op; }
    }
    if (q == 0) { const size_t o = ((size_t)(b * NSEG + seg)) * DRNN + cD;
        *(f32x4*)(P.Atot + o) = (f32x4){atot[0], atot[1], atot[2], atot[3]}; *(f32x4*)(P.Hend + o) = (f32x4){hin[0], hin[1], hin[2], hin[3]}; }
}
__device__ __forceinline__ void rnn_apply(const RnnP& P, LAS float* cl, int b, int seg, int tid) {
    if (seg == 0) return;
    {
        float H[3] = {0.f, 0.f, 0.f};
        for (int s0 = 0; s0 < seg; s0 += 16) { float as[3][16], hs[3][16];
#pragma unroll
            for (int k = 0; k < 3; ++k) { const int c = tid + k * NWAVES * 64;
#pragma unroll
                for (int j = 0; j < 16; ++j) { const bool in = (s0 + j < seg) && (c < DRNN); const size_t o = ((size_t)(b * NSEG + (in ? s0 + j : 0))) * DRNN + (in ? c : 0); as[k][j] = in ? P.Atot[o] : 1.f; hs[k][j] = in ? P.Hend[o] : 0.f; } }
#pragma unroll
            for (int k = 0; k < 3; ++k)
#pragma unroll
                for (int j = 0; j < 16; ++j) H[k] = as[k][j] * H[k] + hs[k][j]; }
#pragma unroll
        for (int k = 0; k < 3; ++k) { const int c = tid + k * NWAVES * 64; if (c < DRNN) cl[c] = H[k]; }
    }
    __syncthreads();
    for (int i = tid; i < 64 * (DRNN / 8); i += NWAVES * 64) { const int r = i / (DRNN / 8), ch = (i % (DRNN / 8)) * 8; const size_t o = ((size_t)(b * SEQ + seg * 64 + r)) * DRNN + ch;
        const u32x4 y = *(const u32x4*)(P.GY + o), p = *(const u32x4*)(P.XR + o); const f32x4 c0 = *(const LAS f32x4*)(cl + ch), c1 = *(const LAS f32x4*)(cl + ch + 4);
        u32x4 w; w.x = cvt_pk_bf16(bf_lo(y.x) + bf_lo(p.x) * c0[0], bf_hi(y.x) + bf_hi(p.x) * c0[1]); w.y = cvt_pk_bf16(bf_lo(y.y) + bf_lo(p.y) * c0[2], bf_hi(y.y) + bf_hi(p.y) * c0[3]);
        w.z = cvt_pk_bf16(bf_lo(y.z) + bf_lo(p.z) * c1[0], bf_hi(y.z) + bf_hi(p.z) * c1[1]); w.w = cvt_pk_bf16(bf_lo(y.w) + bf_lo(p.w) * c1[2], bf_hi(y.w) + bf_hi(p.w) * c1[3]);
        *(u32x4*)(P.GY + o) = w; }
    __syncthreads();
}
#define XB_TMO      128
#define XB_XCNT(j)  (256  + 64 * (j))
#define XB_XSUB(j)  (1280 + 64 * (j))
#define XB_XGEN(j)  (2304 + 64 * (j))
#define XB_TOP      3328
#define XB_TOPGEN   3392
#define XCD_BAR_WORDS 3456
#define XB_SPIN_CAP (1u << 18)

__device__ __forceinline__ unsigned xb_ld(unsigned* p)              { return __hip_atomic_load(p, __ATOMIC_RELAXED, __HIP_MEMORY_SCOPE_AGENT); }
__device__ __forceinline__ unsigned xb_add(unsigned* p, unsigned v) { return __hip_atomic_fetch_add(p, v, __ATOMIC_RELAXED, __HIP_MEMORY_SCOPE_AGENT); }
__device__ __forceinline__ unsigned xb_xcc_id() { return (unsigned)__builtin_amdgcn_s_getreg((3 << 11) | 20) & 0xFu; }
#define XB_SPIN(cond, bar) do { unsigned _sp = 0; while (cond) { __builtin_amdgcn_s_sleep(1); \
    if ((++_sp & 255u) == 0u) { if (xb_ld(&(bar)[XB_TMO])) break; if (_sp > XB_SPIN_CAP) { atomicAdd(&(bar)[XB_TMO], 1u); break; } } } } while (0)

struct XcdBarrier {
    unsigned* bar; unsigned x;
    volatile LAS unsigned* st;
};

__device__ __forceinline__ XcdBarrier xcd_barrier_post(unsigned* bar, volatile LAS unsigned* st) {
    XcdBarrier b; b.bar = bar; b.x = xb_xcc_id(); b.st = st;
    if (threadIdx.x == 0) (void)xb_add(&bar[XB_XCNT(b.x)], 1u);
    return b;
}
__device__ __forceinline__ void xcd_barrier_complete(unsigned* bar, unsigned x, unsigned& nloc, unsigned& nx) {
    const unsigned G = gridDim.x * gridDim.y * gridDim.z;
    unsigned sum, cnt, mine, sp = 0u;
    for (;;) {
        sum = 0u; cnt = 0u; mine = 0u;
#pragma unroll
        for (unsigned j = 0; j < 16; ++j) { const unsigned c = xb_ld(&bar[XB_XCNT(j)]); sum += c; cnt += (c > 0u) ? 1u : 0u; mine = (j == x) ? c : mine; }
        if (sum == G) break;
        __builtin_amdgcn_s_sleep(1);
        if ((++sp & 255u) == 0u) { if (xb_ld(&bar[XB_TMO])) break; if (sp > XB_SPIN_CAP) { atomicAdd(&bar[XB_TMO], 1u); break; } }
    }
    nloc = mine > 0u ? mine : 1u; nx = cnt > 0u ? cnt : 1u;
}

__device__ __forceinline__ void xcd_barrier(const XcdBarrier& b) {
    asm volatile("s_waitcnt vmcnt(0)" ::: "memory");
    __syncthreads();
    if (threadIdx.x == 0) {
        unsigned* bar = b.bar;
        __builtin_amdgcn_s_waitcnt(0);
        unsigned nloc = b.st[0], nx = b.st[1];
        if (nloc == 0u) { xcd_barrier_complete(bar, b.x, nloc, nx); b.st[0] = nloc; b.st[1] = nx; }
        const unsigned old = xb_add(&bar[XB_XSUB(b.x)], 1u);
        const unsigned gen = old / nloc;
        if (old + 1u == (gen + 1u) * nloc) {
            __builtin_amdgcn_fence(__ATOMIC_RELEASE, "agent");
            asm volatile("s_waitcnt vmcnt(0)" ::: "memory");
            const unsigned og = xb_add(&bar[XB_TOP], 1u);
            const unsigned tg = og / nx;
            if (og + 1u == (tg + 1u) * nx) xb_add(&bar[XB_TOPGEN], 1u);
            else XB_SPIN(xb_ld(&bar[XB_TOPGEN]) == tg, bar);
            __builtin_amdgcn_fence(__ATOMIC_ACQUIRE, "agent");
            asm volatile("s_waitcnt vmcnt(0)" ::: "memory");
        } else {
            XB_SPIN(xb_ld(&bar[XB_TOPGEN]) == gen, bar);
            __builtin_amdgcn_fence(__ATOMIC_ACQUIRE, "agent");
            asm volatile("s_waitcnt vmcnt(0)" ::: "memory");
        }
    }
    __syncthreads();
}
#ifndef PH_HI
#define PH_HI NPHASE
#endif
#ifndef PH_MASK
#define PH_MASK 511
#endif

struct P3Sched {
    pg8::StaticOrder S0; const bf16 *XB, *WG, *YA, *WA, *YB, *WB;
    __device__ __forceinline__ bool next(int i, pg8::UnitX& u) const { pg8::Unit t; if (!S0.next(i >> 2, t)) return false; const int s = i & 3; u.pm = t.pm; u.pn = t.pn; u.kind = s;
        if (s == 0) { u.A = XB; u.Bt = WG; u.K = D; } else if (s == 1) { u.A = YA; u.Bt = WA; u.K = DRNN; } else if (s == 2) { u.A = XB; u.Bt = WG + (size_t)D * D; u.K = D; } else { u.A = YB; u.Bt = WB; u.K = D; }
        return true; }
    __device__ __forceinline__ void a_ready(const pg8::UnitX&) const {}
    __device__ __forceinline__ void done(const pg8::UnitX&) const {}
};
struct EpiP3 {
    static constexpr bool PERM = true, AFTER_DRAIN = false;
    pg8::EpiGate8 ga, gb; pg8::EpiMix<false> ma; pg8::EpiMix<true> mb;
    __device__ __forceinline__ void operator()(const pg8::f32x4 (&acc)[2][2][4][2], const pg8::UnitX& u, int wr, int wc, int fr, int fq) const {
        const pg8::Unit t{u.pm, u.pn};
        if (u.kind == 0) ga(acc, t, wr, wc, fr, fq); else if (u.kind == 1) ma(acc, t, wr, wc, fr, fq); else if (u.kind == 2) gb(acc, t, wr, wc, fr, fq); else mb(acc, t, wr, wc, fr, fq);
    }
};

__global__ void __launch_bounds__(NWAVES * 64, 2) fwd_megakernel(Args a) {
    extern __shared__ __attribute__((aligned(16))) unsigned char lds_raw[];
    LAS unsigned char* lds = (LAS unsigned char*)lds_raw;
    cg::grid_group grid = cg::this_grid();
    { LAS unsigned* z = (LAS unsigned*)(lds + 131072); if (threadIdx.x < 64) z[threadIdx.x] = 0u; }
    if (blockIdx.x == 0) { unsigned* bw = (unsigned*)(*(unsigned char* const __attribute__((address_space(4)))*)((kptr_t)__builtin_amdgcn_kernarg_segment_ptr() + 176) + WS_BAR);
        for (int i = threadIdx.x; i < XCD_BAR_WORDS; i += NWAVES * 64) __hip_atomic_store(bw + i, 0u, __ATOMIC_RELAXED, __HIP_MEMORY_SCOPE_AGENT);
        __builtin_amdgcn_fence(__ATOMIC_RELEASE, "agent"); asm volatile("s_waitcnt vmcnt(0)" ::: "memory"); }
    __syncthreads();
    grid.sync();
    (void)xcd_barrier_post((unsigned*)(*(unsigned char* const __attribute__((address_space(4)))*)((kptr_t)__builtin_amdgcn_kernarg_segment_ptr() + 176) + WS_BAR), (volatile LAS unsigned*)(lds + 131072 + 32));
    int tid = threadIdx.x, G = gridDim.x, bx = blockIdx.x;
    kptr_t kp = (kptr_t)__builtin_amdgcn_kernarg_segment_ptr();
    unsigned char* ws = *(unsigned char* const __attribute__((address_space(4)))*)(kp + 176);
    float* const outp = *(float* const __attribute__((address_space(4)))*)(kp + 168);
    const int ph_lo = *(const int __attribute__((address_space(4)))*)(kp + 184), ph_hi = *(const int __attribute__((address_space(4)))*)(kp + 188);
#define REFRESH_PTRS() asm volatile("" : "+s"(ws), "+s"(kp))
    float* ssq = (float*)(ws + WS_SSQ); float* vst = (float*)(ws + WS_VST);
    bf16* XB = (bf16*)(ws + WS_XB); bf16* XR = (bf16*)(ws + WS_XR); bf16* GR = (bf16*)(ws + WS_GR); bf16* U = (bf16*)(ws + WS_U); bf16* V = (bf16*)(ws + WS_V);
    bf16* F = (bf16*)(ws + WS_F); bf16* S1 = (bf16*)(ws + WS_S1); bf16* S2 = (bf16*)(ws + WS_S2);

    for (int ph = ph_lo; ph < ph_hi; ++ph) {
        if (ph > ph_lo) { XcdBarrier bar; bar.bar = (unsigned*)(ws + WS_BAR); bar.x = xb_xcc_id(); bar.st = (volatile LAS unsigned*)(lds + 131072 + 32); xcd_barrier(bar); }
#ifdef TS_SEL
        if (blockIdx.x == 0 && threadIdx.x == 0) ((unsigned long long*)(ws + WS_TS))[ph] = __builtin_amdgcn_s_memrealtime();
        if (ph == NPHASE - 1) { XcdBarrier bar; bar.bar = (unsigned*)(ws + WS_BAR); bar.x = xb_xcc_id(); bar.st = (volatile LAS unsigned*)(lds + 131072 + 32); xcd_barrier(bar); }
#endif
        asm volatile("" : "+s"(ws)); asm volatile("" : "+s"(kp)); asm volatile("" : "+v"(tid)); asm volatile("" : "+s"(G)); asm volatile("" : "+s"(bx));
        const int lane = tid & 63, wave = __builtin_amdgcn_readfirstlane(tid >> 6);
        const int vcu = (G % 8 == 0) ? (bx % 8) * (G / 8) + bx / 8 : bx;
        const int gw = vcu * NWAVES + wave, NGW = G * NWAVES;
        ssq = (float*)(ws + WS_SSQ); vst = (float*)(ws + WS_VST); XB = (bf16*)(ws + WS_XB); XR = (bf16*)(ws + WS_XR); GR = (bf16*)(ws + WS_GR); U = (bf16*)(ws + WS_U); V = (bf16*)(ws + WS_V);
        F = (bf16*)(ws + WS_F); S1 = (bf16*)(ws + WS_S1); S2 = (bf16*)(ws + WS_S2);
        if (ph == 0) { if (PH_MASK & 256) p0_prologue(kp, ws, lds, gw, NGW, wave, lane); continue; }
        if (ph == NPHASE - 1) {
            const float* gf = AIN(kp, I_FNG);
            for (int m = gw; m < M; m += NGW) { f32x4* xr = (f32x4*)(outp + (size_t)m * D) + lane; const u32x2* xbr = (const u32x2*)(XB + (size_t)m * D) + lane; f32x4 v[4]; float s = 0.f;
#pragma unroll
                for (int j = 0; j < 4; ++j) { const u32x2 w = xbr[64 * j]; v[j] = (f32x4){bf_lo(w.x), bf_hi(w.x), bf_lo(w.y), bf_hi(w.y)}; s += (v[j].x * v[j].x + v[j].y * v[j].y) + (v[j].z * v[j].z + v[j].w * v[j].w); }
                const float rs = __builtin_amdgcn_rsqf(wave_sum(s) * (1.0f / 1024.0f) + pg8::RMS_EPS);
#pragma unroll
                for (int j = 0; j < 4; ++j) { const f32x4 g4 = *((const f32x4*)gf + lane + 64 * j); f32x4 o = v[j] * rs * g4;
#ifdef TS_SEL
                    { const unsigned long long* ts = (const unsigned long long*)(ws + WS_TS); unsigned long long sel = 0; const int ids[] = TS_SEL;
                      for (unsigned k = 0; k < sizeof(ids) / sizeof(int); ++k) sel += ts[ids[k] + 1] - ts[ids[k]];
                      const float frac = (float)sel / (float)(ts[NPHASE - 1] - ts[0]), dlt = 0.02f * sqrtf(frac); o += (f32x4){dlt, -dlt, dlt, -dlt}; }
#endif
                    xr[64 * j] = o; } }
            continue;
        }
        const int l = (ph - 1) / 7, sub = (ph - 1) % 7;
        const unsigned char* wl = ws + WS_W + (size_t)l * W_LAYER;
        if (sub == 0 && (PH_MASK & 1)) {
            pg8::Gemm g{XB, (const bf16*)(wl + W_IN), M, NP1, D}; pg8::StaticOrder S; S.init(M, NP1, G, bx);
            pg8::EpiIn E{XR, GR, U, V, (bf16*)(ws + WS_HALO), ssq + (2 * l) * M, vst + (2 * l) * M, vst + (2 * l + 1) * M};
            pg8::gemm_phase<pg8::EpiIn, pg8::StaticOrder, true, true>(lds, g, S, E, tid);
            {
                const int rounds = (S.nwg + G - 1) / G, nidle = rounds * G - S.nwg, first_idle = G - nidle;
                const bool all = (nidle == 0); const int cg = all ? gw : (bx - first_idle) * NWAVES + wave, cn = all ? NGW : nidle * NWAVES;
                if (all || bx >= first_idle) { LAS float* scr = (LAS float*)(lds + wave * 16384);
                    convert_layer(kp, ws, l, CVT_WIN, CVT_ALL, scr, cg, cn, lane);
                    if (l + 1 < DEPTH) convert_layer(kp, ws, l + 1, 0, CVT_WIN, scr, cg, cn, lane); }
            }
        }
#ifdef NAIVE_MIX
        else if (sub == 1) { naive_vstats(V, vst + (2 * l) * M, vst + (2 * l + 1) * M, gw, NGW, lane); }
        else if (sub == 2) {
            naive_sgu(V, U, AIN(kp, I_WS) + (size_t)l * 8 * 128 * 128, AIN(kp, I_BS) + l * 1024, AIN(kp, I_LNG) + l * 1024, AIN(kp, I_LNB) + l * 1024, vst + (2 * l) * M, vst + (2 * l + 1) * M, gw * 64 + lane, NGW * 64);
            naive_rnn(XR, GR, AIN(kp, I_LWA) + (size_t)l * NH * 4096, AIN(kp, I_LWX) + (size_t)l * NH * 4096, AIN(kp, I_LBA) + l * DRNN, AIN(kp, I_LBX) + l * DRNN, AIN(kp, I_LAM) + l * DRNN, AIN(kp, I_CW) + l * 4 * DRNN, AIN(kp, I_CB) + l * DRNN, gw, NGW, lane);
        }
#endif
        else if (sub == 1 && (PH_MASK & 2)) {
            SguP P{V, U, (const bf16*)(wl + W_S), AIN(kp, I_BS) + l * 1024, AIN(kp, I_LNG) + l * 1024, AIN(kp, I_LNB) + l * 1024, vst + (2 * l) * M, vst + (2 * l + 1) * M};
            { LAS unsigned char* raw = lds + 32768; if (vcu < BATCH * 32 * 8) sgu_dma(P, raw, vcu, wave, lane);
              for (int it = vcu; it < BATCH * 32 * 8; it += G) sgu_item(P, lds, raw, (it + G < BATCH * 32 * 8) ? it + G : -1, it >> 8, (it >> 3) & 31, it & 7, tid, wave, lane);
              __syncthreads(); }
            RnnP R{XR, GR, (const bf16*)(ws + WS_HALO), (const bf16*)(wl + W_L), AIN(kp, I_CW) + l * 4 * DRNN, AIN(kp, I_CB) + l * DRNN, AIN(kp, I_LBA) + l * DRNN, AIN(kp, I_LBX) + l * DRNN, AIN(kp, I_LAM) + l * DRNN,
                   (float*)(ws + WS_ATOT), (float*)(ws + WS_HEND)};
            LAS float* xl = (LAS float*)(lds + 40960 + wave * 6144);
            { const int per = (BATCH * NH * NSEG + G - 1) / G, base = vcu * per, lim = min(base + per, BATCH * NH * NSEG);
              for (int j = wave; j < per; j += NWAVES) { const int it = base + j; if (it < lim) rnn_item(R, xl, (it / NH) % BATCH, it % NH, it / (NH * BATCH), lane); } }
        } else if (sub == 2 && (PH_MASK & 4)) {
            RnnP R{XR, GR, (const bf16*)(ws + WS_HALO), (const bf16*)(wl + W_L), AIN(kp, I_CW) + l * 4 * DRNN, AIN(kp, I_CB) + l * DRNN, AIN(kp, I_LBA) + l * DRNN, AIN(kp, I_LBX) + l * DRNN, AIN(kp, I_LAM) + l * DRNN,
                   (float*)(ws + WS_ATOT), (float*)(ws + WS_HEND)};
            for (int it = vcu; it < BATCH * NSEG; it += G) rnn_apply(R, (LAS float*)lds, it / NSEG, it % NSEG, tid);
        } else if (sub == 3 && (PH_MASK & 8)) {
            pg8::StaticOrder S; S.init(M, D, G, bx);
            unsigned char* G8 = (unsigned char*)outp;
            P3Sched PS{S, XB, (const bf16*)(wl + W_G), GR, (const bf16*)(wl + W_A), U, (const bf16*)(wl + W_B)};
            EpiP3 E{pg8::EpiGate8{G8, ssq + (2 * l) * M}, pg8::EpiGate8{G8 + (size_t)M * D, ssq + (2 * l) * M}, pg8::EpiMix<false>{S1, G8}, pg8::EpiMix<true>{S1, G8 + (size_t)M * D}};
            pg8::gemm_phase_multi<EpiP3, P3Sched, true, true>(lds, PS, E, tid);
        } else if (sub == 4 && (PH_MASK & 16)) {
            pg8::Gemm g{S1, (const bf16*)(wl + W_O), M, D, D}; pg8::StaticOrder S; S.init(M, D, G, bx);
            pg8::EpiRes E{XB, ssq + (2 * l + 1) * M};
            pg8::gemm_phase<pg8::EpiRes, pg8::StaticOrder, true, true>(lds, g, S, E, tid);
        } else if (sub == 5 && (PH_MASK & 32)) {
            pg8::Gemm g{XB, (const bf16*)(wl + W_UP), M, FF, D}; pg8::StaticOrder S; S.init(M, FF, G, bx);
            pg8::EpiAct<1> E{F, FF, ssq + (2 * l + 1) * M};
            pg8::gemm_phase<pg8::EpiAct<1>, pg8::StaticOrder, true, true>(lds, g, S, E, tid);
        } else if (PH_MASK & 64) {
            pg8::Gemm g{F, (const bf16*)(wl + W_DN), M, D, FF}; pg8::StaticOrder S; S.init(M, D, G, bx);
            pg8::EpiRes E{XB, ssq + (2 * l + 2) * M};
            pg8::gemm_phase<pg8::EpiRes, pg8::StaticOrder, true, true>(lds, g, S, E, tid);
        }
    }
}

extern "C" void kernel_launch(void* const* d_in, const int* in_sizes, int n_in, void* d_out, int out_size, void* d_ws, size_t ws_size, hipStream_t stream) {
    static int grid = 0;
    if (grid == 0) {
        if (n_in != 21 || out_size != M * D || ws_size < WS_END) { fprintf(stderr, "kernel_launch: unexpected shapes (n_in %d, out %d, ws %zu); nothing launched\n", n_in, out_size, ws_size); grid = -1; return; }
        int dev = 0, cus = 0, per_cu = 0;
        if (hipGetDevice(&dev) != hipSuccess || hipDeviceGetAttribute(&cus, hipDeviceAttributeMultiprocessorCount, dev) != hipSuccess) { grid = -1; return; }
        if (hipFuncSetAttribute((const void*)fwd_megakernel, hipFuncAttributeMaxDynamicSharedMemorySize, LDS_BYTES) != hipSuccess) { fprintf(stderr, "kernel_launch: hipFuncSetAttribute failed\n"); grid = -1; return; }
        if (hipOccupancyMaxActiveBlocksPerMultiprocessor(&per_cu, (const void*)fwd_megakernel, NWAVES * 64, LDS_BYTES) != hipSuccess || per_cu < 1) per_cu = 1;
        (void)hipGetLastError();
        grid = cus * per_cu;
        fprintf(stderr, "kernel_launch: %d CUs x %d -> grid %d, ws %zu\n", cus, per_cu, grid, ws_size);
    }
    if (grid < 0) return;
#ifdef EXP_POISON
    (void)hipMemsetAsync(d_ws, 0xAA, WS_END, stream); (void)hipMemsetAsync(d_out, 0xAA, (size_t)M * D * 4, stream);
#endif
    Args a{};
    for (int i = 0; i < 21; ++i) a.in[i] = (const float*)d_in[i];
    a.out = (float*)d_out; a.ws = (unsigned char*)d_ws; a.ph_lo = 0; a.ph_hi = PH_HI;
    void* args[] = {&a};
    const hipError_t e = hipLaunchCooperativeKernel((const void*)fwd_megakernel, dim3(grid), dim3(NWAVES * 64), args, LDS_BYTES, stream);
    if (e != hipSuccess) fprintf(stderr, "kernel_launch: cooperative launch failed: %s (grid %d)\n", hipGetErrorString(e), grid);
}
```

```cpp
#include <hip/hip_runtime.h>
#include <hip/hip_cooperative_groups.h>
#include <cstdio>
#include <cstdint>
namespace cg = cooperative_groups;
namespace pg8 {
#define PG8_LAS __attribute__((address_space(3)))
typedef unsigned short bf16_t;
typedef short bf16x8 __attribute__((ext_vector_type(8)));
typedef float f32x4 __attribute__((ext_vector_type(4)));
typedef unsigned u32x4 __attribute__((ext_vector_type(4)));
typedef unsigned u32x2 __attribute__((ext_vector_type(2)));
constexpr int BM = 256, BK = 64, HALF = 128, HTB = HALF * BK * 2, STAGE_BYTES = 8 * HTB, NXCD = 8, WGM = 4;
__host__ __device__ __forceinline__ int lds_byte(int r, int c) { const int st = (r >> 4) * 2 + (c >> 5), rr = r & 15, cc = c & 31, ob = rr * 64 + cc * 2; return st * 1024 + (ob ^ (((ob >> 9) & 1) << 5)); }
__host__ __device__ __forceinline__ void stage_rc(int b, int& R, int& C) { const int st = b / 1024, sb = b % 1024, swz = sb ^ (((sb >> 9) & 1) << 5); R = (st >> 1) * 16 + swz / 64; C = (st & 1) * 32 + (swz % 64) / 2; }
__host__ __device__ __forceinline__ int perm32(int rho) { const int n = rho >> 4, i = rho & 15; return 8 * (i >> 2) + 4 * n + (i & 3); }
struct Unit { int pm, pn; };
struct Gemm { const bf16_t* A; const bf16_t* Bt; int M, N, K; };
struct StaticOrder {
    int nM, nN, nwg, G, c;
    __host__ __device__ void init(int M, int N, int G_, int c_) { nM = M / BM; nN = N / BM; nwg = nM * nN; G = G_; c = c_; }
    __host__ __device__ bool next(int i, Unit& u) const {
        const long L = (long)i * G + c; if (L >= nwg) return false;
        int wgid = (int)L; { const int q = nwg / NXCD, r = nwg % NXCD, xcd = wgid % NXCD, off = wgid / NXCD; wgid = (xcd < r ? xcd * (q + 1) : r * (q + 1) + (xcd - r) * q) + off; }
        const int nig = WGM * nN, gid = wgid / nig, fm = gid * WGM, gsz = (nM - fm) < WGM ? (nM - fm) : WGM;
        u.pm = fm + ((wgid % nig) % gsz); u.pn = (wgid % nig) / gsz; return true;
    }
    __device__ __forceinline__ void a_ready(const Unit&) const {}
    __device__ __forceinline__ void done(const Unit&) const {}
};

constexpr float RMS_EPS = 1e-6f;
__device__ __forceinline__ unsigned cvt_pk_bf16(float lo, float hi) { unsigned r; asm volatile("v_cvt_pk_bf16_f32 %0, %1, %2" : "=v"(r) : "v"(lo), "v"(hi)); return r; }
__device__ __forceinline__ float bf_lo(unsigned w) { return __uint_as_float(w << 16); }
__device__ __forceinline__ float bf_hi(unsigned w) { return __uint_as_float(w & 0xffff0000u); }
__device__ __forceinline__ float sigm(float x) { return __builtin_amdgcn_rcpf(1.0f + __builtin_amdgcn_exp2f(-1.44269504f * x)); }
__device__ __forceinline__ float gelu_t(float x) { const float z = x * (1.5957691216f + 0.0713548163f * x * x); return x * __builtin_amdgcn_rcpf(1.0f + __builtin_amdgcn_exp2f(-1.44269504f * z)); }
constexpr float FIX_SSQ = 4096.0f, FIX_V = 65536.0f;
__device__ __forceinline__ float unfix(float slot, float scale) { return (float)(int)__float_as_uint(slot) * (1.0f / scale); }
__device__ __forceinline__ float tofix(float v, float scale) { return __uint_as_float((unsigned)(int)__builtin_rintf(v * scale)); }
__device__ __forceinline__ float rstd_of(float ssq) { return __builtin_amdgcn_rsqf(unfix(ssq, FIX_SSQ) * (1.0f / 1024.0f) + RMS_EPS); }
__device__ __forceinline__ void fadd_fix(float* p, float v, float scale) { (void)__hip_atomic_fetch_add((unsigned*)p, (unsigned)(int)__builtin_rintf(v * scale), __ATOMIC_RELAXED, __HIP_MEMORY_SCOPE_AGENT); }

struct EpiIn {
    static constexpr bool PERM = true, AFTER_DRAIN = false;
    bf16_t* XR; bf16_t* GR; bf16_t* U; bf16_t* V; bf16_t* HALO; const float* ssq; float* vsum; float* vsq;
    __device__ __forceinline__ void operator()(const f32x4 (&acc)[2][2][4][2], const Unit& u, int wr, int wc, int fr, int fq) const {
        const int pn = u.pn; bf16_t* base; int ldc, colt, act;
        if (pn < 5) { base = XR; ldc = 1280; colt = pn * 256; act = 0; }
        else if (pn < 10) { base = GR; ldc = 1280; colt = (pn - 5) * 256; act = 1; }
        else if (pn < 14) { base = U; ldc = 1024; colt = (pn - 10) * 256; act = 1; }
        else { base = V; ldc = 1024; colt = (pn - 14) * 256; act = 2; }
        const int row0 = u.pm * BM + wr * 64 + fr, col0 = colt + wc * 32 + 8 * fq;
        float rs8[8];
#pragma unroll
        for (int i = 0; i < 8; ++i) rs8[i] = ssq[row0 + (i >> 2) * HALF + (i & 3) * 16];
        asm volatile("" ::: "memory");
#pragma unroll
        for (int ai = 0; ai < 2; ++ai)
#pragma unroll
            for (int m = 0; m < 4; ++m) {
                const int row = row0 + ai * HALF + m * 16; const float rs = rstd_of(rs8[ai * 4 + m]);
                bf16_t* rowp = base + (size_t)row * ldc + col0; float s1 = 0.f, s2 = 0.f;
#pragma unroll
                for (int bj = 0; bj < 2; ++bj) { f32x4 v0 = acc[ai][bj][m][0] * rs, v1 = acc[ai][bj][m][1] * rs;
                    if (act) {
#pragma unroll
                        for (int j = 0; j < 4; ++j) { v0[j] = gelu_t(v0[j]); v1[j] = gelu_t(v1[j]); } }
                    if (act == 2) {
#pragma unroll
                        for (int j = 0; j < 4; ++j) { s1 += v0[j] + v1[j]; s2 += v0[j] * v0[j] + v1[j] * v1[j]; } }
                    u32x4 w; w.x = cvt_pk_bf16(v0[0], v0[1]); w.y = cvt_pk_bf16(v0[2], v0[3]); w.z = cvt_pk_bf16(v1[0], v1[1]); w.w = cvt_pk_bf16(v1[2], v1[3]);
                    *(u32x4*)(rowp + bj * HALF) = w;
                    if (pn < 5 && m == 3 && fr >= 13) *(u32x4*)(HALO + ((size_t)(row >> 6) * 3 + (fr - 13)) * 1280 + col0 + bj * HALF) = w; }
                if (act == 2) { s1 += __shfl_xor(s1, 16); s1 += __shfl_xor(s1, 32); s2 += __shfl_xor(s2, 16); s2 += __shfl_xor(s2, 32);
                    if (fq == 0) { fadd_fix(vsum + row, s1, FIX_V); fadd_fix(vsq + row, s2, FIX_V); } }
            }
    }
};
template <int ACT> struct EpiAct {
    static constexpr bool PERM = true, AFTER_DRAIN = false;
    bf16_t* O; int ldc; const float* ssq;
    __device__ __forceinline__ void operator()(const f32x4 (&acc)[2][2][4][2], const Unit& u, int wr, int wc, int fr, int fq) const {
        const int row0 = u.pm * BM + wr * 64 + fr, col0 = u.pn * BM + wc * 32 + 8 * fq;
        float rs8[8];
#pragma unroll
        for (int i = 0; i < 8; ++i) rs8[i] = ssq[row0 + (i >> 2) * HALF + (i & 3) * 16];
        asm volatile("" ::: "memory");
#pragma unroll
        for (int ai = 0; ai < 2; ++ai)
#pragma unroll
            for (int m = 0; m < 4; ++m) {
                const int row = row0 + ai * HALF + m * 16; const float rs = rstd_of(rs8[ai * 4 + m]);
                bf16_t* rowp = O + (size_t)row * ldc + col0;
#pragma unroll
                for (int bj = 0; bj < 2; ++bj) { f32x4 v0 = acc[ai][bj][m][0] * rs, v1 = acc[ai][bj][m][1] * rs;
#pragma unroll
                    for (int j = 0; j < 4; ++j) {
                        if (ACT == 0) { v0[j] = sigm(v0[j]); v1[j] = sigm(v1[j]); }
                        else { const float a = fmaxf(v0[j], 0.f), b = fmaxf(v1[j], 0.f); v0[j] = a * a; v1[j] = b * b; } }
                    u32x4 w; w.x = cvt_pk_bf16(v0[0], v0[1]); w.y = cvt_pk_bf16(v0[2], v0[3]); w.z = cvt_pk_bf16(v1[0], v1[1]); w.w = cvt_pk_bf16(v1[2], v1[3]);
                    *(u32x4*)(rowp + bj * HALF) = w; }
            }
    }
};
struct EpiGate8 {
    static constexpr bool PERM = true, AFTER_DRAIN = false;
    unsigned char* G8; const float* ssq;
    __device__ __forceinline__ void operator()(const f32x4 (&acc)[2][2][4][2], const Unit& u, int wr, int wc, int fr, int fq) const {
        const int row0 = u.pm * BM + wr * 64 + fr, col0 = u.pn * BM + wc * 32 + 8 * fq;
#pragma unroll
        for (int ai = 0; ai < 2; ++ai)
#pragma unroll
            for (int m = 0; m < 4; ++m) {
                const int row = row0 + ai * HALF + m * 16; const float rs = rstd_of(ssq[row]);
                unsigned char* rowp = G8 + (size_t)row * 1024 + col0;
#pragma unroll
                for (int bj = 0; bj < 2; ++bj) { const f32x4 v0 = acc[ai][bj][m][0] * rs, v1 = acc[ai][bj][m][1] * rs; unsigned q[8];
#pragma unroll
                    for (int j = 0; j < 4; ++j) { q[j] = (unsigned)__builtin_rintf(255.0f * sigm(v0[j])); q[4 + j] = (unsigned)__builtin_rintf(255.0f * sigm(v1[j])); }
                    u32x2 w; w.x = q[0] | (q[1] << 8) | (q[2] << 16) | (q[3] << 24); w.y = q[4] | (q[5] << 8) | (q[6] << 16) | (q[7] << 24);
                    *(u32x2*)(rowp + bj * HALF) = w; }
            }
    }
};
template <bool ADD> struct EpiMix {
    static constexpr bool PERM = true, AFTER_DRAIN = false;
    bf16_t* O; const unsigned char* G8;
    __device__ __forceinline__ void operator()(const f32x4 (&acc)[2][2][4][2], const Unit& u, int wr, int wc, int fr, int fq) const {
        const int row0 = u.pm * BM + wr * 64 + fr, col0 = u.pn * BM + wc * 32 + 8 * fq;
#pragma unroll
        for (int ai = 0; ai < 2; ++ai)
#pragma unroll
            for (int m = 0; m < 4; ++m) {
                const size_t off = (size_t)(row0 + ai * HALF + m * 16) * 1024 + col0;
#pragma unroll
                for (int bj = 0; bj < 2; ++bj) { const u32x2 gq = *(const u32x2*)(G8 + off + bj * HALF); const f32x4 a0 = acc[ai][bj][m][0], a1 = acc[ai][bj][m][1];
                    const float k = 1.0f / 255.0f; f32x4 v0, v1;
                    v0[0] = (float)(gq.x & 255u) * k * a0[0]; v0[1] = (float)((gq.x >> 8) & 255u) * k * a0[1]; v0[2] = (float)((gq.x >> 16) & 255u) * k * a0[2]; v0[3] = (float)(gq.x >> 24) * k * a0[3];
                    v1[0] = (float)(gq.y & 255u) * k * a1[0]; v1[1] = (float)((gq.y >> 8) & 255u) * k * a1[1]; v1[2] = (float)((gq.y >> 16) & 255u) * k * a1[2]; v1[3] = (float)(gq.y >> 24) * k * a1[3];
                    if (ADD) { const u32x4 tw = *(const u32x4*)(O + off + bj * HALF);
                        v0[0] += bf_lo(tw.x); v0[1] += bf_hi(tw.x); v0[2] += bf_lo(tw.y); v0[3] += bf_hi(tw.y); v1[0] += bf_lo(tw.z); v1[1] += bf_hi(tw.z); v1[2] += bf_lo(tw.w); v1[3] += bf_hi(tw.w); }
                    u32x4 w; w.x = cvt_pk_bf16(v0[0], v0[1]); w.y = cvt_pk_bf16(v0[2], v0[3]); w.z = cvt_pk_bf16(v1[0], v1[1]); w.w = cvt_pk_bf16(v1[2], v1[3]);
                    *(u32x4*)(O + off + bj * HALF) = w; }
                asm volatile("" ::: "memory");
            }
    }
};
struct EpiRes {
    static constexpr bool PERM = true, AFTER_DRAIN = false;
    bf16_t* xb; float* ssq_out;
    __device__ __forceinline__ void operator()(const f32x4 (&acc)[2][2][4][2], const Unit& u, int wr, int wc, int fr, int fq) const {
        const int row0 = u.pm * BM + wr * 64 + fr, col0 = u.pn * BM + wc * 32 + 8 * fq;
#pragma unroll
        for (int ai = 0; ai < 2; ++ai)
#pragma unroll
            for (int m = 0; m < 4; ++m) {
                const int row = row0 + ai * HALF + m * 16; const size_t off = (size_t)row * 1024 + col0; float s = 0.f;
#pragma unroll
                for (int bj = 0; bj < 2; ++bj) { const u32x4 xw = *(const u32x4*)(xb + off + bj * HALF); const f32x4 a0 = acc[ai][bj][m][0], a1 = acc[ai][bj][m][1];
                    f32x4 v0, v1; v0[0] = bf_lo(xw.x) + a0[0]; v0[1] = bf_hi(xw.x) + a0[1]; v0[2] = bf_lo(xw.y) + a0[2]; v0[3] = bf_hi(xw.y) + a0[3];
                    v1[0] = bf_lo(xw.z) + a1[0]; v1[1] = bf_hi(xw.z) + a1[1]; v1[2] = bf_lo(xw.w) + a1[2]; v1[3] = bf_hi(xw.w) + a1[3];
                    u32x4 w; w.x = cvt_pk_bf16(v0[0], v0[1]); w.y = cvt_pk_bf16(v0[2], v0[3]); w.z = cvt_pk_bf16(v1[0], v1[1]); w.w = cvt_pk_bf16(v1[2], v1[3]);
                    *(u32x4*)(xb + off + bj * HALF) = w;
                    s += (v0[0] * v0[0] + v0[1] * v0[1]) + (v0[2] * v0[2] + v0[3] * v0[3]) + (v1[0] * v1[0] + v1[1] * v1[1]) + (v1[2] * v1[2] + v1[3] * v1[3]); }
                s += __shfl_xor(s, 16); s += __shfl_xor(s, 32);
                if (fq == 0) fadd_fix(ssq_out + row, s, FIX_SSQ);
                asm volatile("" ::: "memory");
            }
    }
};
template <class Epi, class Sched, bool ALIGN_EPI = false, bool SP2 = false>
__device__ __forceinline__ void gemm_phase(PG8_LAS unsigned char* lds, const Gemm g, const Sched& S, const Epi& E, const int tid) {
    const int wid = __builtin_amdgcn_readfirstlane(tid >> 6), lane = tid & 63, wr = wid >> 2, wc = wid & 3, fr = lane & 15, fq = lane >> 4;
    const int K = g.K, nt = K / BK;
    unsigned voffA[2], voffB[2];
#pragma unroll
    for (int i = 0; i < 2; ++i) { int R, C; stage_rc(tid * 16 + i * 8192, R, C); const int Rb = Epi::PERM ? ((R & ~31) + perm32(R & 31)) : R;
        voffA[i] = (unsigned)(R * K + C) * 2u; voffB[i] = (unsigned)(Rb * K + C) * 2u; }
    const size_t kstep = (size_t)(BK * 2);
    const size_t hstep = (size_t)HALF * K * 2;
    const size_t tstep = 2 * hstep;
    const unsigned ldsw = (unsigned)wid * 1024u;
    const int aoff = lds_byte(wr * 64 + fr, fq * 8), boff = lds_byte(wc * 32 + fr, fq * 8);
#define PG8_SA(b, h) (((b) * 2 + (h)) * HTB)
#define PG8_SB(b, h) ((4 + (b) * 2 + (h)) * HTB)
#define PG8_STAGE(bufoff, gbase, voff) do { _Pragma("unroll") for (int _i = 0; _i < 2; ++_i) \
        __builtin_amdgcn_global_load_lds((const unsigned*)((const char*)(gbase) + (voff)[_i]), (PG8_LAS unsigned*)(lds + (bufoff) + ldsw + _i * 8192), 16, 0, 0); } while (0)
#define PG8_LDA(dst, b, h) do { _Pragma("unroll") for (int m = 0; m < 4; ++m) _Pragma("unroll") for (int k = 0; k < 2; ++k) dst[m][k] = *(const PG8_LAS bf16x8*)(lds + PG8_SA(b, h) + aoff + m * 2048 + k * 1024); } while (0)
#define PG8_LDB(dst, b, h) do { _Pragma("unroll") for (int n = 0; n < 2; ++n) _Pragma("unroll") for (int k = 0; k < 2; ++k) dst[n][k] = *(const PG8_LAS bf16x8*)(lds + PG8_SB(b, h) + boff + n * 2048 + k * 1024); } while (0)
#define PG8_MMA(ai, bj, At, Bt) do { __builtin_amdgcn_s_setprio(1); _Pragma("unroll") for (int m = 0; m < 4; ++m) _Pragma("unroll") for (int n = 0; n < 2; ++n) _Pragma("unroll") for (int k = 0; k < 2; ++k) \
        acc[ai][bj][m][n] = __builtin_amdgcn_mfma_f32_16x16x32_bf16(Bt[n][k], At[m][k], acc[ai][bj][m][n], 0, 0, 0); __builtin_amdgcn_s_setprio(0); } while (0)
#define PG8_WAIT_V(n) asm volatile("s_waitcnt vmcnt(" #n ")" ::: "memory")
#define PG8_WAIT_L(n) asm volatile("s_waitcnt lgkmcnt(" #n ")" ::: "memory")
#define PG8_BAR __builtin_amdgcn_s_barrier()
#define PG8_SCHED __builtin_amdgcn_sched_barrier(0)
    Unit cur, nxt; int ui = 0;
    if (!S.next(0, cur)) return;
    f32x4 acc[2][2][4][2];
#pragma unroll
    for (int a = 0; a < 2; ++a)
#pragma unroll
        for (int b = 0; b < 2; ++b)
#pragma unroll
            for (int m = 0; m < 4; ++m)
#pragma unroll
                for (int n = 0; n < 2; ++n) acc[a][b][m][n] = (f32x4){0.f, 0.f, 0.f, 0.f};
    bf16x8 At[4][2], B0[2][2], B1[2][2];
    const char* cA = (const char*)g.A + (size_t)cur.pm * tstep; const char* cB = (const char*)g.Bt + (size_t)cur.pn * tstep;
    S.a_ready(cur);
    if constexpr (SP2) {
        PG8_STAGE(PG8_SB(0, 0), cB, voffB); PG8_STAGE(PG8_SB(0, 1), cB + hstep, voffB); PG8_STAGE(PG8_SA(0, 0), cA, voffA); PG8_STAGE(PG8_SA(0, 1), cA + hstep, voffA);
        if (wr == 1) PG8_BAR;
        PG8_WAIT_V(2); PG8_BAR;
        PG8_STAGE(PG8_SB(1, 0), cB + kstep, voffB); PG8_STAGE(PG8_SA(1, 0), cA + kstep, voffA); PG8_STAGE(PG8_SB(1, 1), cB + hstep + kstep, voffB);
        PG8_WAIT_V(6); PG8_BAR;
    } else {
        PG8_STAGE(PG8_SB(0, 0), cB, voffB); PG8_STAGE(PG8_SA(0, 0), cA, voffA); PG8_STAGE(PG8_SB(0, 1), cB + hstep, voffB); PG8_STAGE(PG8_SA(0, 1), cA + hstep, voffA);
        if (wr == 1) PG8_BAR;
        PG8_WAIT_V(4); PG8_BAR;
        PG8_STAGE(PG8_SB(1, 0), cB + kstep, voffB); PG8_STAGE(PG8_SA(1, 0), cA + kstep, voffA); PG8_STAGE(PG8_SB(1, 1), cB + hstep + kstep, voffB);
        PG8_WAIT_V(6); PG8_BAR;
    }
    for (;;) {
        const bool has_next = S.next(ui + 1, nxt);
        const char* nA = has_next ? (const char*)g.A + (size_t)nxt.pm * tstep : cA; const char* nB = has_next ? (const char*)g.Bt + (size_t)nxt.pn * tstep : cB;
        for (int t = 0; t < nt; t += 2) {
            const bool last = (t == nt - 2);
            const char* a1 = cA + (size_t)(t + 1) * kstep;
            const char* a2 = last ? nA : cA + (size_t)(t + 2) * kstep; const char* b2 = last ? nB : cB + (size_t)(t + 2) * kstep;
            const char* a3 = a2 + kstep; const char* b3 = b2 + kstep;
            if (last && has_next) S.a_ready(nxt);
            if constexpr (SP2) {
            PG8_LDB(B0, 0, 0); PG8_LDB(B1, 0, 1); PG8_SCHED; PG8_LDA(At, 0, 0); PG8_STAGE(PG8_SA(1, 1), a1 + hstep, voffA);
            PG8_WAIT_V(8); PG8_WAIT_L(0); PG8_BAR; PG8_MMA(0, 0, At, B0); PG8_MMA(0, 1, At, B1); PG8_BAR; PG8_SCHED;
            PG8_LDA(At, 0, 1); PG8_STAGE(PG8_SB(0, 0), b2, voffB); PG8_STAGE(PG8_SB(0, 1), b2 + hstep, voffB); PG8_STAGE(PG8_SA(0, 0), a2, voffA);
            PG8_WAIT_V(8); PG8_WAIT_L(0); PG8_BAR; PG8_MMA(1, 0, At, B0); PG8_MMA(1, 1, At, B1); PG8_BAR; PG8_SCHED;
            PG8_LDB(B0, 1, 0); PG8_LDB(B1, 1, 1); PG8_SCHED; PG8_LDA(At, 1, 0); PG8_STAGE(PG8_SA(0, 1), a2 + hstep, voffA);
            PG8_WAIT_V(8); PG8_WAIT_L(0); PG8_BAR; PG8_MMA(0, 0, At, B0); PG8_MMA(0, 1, At, B1); PG8_BAR; PG8_SCHED;
            PG8_LDA(At, 1, 1); PG8_STAGE(PG8_SB(1, 0), b3, voffB); PG8_STAGE(PG8_SB(1, 1), b3 + hstep, voffB); PG8_STAGE(PG8_SA(1, 0), a3, voffA);
            PG8_WAIT_V(8); PG8_WAIT_L(0); PG8_BAR; PG8_MMA(1, 0, At, B0); PG8_MMA(1, 1, At, B1); PG8_BAR; PG8_SCHED;
            } else {
            PG8_LDB(B0, 0, 0); PG8_SCHED; PG8_LDA(At, 0, 0); PG8_STAGE(PG8_SA(1, 1), a1 + hstep, voffA);
            PG8_WAIT_L(8); PG8_BAR; PG8_WAIT_L(0); PG8_MMA(0, 0, At, B0); PG8_BAR; PG8_SCHED;
            PG8_LDB(B1, 0, 1); PG8_STAGE(PG8_SB(0, 0), b2, voffB);
            PG8_BAR; PG8_WAIT_L(0); PG8_MMA(0, 1, At, B1); PG8_BAR;
            PG8_LDA(At, 0, 1); PG8_STAGE(PG8_SA(0, 0), a2, voffA);
            PG8_BAR; PG8_WAIT_L(0); PG8_MMA(1, 0, At, B0); PG8_BAR; PG8_SCHED;
            PG8_STAGE(PG8_SB(0, 1), b2 + hstep, voffB);
            PG8_WAIT_V(6); PG8_BAR; PG8_MMA(1, 1, At, B1); PG8_BAR;
            PG8_LDB(B0, 1, 0); PG8_SCHED; PG8_LDA(At, 1, 0); PG8_STAGE(PG8_SA(0, 1), a2 + hstep, voffA);
            PG8_WAIT_L(8); PG8_BAR; PG8_WAIT_L(0); PG8_MMA(0, 0, At, B0); PG8_BAR; PG8_SCHED;
            PG8_LDB(B1, 1, 1); PG8_STAGE(PG8_SB(1, 0), b3, voffB);
            PG8_BAR; PG8_WAIT_L(0); PG8_MMA(0, 1, At, B1); PG8_BAR;
            PG8_LDA(At, 1, 1); PG8_STAGE(PG8_SA(1, 0), a3, voffA);
            PG8_BAR; PG8_WAIT_L(0); PG8_MMA(1, 0, At, B0); PG8_BAR; PG8_SCHED;
            PG8_STAGE(PG8_SB(1, 1), b3 + hstep, voffB);
            PG8_WAIT_V(6); PG8_BAR; PG8_MMA(1, 1, At, B1); PG8_BAR;
            }
        }
        if constexpr (ALIGN_EPI) { if (wr == 0) PG8_BAR; }
        if constexpr (!Epi::AFTER_DRAIN) { E(acc, cur, wr, wc, fr, fq); S.done(cur); }
        if (!has_next) break;
#pragma unroll
        for (int a = 0; a < 2; ++a)
#pragma unroll
            for (int b = 0; b < 2; ++b)
#pragma unroll
                for (int m = 0; m < 4; ++m)
#pragma unroll
                    for (int n = 0; n < 2; ++n) acc[a][b][m][n] = (f32x4){0.f, 0.f, 0.f, 0.f};
        cur = nxt; cA = nA; cB = nB; ++ui;
        if constexpr (ALIGN_EPI) { if (wr == 1) PG8_BAR; }
    }
    PG8_WAIT_V(0);
    if constexpr (!ALIGN_EPI) { if (wr == 0) PG8_BAR; }
    PG8_BAR;
    if constexpr (Epi::AFTER_DRAIN) { E.fused(acc, cur, wr, wc, fr, fq, lds, wid, lane); S.done(cur); }
#undef PG8_SA
#undef PG8_SB
#undef PG8_STAGE
#undef PG8_LDA
#undef PG8_LDB
#undef PG8_MMA
#undef PG8_WAIT_V
#undef PG8_WAIT_L
#undef PG8_BAR
#undef PG8_SCHED
}

struct UnitX { int pm, pn; const bf16_t* A; const bf16_t* Bt; int K; int kind; };
template <class Epi, class Sched, bool ALIGN_EPI = false, bool SP2 = false>
__device__ __forceinline__ void gemm_phase_multi(PG8_LAS unsigned char* lds, const Sched& S, const Epi& E, const int tid) {
    const int wid = __builtin_amdgcn_readfirstlane(tid >> 6), lane = tid & 63, wr = wid >> 2, wc = wid & 3, fr = lane & 15, fq = lane >> 4;
    int sR[2], sRb[2], sC[2];
#pragma unroll
    for (int i = 0; i < 2; ++i) { int R, C; stage_rc(tid * 16 + i * 8192, R, C); sR[i] = R; sRb[i] = Epi::PERM ? ((R & ~31) + perm32(R & 31)) : R; sC[i] = C; }
    unsigned voffA[2], voffB[2], voffAn[2], voffBn[2];
#define PG8_VOFF(dA, dB, KK) do { _Pragma("unroll") for (int _i = 0; _i < 2; ++_i) { dA[_i] = (unsigned)(sR[_i] * (KK) + sC[_i]) * 2u; dB[_i] = (unsigned)(sRb[_i] * (KK) + sC[_i]) * 2u; } } while (0)
    const size_t kstep = (size_t)(BK * 2);
    const unsigned ldsw = (unsigned)wid * 1024u;
    const int aoff = lds_byte(wr * 64 + fr, fq * 8), boff = lds_byte(wc * 32 + fr, fq * 8);
#define PG8_SA(b, h) (((b) * 2 + (h)) * HTB)
#define PG8_SB(b, h) ((4 + (b) * 2 + (h)) * HTB)
#define PG8_STAGE(bufoff, gbase, voff) do { _Pragma("unroll") for (int _i = 0; _i < 2; ++_i) \
        __builtin_amdgcn_global_load_lds((const unsigned*)((const char*)(gbase) + (voff)[_i]), (PG8_LAS unsigned*)(lds + (bufoff) + ldsw + _i * 8192), 16, 0, 0); } while (0)
#define PG8_LDA(dst, b, h) do { _Pragma("unroll") for (int m = 0; m < 4; ++m) _Pragma("unroll") for (int k = 0; k < 2; ++k) dst[m][k] = *(const PG8_LAS bf16x8*)(lds + PG8_SA(b, h) + aoff + m * 2048 + k * 1024); } while (0)
#define PG8_LDB(dst, b, h) do { _Pragma("unroll") for (int n = 0; n < 2; ++n) _Pragma("unroll") for (int k = 0; k < 2; ++k) dst[n][k] = *(const PG8_LAS bf16x8*)(lds + PG8_SB(b, h) + boff + n * 2048 + k * 1024); } while (0)
#define PG8_MMA(ai, bj, At, Bt) do { __builtin_amdgcn_s_setprio(1); _Pragma("unroll") for (int m = 0; m < 4; ++m) _Pragma("unroll") for (int n = 0; n < 2; ++n) _Pragma("unroll") for (int k = 0; k < 2; ++k) \
        acc[ai][bj][m][n] = __builtin_amdgcn_mfma_f32_16x16x32_bf16(Bt[n][k], At[m][k], acc[ai][bj][m][n], 0, 0, 0); __builtin_amdgcn_s_setprio(0); } while (0)
#define PG8_WAIT_V(n) asm volatile("s_waitcnt vmcnt(" #n ")" ::: "memory")
#define PG8_WAIT_L(n) asm volatile("s_waitcnt lgkmcnt(" #n ")" ::: "memory")
#define PG8_BAR __builtin_amdgcn_s_barrier()
#define PG8_SCHED __builtin_amdgcn_sched_barrier(0)
    UnitX cur, nxt; int ui = 0;
    if (!S.next(0, cur)) return;
    int K = cur.K, nt = K / BK; size_t hstep = (size_t)HALF * K * 2, hstepn = hstep; PG8_VOFF(voffA, voffB, K); PG8_VOFF(voffAn, voffBn, K);
    f32x4 acc[2][2][4][2];
#pragma unroll
    for (int a = 0; a < 2; ++a)
#pragma unroll
        for (int b = 0; b < 2; ++b)
#pragma unroll
            for (int m = 0; m < 4; ++m)
#pragma unroll
                for (int n = 0; n < 2; ++n) acc[a][b][m][n] = (f32x4){0.f, 0.f, 0.f, 0.f};
    bf16x8 At[4][2], B0[2][2], B1[2][2];
    const char* cA = (const char*)cur.A + (size_t)cur.pm * 2 * hstep; const char* cB = (const char*)cur.Bt + (size_t)cur.pn * 2 * hstep;
    S.a_ready(cur);
    if constexpr (SP2) {
        PG8_STAGE(PG8_SB(0, 0), cB, voffB); PG8_STAGE(PG8_SB(0, 1), cB + hstep, voffB); PG8_STAGE(PG8_SA(0, 0), cA, voffA); PG8_STAGE(PG8_SA(0, 1), cA + hstep, voffA);
        if (wr == 1) PG8_BAR;
        PG8_WAIT_V(2); PG8_BAR;
        PG8_STAGE(PG8_SB(1, 0), cB + kstep, voffB); PG8_STAGE(PG8_SA(1, 0), cA + kstep, voffA); PG8_STAGE(PG8_SB(1, 1), cB + hstep + kstep, voffB);
        PG8_WAIT_V(6); PG8_BAR;
    } else {
        PG8_STAGE(PG8_SB(0, 0), cB, voffB); PG8_STAGE(PG8_SA(0, 0), cA, voffA); PG8_STAGE(PG8_SB(0, 1), cB + hstep, voffB); PG8_STAGE(PG8_SA(0, 1), cA + hstep, voffA);
        if (wr == 1) PG8_BAR;
        PG8_WAIT_V(4); PG8_BAR;
        PG8_STAGE(PG8_SB(1, 0), cB + kstep, voffB); PG8_STAGE(PG8_SA(1, 0), cA + kstep, voffA); PG8_STAGE(PG8_SB(1, 1), cB + hstep + kstep, voffB);
        PG8_WAIT_V(6); PG8_BAR;
    }
    for (;;) {
        const bool has_next = S.next(ui + 1, nxt);
        if (has_next) { hstepn = (size_t)HALF * nxt.K * 2; PG8_VOFF(voffAn, voffBn, nxt.K); } else { hstepn = hstep; PG8_VOFF(voffAn, voffBn, K); }
        const char* nA = has_next ? (const char*)nxt.A + (size_t)nxt.pm * 2 * hstepn : cA; const char* nB = has_next ? (const char*)nxt.Bt + (size_t)nxt.pn * 2 * hstepn : cB;
        for (int t = 0; t < nt; t += 2) {
            const bool last = (t == nt - 2);
            const char* a1 = cA + (size_t)(t + 1) * kstep;
            const char* a2 = last ? nA : cA + (size_t)(t + 2) * kstep; const char* b2 = last ? nB : cB + (size_t)(t + 2) * kstep;
            const char* a3 = a2 + kstep; const char* b3 = b2 + kstep;
            unsigned vA2[2], vB2[2]; vA2[0] = last ? voffAn[0] : voffA[0]; vA2[1] = last ? voffAn[1] : voffA[1]; vB2[0] = last ? voffBn[0] : voffB[0]; vB2[1] = last ? voffBn[1] : voffB[1];
            const size_t hs2 = last ? hstepn : hstep;
            if (last && has_next) S.a_ready(nxt);
            if constexpr (SP2) {
            PG8_LDB(B0, 0, 0); PG8_LDB(B1, 0, 1); PG8_SCHED; PG8_LDA(At, 0, 0); PG8_STAGE(PG8_SA(1, 1), a1 + hstep, voffA);
            PG8_WAIT_V(8); PG8_WAIT_L(0); PG8_BAR; PG8_MMA(0, 0, At, B0); PG8_MMA(0, 1, At, B1); PG8_BAR; PG8_SCHED;
            PG8_LDA(At, 0, 1); PG8_STAGE(PG8_SB(0, 0), b2, vB2); PG8_STAGE(PG8_SB(0, 1), b2 + hs2, vB2); PG8_STAGE(PG8_SA(0, 0), a2, vA2);
            PG8_WAIT_V(8); PG8_WAIT_L(0); PG8_BAR; PG8_MMA(1, 0, At, B0); PG8_MMA(1, 1, At, B1); PG8_BAR; PG8_SCHED;
            PG8_LDB(B0, 1, 0); PG8_LDB(B1, 1, 1); PG8_SCHED; PG8_LDA(At, 1, 0); PG8_STAGE(PG8_SA(0, 1), a2 + hs2, vA2);
            PG8_WAIT_V(8); PG8_WAIT_L(0); PG8_BAR; PG8_MMA(0, 0, At, B0); PG8_MMA(0, 1, At, B1); PG8_BAR; PG8_SCHED;
            PG8_LDA(At, 1, 1); PG8_STAGE(PG8_SB(1, 0), b3, vB2); PG8_STAGE(PG8_SB(1, 1), b3 + hs2, vB2); PG8_STAGE(PG8_SA(1, 0), a3, vA2);
            PG8_WAIT_V(8); PG8_WAIT_L(0); PG8_BAR; PG8_MMA(1, 0, At, B0); PG8_MMA(1, 1, At, B1); PG8_BAR; PG8_SCHED;
            } else {
            PG8_LDB(B0, 0, 0); PG8_SCHED; PG8_LDA(At, 0, 0); PG8_STAGE(PG8_SA(1, 1), a1 + hstep, voffA);
            PG8_WAIT_L(8); PG8_BAR; PG8_WAIT_L(0); PG8_MMA(0, 0, At, B0); PG8_BAR; PG8_SCHED;
            PG8_LDB(B1, 0, 1); PG8_STAGE(PG8_SB(0, 0), b2, voffB);
            PG8_BAR; PG8_WAIT_L(0); PG8_MMA(0, 1, At, B1); PG8_BAR;
            PG8_LDA(At, 0, 1); PG8_STAGE(PG8_SA(0, 0), a2, voffA);
            PG8_BAR; PG8_WAIT_L(0); PG8_MMA(1, 0, At, B0); PG8_BAR; PG8_SCHED;
            PG8_STAGE(PG8_SB(0, 1), b2 + hstep, voffB);
            PG8_WAIT_V(6); PG8_BAR; PG8_MMA(1, 1, At, B1); PG8_BAR;
            PG8_LDB(B0, 1, 0); PG8_SCHED; PG8_LDA(At, 1, 0); PG8_STAGE(PG8_SA(0, 1), a2 + hstep, voffA);
            PG8_WAIT_L(8); PG8_BAR; PG8_WAIT_L(0); PG8_MMA(0, 0, At, B0); PG8_BAR; PG8_SCHED;
            PG8_LDB(B1, 1, 1); PG8_STAGE(PG8_SB(1, 0), b3, voffB);
            PG8_BAR; PG8_WAIT_L(0); PG8_MMA(0, 1, At, B1); PG8_BAR;
            PG8_LDA(At, 1, 1); PG8_STAGE(PG8_SA(1, 0), a3, voffA);
            PG8_BAR; PG8_WAIT_L(0); PG8_MMA(1, 0, At, B0); PG8_BAR; PG8_SCHED;
            PG8_STAGE(PG8_SB(1, 1), b3 + hstep, voffB);
            PG8_WAIT_V(6); PG8_BAR; PG8_MMA(1, 1, At, B1); PG8_BAR;
            }
        }
        if constexpr (ALIGN_EPI) { if (wr == 0) PG8_BAR; }
        if constexpr (!Epi::AFTER_DRAIN) { E(acc, cur, wr, wc, fr, fq); S.done(cur); }
        if (!has_next) break;
#pragma unroll
        for (int a = 0; a < 2; ++a)
#pragma unroll
            for (int b = 0; b < 2; ++b)
#pragma unroll
                for (int m = 0; m < 4; ++m)
#pragma unroll
                    for (int n = 0; n < 2; ++n) acc[a][b][m][n] = (f32x4){0.f, 0.f, 0.f, 0.f};
        cur = nxt; cA = nA; cB = nB; ++ui; K = cur.K; nt = K / BK; hstep = hstepn; voffA[0] = voffAn[0]; voffA[1] = voffAn[1]; voffB[0] = voffBn[0]; voffB[1] = voffBn[1];
        if constexpr (ALIGN_EPI) { if (wr == 1) PG8_BAR; }
    }
    PG8_WAIT_V(0);
    if constexpr (!ALIGN_EPI) { if (wr == 0) PG8_BAR; }
    PG8_BAR;
    if constexpr (Epi::AFTER_DRAIN) { E.fused(acc, cur, wr, wc, fr, fq, lds, wid, lane); S.done(cur); }
#undef PG8_SA
#undef PG8_SB
#undef PG8_STAGE
#undef PG8_LDA
#undef PG8_LDB
#undef PG8_MMA
#undef PG8_WAIT_V
#undef PG8_WAIT_L
#undef PG8_BAR
#undef PG8_SCHED
#undef PG8_VOFF
}


}
constexpr int BATCH = 4, SEQ = 4096, D = 1024, DRNN = 1280, NH = 20, FF = 4096, DEPTH = 2;
constexpr int M = BATCH * SEQ;
constexpr int DIN = 6656, NP1 = 4608;
constexpr int NSEG = 64;
constexpr int NWAVES = 8;
constexpr size_t KiB = 1024, MiB = 1u << 20;
constexpr size_t WS_SSQ = 0;
constexpr size_t WS_VST = 320 * KiB;
constexpr size_t WS_TS = 704 * KiB;
constexpr size_t WS_BAR = 640 * KiB;
constexpr size_t WS_ATOT = 1 * MiB, WS_HEND = 1 * MiB + 1280 * KiB;
constexpr size_t WS_W = 4 * MiB, W_LAYER = 37 * MiB;
constexpr size_t W_IN = 0, W_G = 9 * MiB, W_A = 13 * MiB, W_B = 15 * MiB + 512 * KiB, W_O = 17 * MiB + 512 * KiB, W_UP = 19 * MiB + 512 * KiB, W_DN = 27 * MiB + 512 * KiB,
                 W_L = 35 * MiB + 512 * KiB, W_S = 36 * MiB;
constexpr size_t WS_HALO = 254 * MiB;
constexpr size_t WS_XB = 78 * MiB;
constexpr size_t WS_XR = 110 * MiB, WS_GR = 150 * MiB, WS_U = 190 * MiB, WS_V = 222 * MiB, WS_END = 256 * MiB;
constexpr size_t WS_F = 110 * MiB;
constexpr size_t WS_S1 = WS_V, WS_S2 = WS_XR;
static_assert(WS_HEND + 1280 * KiB <= WS_W && WS_W + 2 * W_LAYER <= WS_XB && WS_XB + (size_t)M * D * 2 <= WS_XR && WS_F + (size_t)M * FF * 2 <= WS_HALO && WS_V + (size_t)M * D * 2 <= WS_HALO && WS_HALO + (size_t)(M / 64) * 3 * DRNN * 2 <= WS_END, "d_ws map");
static_assert(W_S + 8 * 128 * 128 * 2 <= W_LAYER && W_L + 2 * 20 * 64 * 64 * 2 <= W_S, "weight map");
constexpr int LDS_BYTES = 147456;
constexpr int NPHASE = 16;

#define LAS __attribute__((address_space(3)))
typedef unsigned short bf16;
typedef float f32x4 __attribute__((ext_vector_type(4)));
typedef short bf16x8 __attribute__((ext_vector_type(8)));
typedef unsigned u32x4 __attribute__((ext_vector_type(4)));
typedef unsigned u32x2 __attribute__((ext_vector_type(2)));
#define LDS_WAIT() asm volatile("s_waitcnt lgkmcnt(0)" ::: "memory")
using pg8::cvt_pk_bf16; using pg8::bf_lo; using pg8::bf_hi; using pg8::sigm;

__device__ __forceinline__ float wave_sum(float v) {
#pragma unroll
    for (int o = 1; o < 64; o <<= 1) v += __shfl_xor(v, o);
    return v;
}
struct Args { const float* in[21]; float* out; unsigned char* ws; int ph_lo, ph_hi; };
enum { I_X = 0, I_NMG, I_WIN, I_CW, I_CB, I_LWA, I_LBA, I_LWX, I_LBX, I_LAM, I_LNG, I_LNB, I_WS, I_BS, I_WA, I_WB, I_WO, I_NFG, I_WUP, I_WDN, I_FNG };
typedef const unsigned char __attribute__((address_space(4)))* kptr_t;
#define AIN(kp, i) (*(const float* const __attribute__((address_space(4)))*)((kp) + 8 * (i)))
struct CvtItem { const float* src; const float* ksc; bf16* dst; int ldw, K; };
__device__ __forceinline__ CvtItem cvt_decode(kptr_t kp, unsigned char* wl, int l, int r) {
    constexpr int J0 = 16 * 144, J1 = 16 * 64, J2 = 20 * 32, J3 = 16 * 32, J4 = 16 * 32, J5 = 16 * 128;
    const float* W; const float* ksc = nullptr; bf16* WT; int ldw, K, nblk;
    if (r < J0) { W = AIN(kp, I_WIN) + (size_t)l * D * DIN; ldw = DIN; K = D; nblk = NP1 / 32; WT = (bf16*)(wl + W_IN); ksc = AIN(kp, I_NMG) + l * D; }
    else if ((r -= J0) < J1) { W = AIN(kp, I_WIN) + (size_t)l * D * DIN + NP1; ldw = DIN; K = D; nblk = 2048 / 32; WT = (bf16*)(wl + W_G); ksc = AIN(kp, I_NMG) + l * D; }
    else if ((r -= J1) < J2) { W = AIN(kp, I_WA) + (size_t)l * DRNN * D; ldw = D; K = DRNN; nblk = D / 32; WT = (bf16*)(wl + W_A); }
    else if ((r -= J2) < J3) { W = AIN(kp, I_WB) + (size_t)l * D * D; ldw = D; K = D; nblk = D / 32; WT = (bf16*)(wl + W_B); }
    else if ((r -= J3) < J4) { W = AIN(kp, I_WO) + (size_t)l * D * D; ldw = D; K = D; nblk = D / 32; WT = (bf16*)(wl + W_O); }
    else if ((r -= J4) < J5) { W = AIN(kp, I_WUP) + (size_t)l * D * FF; ldw = FF; K = D; nblk = FF / 32; WT = (bf16*)(wl + W_UP); ksc = AIN(kp, I_NFG) + l * D; }
    else { r -= J5; W = AIN(kp, I_WDN) + (size_t)l * FF * D; ldw = D; K = FF; nblk = D / 32; WT = (bf16*)(wl + W_DN); }
    const int k0 = 64 * (r / nblk), n0 = 32 * (r % nblk);
    CvtItem c; c.src = W + (size_t)k0 * ldw + n0; c.ksc = ksc ? ksc + k0 : nullptr; c.dst = WT + (size_t)n0 * K + k0; c.ldw = ldw; c.K = K; return c;
}
constexpr int CVT_WIN = 16 * 144, CVT_ALL = 16 * 144 + 16 * 64 + 20 * 32 + 16 * 32 + 16 * 32 + 16 * 128 + 64 * 32;
__device__ __forceinline__ void convert_layer(kptr_t kp, unsigned char* ws, int l, int lo, int JL, LAS float* scr, int gw, int NGW, int lane) {
    gw += lo;
    unsigned char* wl = ws + WS_W + (size_t)l * W_LAYER;
    const int lr = lane >> 3, lc = (lane & 7) * 4;
    if (gw >= JL) return;
    CvtItem cur = cvt_decode(kp, wl, l, gw);
    f32x4 v[8];
#pragma unroll
    for (int i = 0; i < 8; ++i) v[i] = __builtin_nontemporal_load((const f32x4*)(cur.src + (size_t)(lr + 8 * i) * cur.ldw + lc));
    for (int it = gw; it < JL; it += NGW) {
        const bool more = it + NGW < JL; CvtItem nxt = cur; f32x4 vn[8];
        if (more) { nxt = cvt_decode(kp, wl, l, it + NGW);
#pragma unroll
            for (int i = 0; i < 8; ++i) vn[i] = __builtin_nontemporal_load((const f32x4*)(nxt.src + (size_t)(lr + 8 * i) * nxt.ldw + lc)); }
        if (cur.ksc) {
#pragma unroll
            for (int i = 0; i < 8; ++i) v[i] = v[i] * cur.ksc[lr + 8 * i]; }
#pragma unroll
        for (int i = 0; i < 8; ++i) { LAS float* d = scr + (lr + 8 * i) * 33 + lc; d[0] = v[i][0]; d[1] = v[i][1]; d[2] = v[i][2]; d[3] = v[i][3]; }
        LDS_WAIT(); asm volatile("" ::: "memory");
        const int c = lane & 7;
#pragma unroll
        for (int j = 0; j < 4; ++j) { const int n = (lane >> 3) + 8 * j; const LAS float* s = scr + (8 * c) * 33 + n;
            u32x4 o; o.x = cvt_pk_bf16(s[0 * 33], s[1 * 33]); o.y = cvt_pk_bf16(s[2 * 33], s[3 * 33]); o.z = cvt_pk_bf16(s[4 * 33], s[5 * 33]); o.w = cvt_pk_bf16(s[6 * 33], s[7 * 33]);
            *(u32x4*)(cur.dst + (size_t)n * cur.K + 8 * c) = o; }
        LDS_WAIT(); asm volatile("" ::: "memory");
        if (more) { cur = nxt;
#pragma unroll
            for (int i = 0; i < 8; ++i) v[i] = vn[i]; }
    }
}
__device__ __forceinline__ void p0_prologue(kptr_t kp, unsigned char* ws, LAS unsigned char* lds, int gw, int NGW, int wave, int lane) {
    LAS float* scr = (LAS float*)(lds + wave * 16384);
    convert_layer(kp, ws, 0, 0, CVT_WIN, scr, gw, NGW, lane);
    const int gt = gw * 64 + lane, NGT = NGW * 64;
    for (int e = gt; e < DEPTH * 2 * NH * 64 * 64; e += NGT) {
        const int i = e & 63, j = (e >> 6) & 63, h = (e >> 12) % NH, g = ((e >> 12) / NH) & 1, l = (e >> 12) / (2 * NH);
        const float v = AIN(kp, g ? I_LWX : I_LWA)[(((size_t)l * NH + h) * 64 + i) * 64 + j];
        ((bf16*)(ws + WS_W + (size_t)l * W_LAYER + W_L))[(((size_t)g * NH + h) * 64 + j) * 64 + i] = (bf16)(cvt_pk_bf16(v, 0.f) & 0xffffu);
    }
    for (int e = gt; e < DEPTH * 8 * 128 * 128; e += NGT) {
        const int s = e & 127, t = (e >> 7) & 127, l = e >> 17;
        float v = AIN(kp, I_WS)[e]; if ((t >> 6) < (s >> 6)) v = 0.f;
        ((bf16*)(ws + WS_W + (size_t)l * W_LAYER + W_S))[e & 131071] = (bf16)(cvt_pk_bf16(v, 0.f) & 0xffffu);
    }
    { float* z = (float*)(ws + WS_SSQ) + M; for (int e = gt; e < 8 * M; e += NGT) z[e] = 0.f; }
    for (int m = gw; m < M; m += NGW) {
        const f32x4* xr = (const f32x4*)(AIN(kp, I_X) + (size_t)m * D) + lane; u32x2* o = (u32x2*)((bf16*)(ws + WS_XB) + (size_t)m * D) + lane; float s = 0.f;
#pragma unroll
        for (int j = 0; j < 4; ++j) { const f32x4 v = __builtin_nontemporal_load(xr + 64 * j); s += (v.x * v.x + v.y * v.y) + (v.z * v.z + v.w * v.w); u32x2 w; w.x = cvt_pk_bf16(v.x, v.y); w.y = cvt_pk_bf16(v.z, v.w); o[64 * j] = w; }
        s = wave_sum(s); if (lane == 0) ((float*)(ws + WS_SSQ))[m] = pg8::tofix(s, pg8::FIX_SSQ);
    }
}

struct SguP { const bf16* V; bf16* U; const bf16* Ws; const float* bs; const float* lng; const float* lnb; const float* vsum; const float* vsq; };
__device__ __forceinline__ unsigned off_b(unsigned row, unsigned ch) { return 256u * row + 16u * (ch ^ (((row & 3) << 2) | ((row >> 2) & 3))); }
__device__ __forceinline__ unsigned tr_addr16(unsigned lane, unsigned c, unsigned ks, unsigned t) { const unsigned g = lane >> 4, q = (lane & 15) >> 2, p = lane & 3; return off_b(32 * ks + 8 * g + 4 * t + q, 2 * c + (p >> 1)) + 8 * (p & 1); }
__device__ __forceinline__ void sgu_dma(const SguP& P, LAS unsigned char* raw, int it, int wave, int lane) {
    const int b = it >> 8, blk = (it >> 3) & 31, g = it & 7, r0 = b * SEQ + blk * 128, c0 = g * 128;
#pragma unroll
    for (int j = 0; j < 4; ++j) { const int row = 16 * wave + 4 * j + (lane >> 4);
        __builtin_amdgcn_global_load_lds((const unsigned*)(P.V + (size_t)(r0 + row) * 1024 + c0 + (lane & 15) * 8), (LAS unsigned*)(raw + (16 * wave + 4 * j) * 256), 16, 0, 0); }
}
__device__ __forceinline__ void sgu_item(const SguP& P, LAS unsigned char* vt, LAS unsigned char* raw, int it_next, int b, int blk, int g, int tid, int wave, int lane) {
    const int r0 = b * SEQ + blk * 128, c0 = g * 128, n = lane & 15, q = lane >> 4;
    const int cc = (tid & 15) * 8;
    const f32x4 g0 = *(const f32x4*)(P.lng + c0 + cc), g1 = *(const f32x4*)(P.lng + c0 + cc + 4), b0 = *(const f32x4*)(P.lnb + c0 + cc), b1 = *(const f32x4*)(P.lnb + c0 + cc + 4);
    float vs1[4], vs2[4];
#pragma unroll
    for (int i = 0; i < 4; ++i) { const int row = r0 + ((tid + 512 * i) >> 4); vs1[i] = P.vsum[row]; vs2[i] = P.vsq[row]; }
    const int nkk = (wave < 4) ? 2 : 4;
    const bf16* Wg = P.Ws + (size_t)g * 128 * 128 + (size_t)(16 * wave + n) * 128 + 8 * q;
    bf16x8 Aw[4];
#pragma unroll
    for (int kk = 0; kk < 4; ++kk) Aw[kk] = (kk < nkk) ? *(const bf16x8*)(Wg + 32 * kk) : (bf16x8){0, 0, 0, 0, 0, 0, 0, 0};
    const int t = 16 * wave + n; const float bias = P.bs[g * 128 + t];
    bf16* ubase = P.U + (size_t)(r0 + t) * 1024 + c0 + 4 * q;
    u32x2 upre[8];
#pragma unroll
    for (int c = 0; c < 8; ++c) upre[c] = *(const u32x2*)(ubase + 16 * c);
    asm volatile("s_waitcnt vmcnt(0)" ::: "memory"); __syncthreads();
#pragma unroll
    for (int i = 0; i < 4; ++i) {
        const int chunk = tid + 512 * i, s = chunk >> 4, ch = chunk & 15;
        const float mu = pg8::unfix(vs1[i], pg8::FIX_V) * (1.0f / 1024.0f), var = fmaxf(pg8::unfix(vs2[i], pg8::FIX_V) * (1.0f / 1024.0f) - mu * mu, 0.f), rstd = __builtin_amdgcn_rsqf(var + 1e-6f);
        const u32x4 v = *(const LAS u32x4*)(raw + chunk * 16);
        float y[8];
        y[0] = (bf_lo(v.x) - mu) * rstd * g0[0] + b0[0]; y[1] = (bf_hi(v.x) - mu) * rstd * g0[1] + b0[1]; y[2] = (bf_lo(v.y) - mu) * rstd * g0[2] + b0[2]; y[3] = (bf_hi(v.y) - mu) * rstd * g0[3] + b0[3];
        y[4] = (bf_lo(v.z) - mu) * rstd * g1[0] + b1[0]; y[5] = (bf_hi(v.z) - mu) * rstd * g1[1] + b1[1]; y[6] = (bf_lo(v.w) - mu) * rstd * g1[2] + b1[2]; y[7] = (bf_hi(v.w) - mu) * rstd * g1[3] + b1[3];
        u32x4 w; w.x = cvt_pk_bf16(y[0], y[1]); w.y = cvt_pk_bf16(y[2], y[3]); w.z = cvt_pk_bf16(y[4], y[5]); w.w = cvt_pk_bf16(y[6], y[7]);
        *(LAS u32x4*)(vt + off_b(s, ch)) = w;
    }
    __syncthreads();
    if (it_next >= 0) sgu_dma(P, raw, it_next, wave, lane);
    const unsigned vb = (unsigned)(size_t)vt;
#pragma unroll
    for (int c = 0; c < 8; ++c) {
        typedef unsigned short u16x4 __attribute__((ext_vector_type(4)));
        u16x4 r[8]; unsigned ad[8];
#pragma unroll
        for (int kk = 0; kk < 4; ++kk) { ad[2 * kk] = vb + tr_addr16(lane, c, kk, 0); ad[2 * kk + 1] = vb + tr_addr16(lane, c, kk, 1); }
        asm volatile("ds_read_b64_tr_b16 %0, %8\n\tds_read_b64_tr_b16 %1, %9\n\tds_read_b64_tr_b16 %2, %10\n\tds_read_b64_tr_b16 %3, %11\n\t"
                     "ds_read_b64_tr_b16 %4, %12\n\tds_read_b64_tr_b16 %5, %13\n\tds_read_b64_tr_b16 %6, %14\n\tds_read_b64_tr_b16 %7, %15\n\ts_waitcnt lgkmcnt(0)"
                     : "=&v"(r[0]), "=&v"(r[1]), "=&v"(r[2]), "=&v"(r[3]), "=&v"(r[4]), "=&v"(r[5]), "=&v"(r[6]), "=&v"(r[7])
                     : "v"(ad[0]), "v"(ad[1]), "v"(ad[2]), "v"(ad[3]), "v"(ad[4]), "v"(ad[5]), "v"(ad[6]), "v"(ad[7]) : "memory");
        f32x4 d = (f32x4){0.f, 0.f, 0.f, 0.f};
#pragma unroll
        for (int kk = 0; kk < 4; ++kk) { if (kk < nkk) { bf16x8 Bv; Bv[0] = (short)r[2 * kk][0]; Bv[1] = (short)r[2 * kk][1]; Bv[2] = (short)r[2 * kk][2]; Bv[3] = (short)r[2 * kk][3];
            Bv[4] = (short)r[2 * kk + 1][0]; Bv[5] = (short)r[2 * kk + 1][1]; Bv[6] = (short)r[2 * kk + 1][2]; Bv[7] = (short)r[2 * kk + 1][3];
            d = __builtin_amdgcn_mfma_f32_16x16x32_bf16(Bv, Aw[kk], d, 0, 0, 0); } }
        const u32x2 uw = upre[c];
        u32x2 o; o.x = cvt_pk_bf16(bf_lo(uw.x) * (d[0] + bias), bf_hi(uw.x) * (d[1] + bias)); o.y = cvt_pk_bf16(bf_lo(uw.y) * (d[2] + bias), bf_hi(uw.y) * (d[3] + bias));
        *(u32x2*)(ubase + 16 * c) = o;
    }
}

struct RnnP { bf16* XR; bf16* GY; const bf16* HALO; const bf16* WL; const float* cw; const float* cb; const float* ba; const float* bx; const float* lam; float* Atot; float* Hend; };
constexpr int XL_LD = 68;
__device__ __forceinline__ float softplus_f(float z) { return fmaxf(z, 0.f) + log1pf(__expf(-fabsf(z))); }
__device__ __forceinline__ void rnn_item(const RnnP& P, LAS float* xl, int b, int h, int seg, int lane) {
    const int n = lane & 15, q = lane >> 4;
    const int cD = h * 64 + 4 * n;
    bf16x8 Wf[2][4][2];
#pragma unroll
    for (int g = 0; g < 2; ++g)
#pragma unroll
        for (int c = 0; c < 4; ++c)
#pragma unroll
            for (int ks = 0; ks < 2; ++ks) Wf[g][c][ks] = *(const bf16x8*)(P.WL + (((size_t)g * NH + h) * 64 + 4 * n + c) * 64 + 32 * ks + 8 * q);
    const f32x4 ba4 = *(const f32x4*)(P.ba + cD), bx4 = *(const f32x4*)(P.bx + cD), lam4 = *(const f32x4*)(P.lam + cD);
    float sp4[4];
#pragma unroll
    for (int c = 0; c < 4; ++c) sp4[c] = 8.0f * softplus_f(-lam4[c]);
    float hin[4] = {0.f, 0.f, 0.f, 0.f}, atot[4] = {1.f, 1.f, 1.f, 1.f};
    LAS float* wlp = xl + 16 * XL_LD;
#pragma unroll
    for (int k = 0; k < 5; ++k) wlp[k * 64 + lane] = (k < 4) ? P.cw[k * DRNN + h * 64 + lane] : P.cb[h * 64 + lane];
    u32x4 xn[2][4];
#define RNN_FETCH(NT) do { const int tl_ = 16 * (NT) + n; _Pragma("unroll") for (int ks = 0; ks < 2; ++ks) _Pragma("unroll") for (int k = 0; k < 4; ++k) { const int tl = tl_ - 3 + k;   \
        const bf16* src = (tl >= 0) ? P.XR + ((size_t)(b * SEQ + seg * 64 + tl)) * DRNN : P.HALO + ((size_t)((b * NSEG + (seg > 0 ? seg - 1 : 0)) * 3 + (tl + 3))) * DRNN; \
        u32x4 xv = *(const u32x4*)(src + h * 64 + 32 * ks + 8 * q); if (tl < 0 && seg == 0) xv = (u32x4){0u, 0u, 0u, 0u}; xn[ks][k] = xv; } } while (0)
    RNN_FETCH(0);
#pragma unroll 1
    for (int nt = 0; nt < 4; ++nt) {
        asm volatile("" ::: "memory");
        const int t0 = seg * 64 + 16 * nt;
        bf16x8 Xf[2];
#pragma unroll
        for (int ks = 0; ks < 2; ++ks) {
            const LAS float* wq = wlp + 32 * ks + 8 * q;
            f32x4 x0 = *(const LAS f32x4*)(wq + 4 * 64), x1 = *(const LAS f32x4*)(wq + 4 * 64 + 4);
#pragma unroll
            for (int k = 0; k < 4; ++k) { const u32x4 xv = xn[ks][k];
                const f32x4 w0 = *(const LAS f32x4*)(wq + k * 64), w1 = *(const LAS f32x4*)(wq + k * 64 + 4);
                x0[0] += bf_lo(xv.x) * w0[0]; x0[1] += bf_hi(xv.x) * w0[1]; x0[2] += bf_lo(xv.y) * w0[2]; x0[3] += bf_hi(xv.y) * w0[3];
                x1[0] += bf_lo(xv.z) * w1[0]; x1[1] += bf_hi(xv.z) * w1[1]; x1[2] += bf_lo(xv.w) * w1[2]; x1[3] += bf_hi(xv.w) * w1[3]; }
            *(LAS f32x4*)(xl + n * XL_LD + 32 * ks + 8 * q) = x0; *(LAS f32x4*)(xl + n * XL_LD + 32 * ks + 8 * q + 4) = x1;
            u32x4 w; w.x = cvt_pk_bf16(x0[0], x0[1]); w.y = cvt_pk_bf16(x0[2], x0[3]); w.z = cvt_pk_bf16(x1[0], x1[1]); w.w = cvt_pk_bf16(x1[2], x1[3]);
            Xf[ks] = __builtin_bit_cast(bf16x8, w);
        }
        if (nt < 3) RNN_FETCH(nt + 1);
        u32x2 gpre[4];
#pragma unroll
        for (int jj = 0; jj < 4; ++jj) gpre[jj] = *(const u32x2*)(P.GY + ((size_t)(b * SEQ + t0 + 4 * q + jj)) * DRNN + cD);
        f32x4 Da[4], Dx[4];
#pragma unroll
        for (int c = 0; c < 4; ++c) {
            Da[c] = __builtin_amdgcn_mfma_f32_16x16x32_bf16(Xf[0], Wf[0][c][0], (f32x4){0.f, 0.f, 0.f, 0.f}, 0, 0, 0); Da[c] = __builtin_amdgcn_mfma_f32_16x16x32_bf16(Xf[1], Wf[0][c][1], Da[c], 0, 0, 0);
            Dx[c] = __builtin_amdgcn_mfma_f32_16x16x32_bf16(Xf[0], Wf[1][c][0], (f32x4){0.f, 0.f, 0.f, 0.f}, 0, 0, 0); Dx[c] = __builtin_amdgcn_mfma_f32_16x16x32_bf16(Xf[1], Wf[1][c][1], Dx[c], 0, 0, 0);
        }
        f32x4 xd[4];
#pragma unroll
        for (int jj = 0; jj < 4; ++jj) xd[jj] = *(const LAS f32x4*)(xl + (4 * q + jj) * XL_LD + 4 * n);
        float hh[4][4], pp[4][4];
#pragma unroll
        for (int c = 0; c < 4; ++c) {
            float av[4], uv[4];
#pragma unroll
            for (int jj = 0; jj < 4; ++jj) {
                const float r = sigm(Da[c][jj] + ba4[c]), ig = sigm(Dx[c][jj] + bx4[c]);
                const float la = -r * sp4[c];
                float d = -la * (1.0f + la * (0.5f + la * (0.16666667f + la * (0.041666668f + la * (0.0083333338f + la * (0.0013888889f + la * 0.0001984127f))))));
                if (__builtin_expect(__any(la < -0.35f), 0)) { if (la < -0.35f) d = 1.0f - __builtin_amdgcn_exp2f(1.44269504f * la); }
                av[jj] = 1.0f - d;
                uv[jj] = __builtin_amdgcn_sqrtf(d * (2.0f - d)) * (ig * xd[jj][c]);
            }
            pp[c][0] = av[0]; hh[c][0] = uv[0];
#pragma unroll
            for (int jj = 1; jj < 4; ++jj) { hh[c][jj] = av[jj] * hh[c][jj - 1] + uv[jj]; pp[c][jj] = av[jj] * pp[c][jj - 1]; }
        }
        float Aq[4], Hq[4], Ax[4], Hx[4];
#pragma unroll
        for (int c = 0; c < 4; ++c) { Aq[c] = pp[c][3]; Hq[c] = hh[c][3]; }
#pragma unroll
        for (int c = 0; c < 4; ++c) { Ax[c] = __shfl_up(Aq[c], 16); Hx[c] = __shfl_up(Hq[c], 16); }
#pragma unroll
        for (int c = 0; c < 4; ++c) if (q >= 1) { Hq[c] = Aq[c] * Hx[c] + Hq[c]; Aq[c] = Aq[c] * Ax[c]; }
#pragma unroll
        for (int c = 0; c < 4; ++c) { Ax[c] = __shfl_up(Aq[c], 32); Hx[c] = __shfl_up(Hq[c], 32); }
#pragma unroll
        for (int c = 0; c < 4; ++c) if (q >= 2) { Hq[c] = Aq[c] * Hx[c] + Hq[c]; Aq[c] = Aq[c] * Ax[c]; }
        float A3[4], H3[4];
#pragma unroll
        for (int c = 0; c < 4; ++c) { Ax[c] = __shfl_up(Aq[c], 16); Hx[c] = __shfl_up(Hq[c], 16); A3[c] = __shfl(Aq[c], 48 + n); H3[c] = __shfl(Hq[c], 48 + n); }
#pragma unroll
        for (int c = 0; c < 4; ++c) {
            if (q == 0) { Ax[c] = 1.f; Hx[c] = 0.f; }
            const float cin = Hx[c] + Ax[c] * hin[c], pin = Ax[c] * atot[c];
#pragma unroll
            for (int jj = 0; jj < 4; ++jj) { hh[c][jj] = hh[c][jj] + pp[c][jj] * cin; pp[c][jj] = pp[c][jj] * pin; }
            hin[c] = H3[c] + A3[c] * hin[c]; atot[c] *= A3[c];
        }
#pragma unroll
        for (int jj = 0; jj < 4; ++jj) { const size_t o = ((size_t)(b * SEQ + t0 + 4 * q + jj)) * DRNN + cD; const u32x2 gw = gpre[jj];
            const float g0 = bf_lo(gw.x), g1 = bf_hi(gw.x), g2 = bf_lo(gw.y), g3 = bf_hi(gw.y);
            u32x2 oy; oy.x = cvt_pk_bf16(hh[0][jj] * g0, hh[1][jj] * g1); oy.y = cvt_pk_bf16(hh[2][jj] * g2, hh[3][jj] * g3); *(u32x2*)(P.GY + o) = oy;
            u32x2 op; op.x = cvt_pk_bf16(pp[0][jj] * g0, pp[1][jj] * g1); op.y = cvt_pk_bf16(pp[2][jj] * g2, pp[3][jj] * g3); *(u32x2*)(P.XR + o) = op; }
    }
    if (q == 0) { const size_t o = ((size_t)(b * NSEG + seg)) * DRNN + cD;
        *(f32x4*)(P.Atot + o) = (f32x4){atot[0], atot[1], atot[2], atot[3]}; *(f32x4*)(P.Hend + o) = (f32x4){hin[0], hin[1], hin[2], hin[3]}; }
}
__device__ __forceinline__ void rnn_apply(const RnnP& P, LAS float* cl, int b, int seg, int tid) {
    if (seg == 0) return;
    {
        float H[3] = {0.f, 0.f, 0.f};
        for (int s0 = 0; s0 < seg; s0 += 16) { float as[3][16], hs[3][16];
#pragma unroll
            for (int k = 0; k < 3; ++k) { const int c = tid + k * NWAVES * 64;
#pragma unroll
                for (int j = 0; j < 16; ++j) { const bool in = (s0 + j < seg) && (c < DRNN); const size_t o = ((size_t)(b * NSEG + (in ? s0 + j : 0))) * DRNN + (in ? c : 0); as[k][j] = in ? P.Atot[o] : 1.f; hs[k][j] = in ? P.Hend[o] : 0.f; } }
#pragma unroll
            for (int k = 0; k < 3; ++k)
#pragma unroll
                for (int j = 0; j < 16; ++j) H[k] = as[k][j] * H[k] + hs[k][j]; }
#pragma unroll
        for (int k = 0; k < 3; ++k) { const int c = tid + k * NWAVES * 64; if (c < DRNN) cl[c] = H[k]; }
    }
    __syncthreads();
    for (int i = tid; i < 64 * (DRNN / 8); i += NWAVES * 64) { const int r = i / (DRNN / 8), ch = (i % (DRNN / 8)) * 8; const size_t o = ((size_t)(b * SEQ + seg * 64 + r)) * DRNN + ch;
        const u32x4 y = *(const u32x4*)(P.GY + o), p = *(const u32x4*)(P.XR + o); const f32x4 c0 = *(const LAS f32x4*)(cl + ch), c1 = *(const LAS f32x4*)(cl + ch + 4);
        u32x4 w; w.x = cvt_pk_bf16(bf_lo(y.x) + bf_lo(p.x) * c0[0], bf_hi(y.x) + bf_hi(p.x) * c0[1]); w.y = cvt_pk_bf16(bf_lo(y.y) + bf_lo(p.y) * c0[2], bf_hi(y.y) + bf_hi(p.y) * c0[3]);
        w.z = cvt_pk_bf16(bf_lo(y.z) + bf_lo(p.z) * c1[0], bf_hi(y.z) + bf_hi(p.z) * c1[1]); w.w = cvt_pk_bf16(bf_lo(y.w) + bf_lo(p.w) * c1[2], bf_hi(y.w) + bf_hi(p.w) * c1[3]);
        *(u32x4*)(P.GY + o) = w; }
    __syncthreads();
}
#define XB_TMO      128
#define XB_XCNT(j)  (256  + 64 * (j))
#define XB_XSUB(j)  (1280 + 64 * (j))
#define XB_XGEN(j)  (2304 + 64 * (j))
#define XB_TOP      3328
#define XB_TOPGEN   3392
#define XCD_BAR_WORDS 3456
#define XB_SPIN_CAP (1u << 18)

__device__ __forceinline__ unsigned xb_ld(unsigned* p)              { return __hip_atomic_load(p, __ATOMIC_RELAXED, __HIP_MEMORY_SCOPE_AGENT); }
__device__ __forceinline__ unsigned xb_add(unsigned* p, unsigned v) { return __hip_atomic_fetch_add(p, v, __ATOMIC_RELAXED, __HIP_MEMORY_SCOPE_AGENT); }
__device__ __forceinline__ unsigned xb_xcc_id() { return (unsigned)__builtin_amdgcn_s_getreg((3 << 11) | 20) & 0xFu; }
#define XB_SPIN(cond, bar) do { unsigned _sp = 0; while (cond) { __builtin_amdgcn_s_sleep(1); \
    if ((++_sp & 255u) == 0u) { if (xb_ld(&(bar)[XB_TMO])) break; if (_sp > XB_SPIN_CAP) { atomicAdd(&(bar)[XB_TMO], 1u); break; } } } } while (0)

struct XcdBarrier {
    unsigned* bar; unsigned x;
    volatile LAS unsigned* st;
};

__device__ __forceinline__ XcdBarrier xcd_barrier_post(unsigned* bar, volatile LAS unsigned* st) {
    XcdBarrier b; b.bar = bar; b.x = xb_xcc_id(); b.st = st;
    if (threadIdx.x == 0) (void)xb_add(&bar[XB_XCNT(b.x)], 1u);
    return b;
}
__device__ __forceinline__ void xcd_barrier_complete(unsigned* bar, unsigned x, unsigned& nloc, unsigned& nx) {
    const unsigned G = gridDim.x * gridDim.y * gridDim.z;
    unsigned sum, cnt, mine, sp = 0u;
    for (;;) {
        sum = 0u; cnt = 0u; mine = 0u;
#pragma unroll
        for (unsigned j = 0; j < 16; ++j) { const unsigned c = xb_ld(&bar[XB_XCNT(j)]); sum += c; cnt += (c > 0u) ? 1u : 0u; mine = (j == x) ? c : mine; }
        if (sum == G) break;
        __builtin_amdgcn_s_sleep(1);
        if ((++sp & 255u) == 0u) { if (xb_ld(&bar[XB_TMO])) break; if (sp > XB_SPIN_CAP) { atomicAdd(&bar[XB_TMO], 1u); break; } }
    }
    nloc = mine > 0u ? mine : 1u; nx = cnt > 0u ? cnt : 1u;
}

__device__ __forceinline__ void xcd_barrier(const XcdBarrier& b) {
    asm volatile("s_waitcnt vmcnt(0)" ::: "memory");
    __syncthreads();
    if (threadIdx.x == 0) {
        unsigned* bar = b.bar;
        __builtin_amdgcn_s_waitcnt(0);
        unsigned nloc = b.st[0], nx = b.st[1];
        if (nloc == 0u) { xcd_barrier_complete(bar, b.x, nloc, nx); b.st[0] = nloc; b.st[1] = nx; }
        const unsigned old = xb_add(&bar[XB_XSUB(b.x)], 1u);
        const unsigned gen = old / nloc;
        if (old + 1u == (gen + 1u) * nloc) {
            __builtin_amdgcn_fence(__ATOMIC_RELEASE, "agent");
            asm volatile("s_waitcnt vmcnt(0)" ::: "memory");
            const unsigned og = xb_add(&bar[XB_TOP], 1u);
            const unsigned tg = og / nx;
            if (og + 1u == (tg + 1u) * nx) xb_add(&bar[XB_TOPGEN], 1u);
            else XB_SPIN(xb_ld(&bar[XB_TOPGEN]) == tg, bar);
            __builtin_amdgcn_fence(__ATOMIC_ACQUIRE, "agent");
            asm volatile("s_waitcnt vmcnt(0)" ::: "memory");
        } else {
            XB_SPIN(xb_ld(&bar[XB_TOPGEN]) == gen, bar);
            __builtin_amdgcn_fence(__ATOMIC_ACQUIRE, "agent");
            asm volatile("s_waitcnt vmcnt(0)" ::: "memory");
        }
    }
    __syncthreads();
}
#ifndef PH_HI
#define PH_HI NPHASE
#endif
#ifndef PH_MASK
#define PH_MASK 511
#endif

struct P3Sched {
    pg8::StaticOrder S0; const bf16 *XB, *WG, *YA, *WA, *YB, *WB;
    __device__ __forceinline__ bool next(int i, pg8::UnitX& u) const { pg8::Unit t; if (!S0.next(i >> 2, t)) return false; const int s = i & 3; u.pm = t.pm; u.pn = t.pn; u.kind = s;
        if (s == 0) { u.A = XB; u.Bt = WG; u.K = D; } else if (s == 1) { u.A = YA; u.Bt = WA; u.K = DRNN; } else if (s == 2) { u.A = XB; u.Bt = WG + (size_t)D * D; u.K = D; } else { u.A = YB; u.Bt = WB; u.K = D; }
        return true; }
    __device__ __forceinline__ void a_ready(const pg8::UnitX&) const {}
    __device__ __forceinline__ void done(const pg8::UnitX&) const {}
};
struct EpiP3 {
    static constexpr bool PERM = true, AFTER_DRAIN = false;
    pg8::EpiGate8 ga, gb; pg8::EpiMix<false> ma; pg8::EpiMix<true> mb;
    __device__ __forceinline__ void operator()(const pg8::f32x4 (&acc)[2][2][4][2], const pg8::UnitX& u, int wr, int wc, int fr, int fq) const {
        const pg8::Unit t{u.pm, u.pn};
        if (u.kind == 0) ga(acc, t, wr, wc, fr, fq); else if (u.kind == 1) ma(acc, t, wr, wc, fr, fq); else if (u.kind == 2) gb(acc, t, wr, wc, fr, fq); else mb(acc, t, wr, wc, fr, fq);
    }
};

__global__ void __launch_bounds__(NWAVES * 64, 2) fwd_megakernel(Args a) {
    extern __shared__ __attribute__((aligned(16))) unsigned char lds_raw[];
    LAS unsigned char* lds = (LAS unsigned char*)lds_raw;
    cg::grid_group grid = cg::this_grid();
    { LAS unsigned* z = (LAS unsigned*)(lds + 131072); if (threadIdx.x < 64) z[threadIdx.x] = 0u; }
    if (blockIdx.x == 0) { unsigned* bw = (unsigned*)(*(unsigned char* const __attribute__((address_space(4)))*)((kptr_t)__builtin_amdgcn_kernarg_segment_ptr() + 176) + WS_BAR);
        for (int i = threadIdx.x; i < XCD_BAR_WORDS; i += NWAVES * 64) __hip_atomic_store(bw + i, 0u, __ATOMIC_RELAXED, __HIP_MEMORY_SCOPE_AGENT);
        __builtin_amdgcn_fence(__ATOMIC_RELEASE, "agent"); asm volatile("s_waitcnt vmcnt(0)" ::: "memory"); }
    __syncthreads();
    grid.sync();
    (void)xcd_barrier_post((unsigned*)(*(unsigned char* const __attribute__((address_space(4)))*)((kptr_t)__builtin_amdgcn_kernarg_segment_ptr() + 176) + WS_BAR), (volatile LAS unsigned*)(lds + 131072 + 32));
    int tid = threadIdx.x, G = gridDim.x, bx = blockIdx.x;
    kptr_t kp = (kptr_t)__builtin_amdgcn_kernarg_segment_ptr();
    unsigned char* ws = *(unsigned char* const __attribute__((address_space(4)))*)(kp + 176);
    float* const outp = *(float* const __attribute__((address_space(4)))*)(kp + 168);
    const int ph_lo = *(const int __attribute__((address_space(4)))*)(kp + 184), ph_hi = *(const int __attribute__((address_space(4)))*)(kp + 188);
#define REFRESH_PTRS() asm volatile("" : "+s"(ws), "+s"(kp))
    float* ssq = (float*)(ws + WS_SSQ); float* vst = (float*)(ws + WS_VST);
    bf16* XB = (bf16*)(ws + WS_XB); bf16* XR = (bf16*)(ws + WS_XR); bf16* GR = (bf16*)(ws + WS_GR); bf16* U = (bf16*)(ws + WS_U); bf16* V = (bf16*)(ws + WS_V);
    bf16* F = (bf16*)(ws + WS_F); bf16* S1 = (bf16*)(ws + WS_S1); bf16* S2 = (bf16*)(ws + WS_S2);

    for (int ph = ph_lo; ph < ph_hi; ++ph) {
        if (ph > ph_lo) { XcdBarrier bar; bar.bar = (unsigned*)(ws + WS_BAR); bar.x = xb_xcc_id(); bar.st = (volatile LAS unsigned*)(lds + 131072 + 32); xcd_barrier(bar); }
#ifdef TS_SEL
        if (blockIdx.x == 0 && threadIdx.x == 0) ((unsigned long long*)(ws + WS_TS))[ph] = __builtin_amdgcn_s_memrealtime();
        if (ph == NPHASE - 1) { XcdBarrier bar; bar.bar = (unsigned*)(ws + WS_BAR); bar.x = xb_xcc_id(); bar.st = (volatile LAS unsigned*)(lds + 131072 + 32); xcd_barrier(bar); }
#endif
        asm volatile("" : "+s"(ws)); asm volatile("" : "+s"(kp)); asm volatile("" : "+v"(tid)); asm volatile("" : "+s"(G)); asm volatile("" : "+s"(bx));
        const int lane = tid & 63, wave = __builtin_amdgcn_readfirstlane(tid >> 6);
        const int vcu = (G % 8 == 0) ? (bx % 8) * (G / 8) + bx / 8 : bx;
        const int gw = vcu * NWAVES + wave, NGW = G * NWAVES;
        ssq = (float*)(ws + WS_SSQ); vst = (float*)(ws + WS_VST); XB = (bf16*)(ws + WS_XB); XR = (bf16*)(ws + WS_XR); GR = (bf16*)(ws + WS_GR); U = (bf16*)(ws + WS_U); V = (bf16*)(ws + WS_V);
        F = (bf16*)(ws + WS_F); S1 = (bf16*)(ws + WS_S1); S2 = (bf16*)(ws + WS_S2);
        if (ph == 0) { if (PH_MASK & 256) p0_prologue(kp, ws, lds, gw, NGW, wave, lane); continue; }
        if (ph == NPHASE - 1) {
            const float* gf = AIN(kp, I_FNG);
            for (int m = gw; m < M; m += NGW) { f32x4* xr = (f32x4*)(outp + (size_t)m * D) + lane; const u32x2* xbr = (const u32x2*)(XB + (size_t)m * D) + lane; f32x4 v[4]; float s = 0.f;
#pragma unroll
                for (int j = 0; j < 4; ++j) { const u32x2 w = xbr[64 * j]; v[j] = (f32x4){bf_lo(w.x), bf_hi(w.x), bf_lo(w.y), bf_hi(w.y)}; s += (v[j].x * v[j].x + v[j].y * v[j].y) + (v[j].z * v[j].z + v[j].w * v[j].w); }
                const float rs = __builtin_amdgcn_rsqf(wave_sum(s) * (1.0f / 1024.0f) + pg8::RMS_EPS);
#pragma unroll
                for (int j = 0; j < 4; ++j) { const f32x4 g4 = *((const f32x4*)gf + lane + 64 * j); f32x4 o = v[j] * rs * g4;
#ifdef TS_SEL
                    { const unsigned long long* ts = (const unsigned long long*)(ws + WS_TS); unsigned long long sel = 0; const int ids[] = TS_SEL;
                      for (unsigned k = 0; k < sizeof(ids) / sizeof(int); ++k) sel += ts[ids[k] + 1] - ts[ids[k]];
                      const float frac = (float)sel / (float)(ts[NPHASE - 1] - ts[0]), dlt = 0.02f * sqrtf(frac); o += (f32x4){dlt, -dlt, dlt, -dlt}; }
#endif
                    xr[64 * j] = o; } }
            continue;
        }
        const int l = (ph - 1) / 7, sub = (ph - 1) % 7;
        const unsigned char* wl = ws + WS_W + (size_t)l * W_LAYER;
        if (sub == 0 && (PH_MASK & 1)) {
            pg8::Gemm g{XB, (const bf16*)(wl + W_IN), M, NP1, D}; pg8::StaticOrder S; S.init(M, NP1, G, bx);
            pg8::EpiIn E{XR, GR, U, V, (bf16*)(ws + WS_HALO), ssq + (2 * l) * M, vst + (2 * l) * M, vst + (2 * l + 1) * M};
            pg8::gemm_phase<pg8::EpiIn, pg8::StaticOrder, true, true>(lds, g, S, E, tid);
            {
                const int rounds = (S.nwg + G - 1) / G, nidle = rounds * G - S.nwg, first_idle = G - nidle;
                const bool all = (nidle == 0); const int cg = all ? gw : (bx - first_idle) * NWAVES + wave, cn = all ? NGW : nidle * NWAVES;
                if (all || bx >= first_idle) { LAS float* scr = (LAS float*)(lds + wave * 16384);
                    convert_layer(kp, ws, l, CVT_WIN, CVT_ALL, scr, cg, cn, lane);
                    if (l + 1 < DEPTH) convert_layer(kp, ws, l + 1, 0, CVT_WIN, scr, cg, cn, lane); }
            }
        }
#ifdef NAIVE_MIX
        else if (sub == 1) { naive_vstats(V, vst + (2 * l) * M, vst + (2 * l + 1) * M, gw, NGW, lane); }
        else if (sub == 2) {
            naive_sgu(V, U, AIN(kp, I_WS) + (size_t)l * 8 * 128 * 128, AIN(kp, I_BS) + l * 1024, AIN(kp, I_LNG) + l * 1024, AIN(kp, I_LNB) + l * 1024, vst + (2 * l) * M, vst + (2 * l + 1) * M, gw * 64 + lane, NGW * 64);
            naive_rnn(XR, GR, AIN(kp, I_LWA) + (size_t)l * NH * 4096, AIN(kp, I_LWX) + (size_t)l * NH * 4096, AIN(kp, I_LBA) + l * DRNN, AIN(kp, I_LBX) + l * DRNN, AIN(kp, I_LAM) + l * DRNN, AIN(kp, I_CW) + l * 4 * DRNN, AIN(kp, I_CB) + l * DRNN, gw, NGW, lane);
        }
#endif
        else if (sub == 1 && (PH_MASK & 2)) {
            SguP P{V, U, (const bf16*)(wl + W_S), AIN(kp, I_BS) + l * 1024, AIN(kp, I_LNG) + l * 1024, AIN(kp, I_LNB) + l * 1024, vst + (2 * l) * M, vst + (2 * l + 1) * M};
            { LAS unsigned char* raw = lds + 32768; if (vcu < BATCH * 32 * 8) sgu_dma(P, raw, vcu, wave, lane);
              for (int it = vcu; it < BATCH * 32 * 8; it += G) sgu_item(P, lds, raw, (it + G < BATCH * 32 * 8) ? it + G : -1, it >> 8, (it >> 3) & 31, it & 7, tid, wave, lane);
              __syncthreads(); }
            RnnP R{XR, GR, (const bf16*)(ws + WS_HALO), (const bf16*)(wl + W_L), AIN(kp, I_CW) + l * 4 * DRNN, AIN(kp, I_CB) + l * DRNN, AIN(kp, I_LBA) + l * DRNN, AIN(kp, I_LBX) + l * DRNN, AIN(kp, I_LAM) + l * DRNN,
                   (float*)(ws + WS_ATOT), (float*)(ws + WS_HEND)};
            LAS float* xl = (LAS float*)(lds + 40960 + wave * 6144);
            { const int per = (BATCH * NH * NSEG + G - 1) / G, base = vcu * per, lim = min(base + per, BATCH * NH * NSEG);
              for (int j = wave; j < per; j += NWAVES) { const int it = base + j; if (it < lim) rnn_item(R, xl, (it / NH) % BATCH, it % NH, it / (NH * BATCH), lane); } }
        } else if (sub == 2 && (PH_MASK & 4)) {
            RnnP R{XR, GR, (const bf16*)(ws + WS_HALO), (const bf16*)(wl + W_L), AIN(kp, I_CW) + l * 4 * DRNN, AIN(kp, I_CB) + l * DRNN, AIN(kp, I_LBA) + l * DRNN, AIN(kp, I_LBX) + l * DRNN, AIN(kp, I_LAM) + l * DRNN,
                   (float*)(ws + WS_ATOT), (float*)(ws + WS_HEND)};
            for (int it = vcu; it < BATCH * NSEG; it += G) rnn_apply(R, (LAS float*)lds, it / NSEG, it % NSEG, tid);
        } else if (sub == 3 && (PH_MASK & 8)) {
            pg8::StaticOrder S; S.init(M, D, G, bx);
            unsigned char* G8 = (unsigned char*)outp;
            P3Sched PS{S, XB, (const bf16*)(wl + W_G), GR, (const bf16*)(wl + W_A), U, (const bf16*)(wl + W_B)};
            EpiP3 E{pg8::EpiGate8{G8, ssq + (2 * l) * M}, pg8::EpiGate8{G8 + (size_t)M * D, ssq + (2 * l) * M}, pg8::EpiMix<false>{S1, G8}, pg8::EpiMix<true>{S1, G8 + (size_t)M * D}};
            pg8::gemm_phase_multi<EpiP3, P3Sched, true, true>(lds, PS, E, tid);
        } else if (sub == 4 && (PH_MASK & 16)) {
            pg8::Gemm g{S1, (const bf16*)(wl + W_O), M, D, D}; pg8::StaticOrder S; S.init(M, D, G, bx);
            pg8::EpiRes E{XB, ssq + (2 * l + 1) * M};
            pg8::gemm_phase<pg8::EpiRes, pg8::StaticOrder, true, true>(lds, g, S, E, tid);
        } else if (sub == 5 && (PH_MASK & 32)) {
            pg8::Gemm g{XB, (const bf16*)(wl + W_UP), M, FF, D}; pg8::StaticOrder S; S.init(M, FF, G, bx);
            pg8::EpiAct<1> E{F, FF, ssq + (2 * l + 1) * M};
            pg8::gemm_phase<pg8::EpiAct<1>, pg8::StaticOrder, true, true>(lds, g, S, E, tid);
        } else if (PH_MASK & 64) {
            pg8::Gemm g{F, (const bf16*)(wl + W_DN), M, D, FF}; pg8::StaticOrder S; S.init(M, D, G, bx);
            pg8::EpiRes E{XB, ssq + (2 * l + 2) * M};
            pg8::gemm_phase<pg8::EpiRes, pg8::StaticOrder, true, true>(lds, g, S, E, tid);
        }
    }
}

extern "C" void kernel_launch(void* const* d_in, const int* in_sizes, int n_in, void* d_out, int out_size, void* d_ws, size_t ws_size, hipStream_t stream) {
    static int grid = 0;
    if (grid == 0) {
        if (n_in != 21 || out_size != M * D || ws_size < WS_END) { fprintf(stderr, "kernel_launch: unexpected shapes (n_in %d, out %d, ws %zu); nothing launched\n", n_in, out_size, ws_size); grid = -1; return; }
        int dev = 0, cus = 0, per_cu = 0;
        if (hipGetDevice(&dev) != hipSuccess || hipDeviceGetAttribute(&cus, hipDeviceAttributeMultiprocessorCount, dev) != hipSuccess) { grid = -1; return; }
        if (hipFuncSetAttribute((const void*)fwd_megakernel, hipFuncAttributeMaxDynamicSharedMemorySize, LDS_BYTES) != hipSuccess) { fprintf(stderr, "kernel_launch: hipFuncSetAttribute failed\n"); grid = -1; return; }
        if (hipOccupancyMaxActiveBlocksPerMultiprocessor(&per_cu, (const void*)fwd_megakernel, NWAVES * 64, LDS_BYTES) != hipSuccess || per_cu < 1) per_cu = 1;
        (void)hipGetLastError();
        grid = cus * per_cu;
        fprintf(stderr, "kernel_launch: %d CUs x %d -> grid %d, ws %zu\n", cus, per_cu, grid, ws_size);
    }
    if (grid < 0) return;
#ifdef EXP_POISON
    (void)hipMemsetAsync(d_ws, 0xAA, WS_END, stream); (void)hipMemsetAsync(d_out, 0xAA, (size_t)M * D * 4, stream);
#endif
    Args a{};
    for (int i = 0; i < 21; ++i) a.in[i] = (const float*)d_in[i];
    a.out = (float*)d_out; a.ws = (unsigned char*)d_ws; a.ph_lo = 0; a.ph_hi = PH_HI;
    void* args[] = {&a};
    const hipError_t e = hipLaunchCooperativeKernel((const void*)fwd_megakernel, dim3(grid), dim3(NWAVES * 64), args, LDS_BYTES, stream);
    if (e != hipSuccess) fprintf(stderr, "kernel_launch: cooperative launch failed: %s (grid %d)\n", hipGetErrorString(e), grid);
}
```
